# Optimizing an MI355X kernel written in HIP

```python
import math
import jax, jax.numpy as jnp
from jax import lax
import numpy as np

D_MODEL = 1024
BATCH = 8
SEQ = 4096
DEPTH = 1

N_HEADS = 8
HEAD_DIM = D_MODEL // 16
ATTN_WIDTH = N_HEADS * HEAD_DIM
ROT_DIM = HEAD_DIM // 4
ROPE_THETA = 500000.0
MOBA_BLOCK = 256
MOBA_TOPK = 3
Q_CHUNK = 128
CONV_WIDTH = D_MODEL // 2
CONV_K = 3
IN_WIDTH = 3 * ATTN_WIDTH + 3 * CONV_WIDTH + 2 * D_MODEL
N_EXPERTS = 256
TOP_K = 8
N_GROUPS = 8
TOPK_GROUPS = 4
EXPERT_DIM = 256
SHARED_DIM = 256
ROUTED_SCALE = 2.5
MOE_BLOCK = 128
PLE_DIM = 256
LN_EPS = 1e-5
DN_ALPHA = (2 * DEPTH) ** 0.25
DN_BETA = (8 * DEPTH) ** -0.25
NEG = -1e30

kernel_name = 'hybrid_moba_shortconv_moe_deepnorm'


def layer_norm(t, g, b):
    tf = t.astype(jnp.float32)
    mu = jnp.mean(tf, axis=-1, keepdims=True)
    var = jnp.mean(jnp.square(tf - mu), axis=-1, keepdims=True)
    out = (tf - mu) * lax.rsqrt(var + LN_EPS) * g.astype(jnp.float32) + b.astype(jnp.float32)
    return out.astype(t.dtype)


def partial_rope(t, pos):
    half = ROT_DIM // 2
    inv_freq = ROPE_THETA ** (-jnp.arange(0, ROT_DIM, 2, dtype=jnp.float32) / ROT_DIM)
    ang = pos.astype(jnp.float32)[:, None] * inv_freq[None, :]
    cos, sin = jnp.cos(ang), jnp.sin(ang)
    tr = t[..., :ROT_DIM].astype(jnp.float32)
    t1, t2 = tr[..., :half], tr[..., half:]
    rot = jnp.concatenate([t1 * cos - t2 * sin, t1 * sin + t2 * cos], axis=-1).astype(t.dtype)
    return jnp.concatenate([rot, t[..., ROT_DIM:]], axis=-1)


def moba_attention(q, k, v):
    B, H, S, Dh = q.shape
    nb = S // MOBA_BLOCK
    nc = S // Q_CHUNK
    k_eff = min(MOBA_TOPK, nb)
    kb = k.reshape(B, H, nb, MOBA_BLOCK, Dh)
    vb = v.reshape(B, H, nb, MOBA_BLOCK, Dh)
    k_mean = jnp.mean(kb.astype(jnp.float32), axis=3)
    qc = q.reshape(B, H, nc, Q_CHUNK, Dh).transpose(0, 2, 1, 3, 4).reshape(B * nc, H, Q_CHUNK, Dh)
    flat = jnp.arange(B * nc, dtype=jnp.int32)
    b_ids = flat // nc
    c_ids = flat % nc
    scale = HEAD_DIM ** -0.5
    head_ids = jnp.arange(H)[:, None, None]

    def chunk(args):
        qi, bi, ci = args
        kb_b, vb_b, km_b = kb[bi], vb[bi], k_mean[bi]
        q_pos = ci * Q_CHUNK + jnp.arange(Q_CHUNK, dtype=jnp.int32)
        own = (ci * Q_CHUNK) // MOBA_BLOCK
        gate = jnp.einsum('hcd,hnd->hcn', qi.astype(jnp.float32), km_b)
        past = jnp.arange(nb)[None, None, :] < own
        gate = jnp.where(past, gate, -jnp.inf)
        _, sel = lax.top_k(gate, k_eff)
        sel_ok = sel < own
        k_sel = kb_b[head_ids, sel]
        v_sel = vb_b[head_ids, sel]
        k_own = lax.dynamic_index_in_dim(kb_b, own, axis=1, keepdims=False)
        v_own = lax.dynamic_index_in_dim(vb_b, own, axis=1, keepdims=False)
        s_sel = jnp.einsum('hcd,hckld->hckl', qi, k_sel).astype(jnp.float32) * scale
        s_sel = jnp.where(sel_ok[..., None], s_sel, NEG)
        k_pos = own * MOBA_BLOCK + jnp.arange(MOBA_BLOCK, dtype=jnp.int32)
        s_own = jnp.einsum('hcd,hld->hcl', qi, k_own).astype(jnp.float32) * scale
        s_own = jnp.where(k_pos[None, None, :] <= q_pos[None, :, None], s_own, NEG)
        logits = jnp.concatenate([s_sel.reshape(H, Q_CHUNK, k_eff * MOBA_BLOCK), s_own], axis=-1)
        probs = jax.nn.softmax(logits, axis=-1).astype(v.dtype)
        p_sel = probs[..., :k_eff * MOBA_BLOCK].reshape(H, Q_CHUNK, k_eff, MOBA_BLOCK)
        p_own = probs[..., k_eff * MOBA_BLOCK:]
        return (jnp.einsum('hckl,hckld->hcd', p_sel, v_sel)
                + jnp.einsum('hcl,hld->hcd', p_own, v_own))

    out = lax.map(chunk, (qc, b_ids, c_ids))
    return out.reshape(B, nc, H, Q_CHUNK, Dh).transpose(0, 2, 1, 3, 4).reshape(B, H, S, Dh)


def short_conv(b_gate, c_gate, h, conv_w):
    u = c_gate * h
    y = lax.conv_general_dilated(u, conv_w[:, None, :].astype(u.dtype), window_strides=(1,),
                                 padding=[(CONV_K - 1, 0)],
                                 dimension_numbers=('NWC', 'WIO', 'NWC'),
                                 feature_group_count=CONV_WIDTH)
    return b_gate * y


def token_mixer(u, w_in, conv_w, w_attn_out, w_conv_out, w_out):
    B, S, _ = u.shape
    z = u @ w_in
    splits = np.cumsum([ATTN_WIDTH, ATTN_WIDTH, ATTN_WIDTH, CONV_WIDTH, CONV_WIDTH, CONV_WIDTH, D_MODEL]).tolist()
    q, k, v, cb, cc, ch, ga, gc = jnp.split(z, splits, axis=-1)
    pos = jnp.arange(S, dtype=jnp.int32)
    to_heads = lambda t: t.reshape(B, S, N_HEADS, HEAD_DIM).transpose(0, 2, 1, 3)
    q = partial_rope(to_heads(q), pos)
    k = partial_rope(to_heads(k), pos)
    v = to_heads(v)
    s_pad = -(-S // MOBA_BLOCK) * MOBA_BLOCK
    padw = ((0, 0), (0, 0), (0, s_pad - S), (0, 0))
    attn = moba_attention(jnp.pad(q, padw), jnp.pad(k, padw), jnp.pad(v, padw))[:, :, :S]
    attn = attn.transpose(0, 2, 1, 3).reshape(B, S, ATTN_WIDTH)
    y_attn = attn @ w_attn_out
    y_conv = short_conv(cb, cc, ch, conv_w) @ w_conv_out
    merged = jax.nn.sigmoid(ga) * y_attn + jax.nn.sigmoid(gc) * y_conv
    return merged @ w_out


def route(xt, w_router, router_bias):
    T = xt.shape[0]
    scores = jax.nn.sigmoid(xt.astype(jnp.float32) @ w_router.astype(jnp.float32))
    choice = scores + router_bias.astype(jnp.float32)[None, :]
    grp = choice.reshape(T, N_GROUPS, N_EXPERTS // N_GROUPS)
    grp_score = jnp.sum(lax.top_k(grp, 2)[0], axis=-1)
    _, grp_idx = lax.top_k(grp_score, TOPK_GROUPS)
    grp_mask = jnp.any(grp_idx[:, :, None] == jnp.arange(N_GROUPS)[None, None, :], axis=1)
    exp_mask = jnp.repeat(grp_mask, N_EXPERTS // N_GROUPS, axis=1)
    _, top_idx = lax.top_k(jnp.where(exp_mask, choice, -jnp.inf), TOP_K)
    top_w = jnp.take_along_axis(scores, top_idx, axis=1)
    top_w = top_w / jnp.sum(top_w, axis=-1, keepdims=True) * ROUTED_SCALE
    return top_idx, top_w


def routed_experts(xt, top_idx, top_w, w_gate, w_up, w_down):
    T, D = xt.shape
    A = T * TOP_K
    e_flat = top_idx.reshape(-1).astype(jnp.int32)
    tok_flat = jnp.arange(A, dtype=jnp.int32) // TOP_K
    w_flat = top_w.reshape(-1)
    order = jnp.argsort(e_flat)
    e_sorted = e_flat[order]
    counts = jnp.bincount(e_flat, length=N_EXPERTS).astype(jnp.int32)
    starts = jnp.cumsum(counts) - counts
    padded = (counts + MOE_BLOCK - 1) // MOE_BLOCK * MOE_BLOCK
    pad_ends = jnp.cumsum(padded)
    pad_starts = pad_ends - padded
    dest = pad_starts[e_sorted] + jnp.arange(A, dtype=jnp.int32) - starts[e_sorted]
    n_blocks = -(-A // MOE_BLOCK) + N_EXPERTS
    R = n_blocks * MOE_BLOCK
    row_tok = jnp.full((R,), T, jnp.int32).at[dest].set(tok_flat[order])
    row_w = jnp.zeros((R,), jnp.float32).at[dest].set(w_flat[order])
    block_start = jnp.arange(n_blocks, dtype=jnp.int32) * MOE_BLOCK
    block_e = jnp.minimum(jnp.searchsorted(pad_ends, block_start, side='right'), N_EXPERTS - 1)
    x_pad = jnp.concatenate([xt, jnp.zeros((1, D), xt.dtype)], axis=0)

    def block(args):
        toks, ws, e = args
        xb = x_pad[toks]
        hb = jax.nn.silu(xb @ w_gate[e]) * (xb @ w_up[e])
        return (hb @ w_down[e]).astype(jnp.float32) * ws[:, None]

    outs = lax.map(block, (row_tok.reshape(n_blocks, MOE_BLOCK), row_w.reshape(n_blocks, MOE_BLOCK), block_e))
    y = jnp.zeros((T + 1, D), jnp.float32).at[row_tok].add(outs.reshape(R, D))
    return y[:T]


def moe_ffn(u, w_router, router_bias, w_exp_gate, w_exp_up, w_exp_down, w_sh_gate, w_sh_up, w_sh_down):
    B, S, D = u.shape
    xt = u.reshape(B * S, D)
    top_idx, top_w = route(xt, w_router, router_bias)
    routed = routed_experts(xt, top_idx, top_w, w_exp_gate, w_exp_up, w_exp_down)
    shared = (jax.nn.silu(xt @ w_sh_gate) * (xt @ w_sh_up)) @ w_sh_down
    return (routed + shared.astype(jnp.float32)).astype(u.dtype).reshape(B, S, D)


def setup_inputs(seed: int = 0) -> dict:
    key = jax.random.key(seed)
    ks = jax.random.split(key, 24)
    f32 = jnp.float32

    def nrm(k, shape, scale):
        return jax.random.normal(k, shape, f32) * scale

    return {
        'x': nrm(ks[0], (BATCH, SEQ, D_MODEL), 1.0),
        'p': nrm(ks[1], (DEPTH, BATCH, SEQ, PLE_DIM), 1.0),
        'w_in': nrm(ks[2], (DEPTH, D_MODEL, IN_WIDTH), D_MODEL ** -0.5),
        'conv_w': nrm(ks[3], (DEPTH, CONV_K, CONV_WIDTH), CONV_K ** -0.5),
        'w_attn_out': nrm(ks[4], (DEPTH, ATTN_WIDTH, D_MODEL), ATTN_WIDTH ** -0.5),
        'w_conv_out': nrm(ks[5], (DEPTH, CONV_WIDTH, D_MODEL), CONV_WIDTH ** -0.5),
        'w_out': nrm(ks[6], (DEPTH, D_MODEL, D_MODEL), DN_BETA * D_MODEL ** -0.5),
        'ln1_g': 1.0 + nrm(ks[7], (DEPTH, D_MODEL), 0.02),
        'ln1_b': nrm(ks[8], (DEPTH, D_MODEL), 0.02),
        'w_router': nrm(ks[9], (DEPTH, D_MODEL, N_EXPERTS), D_MODEL ** -0.5),
        'router_bias': nrm(ks[10], (DEPTH, N_EXPERTS), 0.01),
        'w_exp_gate': nrm(ks[11], (DEPTH, N_EXPERTS, D_MODEL, EXPERT_DIM), D_MODEL ** -0.5),
        'w_exp_up': nrm(ks[12], (DEPTH, N_EXPERTS, D_MODEL, EXPERT_DIM), D_MODEL ** -0.5),
        'w_exp_down': nrm(ks[13], (DEPTH, N_EXPERTS, EXPERT_DIM, D_MODEL), DN_BETA * EXPERT_DIM ** -0.5),
        'w_sh_gate': nrm(ks[14], (DEPTH, D_MODEL, SHARED_DIM), D_MODEL ** -0.5),
        'w_sh_up': nrm(ks[15], (DEPTH, D_MODEL, SHARED_DIM), D_MODEL ** -0.5),
        'w_sh_down': nrm(ks[16], (DEPTH, SHARED_DIM, D_MODEL), DN_BETA * SHARED_DIM ** -0.5),
        'ln2_g': 1.0 + nrm(ks[17], (DEPTH, D_MODEL), 0.02),
        'ln2_b': nrm(ks[18], (DEPTH, D_MODEL), 0.02),
        'w_ple_gate': nrm(ks[19], (DEPTH, D_MODEL, D_MODEL), D_MODEL ** -0.5),
        'w_ple_proj': nrm(ks[20], (DEPTH, PLE_DIM, D_MODEL), DN_BETA * PLE_DIM ** -0.5),
        'ln3_g': 1.0 + nrm(ks[21], (DEPTH, D_MODEL), 0.02),
        'ln3_b': nrm(ks[22], (DEPTH, D_MODEL), 0.02),
    }


def reference(x, p, w_in, conv_w, w_attn_out, w_conv_out, w_out, ln1_g, ln1_b,
              w_router, router_bias, w_exp_gate, w_exp_up, w_exp_down,
              w_sh_gate, w_sh_up, w_sh_down, ln2_g, ln2_b,
              w_ple_gate, w_ple_proj, ln3_g, ln3_b):
    h = x
    for i in range(DEPTH):
        mix = token_mixer(h, w_in[i], conv_w[i], w_attn_out[i], w_conv_out[i], w_out[i])
        h = layer_norm(DN_ALPHA * h + mix, ln1_g[i], ln1_b[i])
        ffn = moe_ffn(h, w_router[i], router_bias[i], w_exp_gate[i], w_exp_up[i], w_exp_down[i],
                      w_sh_gate[i], w_sh_up[i], w_sh_down[i])
        h = layer_norm(DN_ALPHA * h + ffn, ln2_g[i], ln2_b[i])
        ple = jax.nn.sigmoid(h @ w_ple_gate[i]) * (p[i] @ w_ple_proj[i])
        h = layer_norm(DN_ALPHA * h + ple, ln3_g[i], ln3_b[i])
    return h
```

```cpp
#include <hip/hip_runtime.h>
#include <hip/hip_bf16.h>
#include <cstdio>
#include <cstdint>
#include <cmath>

#ifndef MK_N_LAUNCHES
#define MK_N_LAUNCHES 1
#endif

constexpr int NB_ = 8, SEQ_ = 4096, T_ = NB_ * SEQ_, D_ = 1024;
constexpr int NH_ = 8, HD_ = 64, AW_ = 512, CW_ = 512, INW_ = 5120;
constexpr int NE_ = 256, ED_ = 256, TOPK_ = 8, PLE_ = 256;
constexpr int NBLK_ = 16;
constexpr float LN_EPS_ = 1e-5f;
constexpr float DN_ALPHA_ = 1.189207115002721f;
constexpr float ROUTED_SCALE_ = 2.5f;
constexpr int RMAX_ = T_ * TOPK_ + NE_ * 256;

#define GAS __attribute__((address_space(1)))
#define LAS __attribute__((address_space(3)))
typedef unsigned short bf16;
typedef unsigned v4u __attribute__((ext_vector_type(4)));
typedef float f32x4 __attribute__((ext_vector_type(4)));
typedef float f32x2 __attribute__((ext_vector_type(2)));
typedef unsigned u32x2 __attribute__((ext_vector_type(2)));
typedef short bf16x8 __attribute__((ext_vector_type(8)));
typedef GAS unsigned gu32;
#define RLX_AGENT __ATOMIC_RELAXED, __HIP_MEMORY_SCOPE_AGENT
#define LDS_WAIT() asm volatile("s_waitcnt lgkmcnt(0)" ::: "memory")
#define VM_WAIT() asm volatile("s_waitcnt vmcnt(0)" ::: "memory")

typedef float cvt_f32x2_t __attribute__((ext_vector_type(2))); typedef __bf16 cvt_bf16x2_t __attribute__((ext_vector_type(2)));
__device__ __forceinline__ unsigned cvt_pk_bf16(float lo, float hi) { cvt_f32x2_t v = {lo, hi}; cvt_bf16x2_t b = __builtin_convertvector(v, cvt_bf16x2_t); return __builtin_bit_cast(unsigned, b); }
__device__ __forceinline__ float bf_lo(unsigned w) { return __builtin_bit_cast(float, w << 16); }
__device__ __forceinline__ float bf_hi(unsigned w) { return __builtin_bit_cast(float, w & 0xffff0000u); }
__device__ __forceinline__ int lane_id() { unsigned ones = ~0u; asm volatile("" : "+s"(ones)); return (int)__builtin_amdgcn_mbcnt_hi(ones, __builtin_amdgcn_mbcnt_lo(ones, 0u)); }
__device__ __forceinline__ float sigmoidf_(float x) { return __builtin_amdgcn_rcpf(1.0f + __builtin_amdgcn_exp2f(-1.4426950408889634f * x)); }

namespace pg8 {
#define PG8_LAS __attribute__((address_space(3)))
constexpr int BM = 256, BK = 64, HALF = 128, HTB = HALF * BK * 2  , STAGE_BYTES = 8 * HTB, NXCD = 8, WGM = 8;

__host__ __device__ __forceinline__ int lds_byte(int r, int c) { const int st = (r >> 4) * 2 + (c >> 5), rr = r & 15, cc = c & 31, ob = rr * 64 + cc * 2; return st * 1024 + (ob ^ (((ob >> 9) & 1) << 5)); }
__host__ __device__ __forceinline__ void stage_rc(int b, int& R, int& C) { const int st = b / 1024, sb = b % 1024, swz = sb ^ (((sb >> 9) & 1) << 5); R = (st >> 1) * 16 + swz / 64; C = (st & 1) * 32 + (swz % 64) / 2; }
__host__ __device__ __forceinline__ int perm32(int rho) { const int n = rho >> 4, i = rho & 15; return 8 * (i >> 2) + 4 * n + (i & 3); }

struct Unit { const char* a; const char* b; int row0, pn, e; };

struct DenseOrder {
    const char* A; const char* Bt; int K, nM, nN, nwg, G, c;
    static constexpr bool GATHER = false;
    __device__ __forceinline__ void init(const void* A_, const void* Bt_, int M, int N, int K_, int G_, int c_) { A = (const char*)A_; Bt = (const char*)Bt_; K = K_; nM = M / BM; nN = N / BM; nwg = nM * nN; G = G_; c = c_; }
    __device__ __forceinline__ bool next(int i, Unit& u) const {
        const long L = (long)i * G + c; if (L >= nwg) return false;
        int wgid = (int)L; { const int q = nwg / NXCD, r = nwg % NXCD, xcd = wgid % NXCD, off = wgid / NXCD; wgid = (xcd < r ? xcd * (q + 1) : r * (q + 1) + (xcd - r) * q) + off; }
        const int nig = WGM * nN, gid = wgid / nig, fm = gid * WGM, gsz = (nM - fm) < WGM ? (nM - fm) : WGM;
        const int pm = fm + ((wgid % nig) % gsz); int pn = (wgid % nig) / gsz;
#ifdef MK_REV_PN
        if (nN == 20) pn = 19 - pn;
#endif
        u.a = A + (size_t)pm * BM * K * 2; u.b = Bt + (size_t)pn * BM * K * 2; u.row0 = pm * BM; u.pn = pn; u.e = 0; return true;
    }
};

template <class Epi, class Sched, bool ALIGN_EPI>
__device__ __forceinline__ void gemm_phase(PG8_LAS unsigned char* lds, const int K, const Sched& S, const Epi& E, const int wid) {
    const int lane = lane_id(), tid = wid * 64 + lane, wr = wid >> 2, wc = wid & 3, fr = lane & 15, fq = lane >> 4;
    const int nt = K / BK;
    constexpr int NVA = Sched::GATHER ? 2 : 1;
    unsigned voffA[NVA][2], voffB[2];
#pragma unroll
    for (int i = 0; i < 2; ++i) { int R, C; stage_rc(tid * 16 + i * 8192, R, C); const int Rb = Epi::PERM ? ((R & ~31) + perm32(R & 31)) : R;
        voffB[i] = (unsigned)(Rb * K + C) * 2u; if constexpr (!Sched::GATHER) voffA[0][i] = (unsigned)(R * K + C) * 2u; }
    const size_t kstep = (size_t)(BK * 2);
    const size_t hstep = (size_t)HALF * K * 2;
    const size_t hstepA = Sched::GATHER ? 0 : hstep;
    const unsigned ldsw = (unsigned)wid * 1024u;
    const int aoff = lds_byte(wr * 64 + fr, fq * 8), boff = lds_byte(wc * 32 + fr, fq * 8);
#define PG8_SA(b, h) (((b) * 2 + (h)) * HTB)
#define PG8_SB(b, h) ((4 + (b) * 2 + (h)) * HTB)
#define PG8_STAGE(bufoff, gbase, voff) do { _Pragma("unroll") for (int _i = 0; _i < 2; ++_i) \
        __builtin_amdgcn_global_load_lds((const unsigned*)((const char*)(gbase) + (voff)[_i]), (PG8_LAS unsigned*)(lds + (bufoff) + ldsw + _i * 8192), 16, 0, 0); } while (0)
#define PG8_LDA(dst, b, h) do { _Pragma("unroll") for (int m = 0; m < 4; ++m) _Pragma("unroll") for (int k = 0; k < 2; ++k) dst[m][k] = *(const PG8_LAS bf16x8*)(lds + PG8_SA(b, h) + aoff + m * 2048 + k * 1024); } while (0)
#define PG8_LDB(dst, b, h) do { _Pragma("unroll") for (int n = 0; n < 2; ++n) _Pragma("unroll") for (int k = 0; k < 2; ++k) dst[n][k] = *(const PG8_LAS bf16x8*)(lds + PG8_SB(b, h) + boff + n * 2048 + k * 1024); } while (0)
#define PG8_MMA(ai, bj, At, Bt) do { __builtin_amdgcn_s_setprio(1); _Pragma("unroll") for (int m = 0; m < 4; ++m) _Pragma("unroll") for (int n = 0; n < 2; ++n) _Pragma("unroll") for (int k = 0; k < 2; ++k) \
        acc[ai][bj][m][n] = __builtin_amdgcn_mfma_f32_16x16x32_bf16(Bt[n][k], At[m][k], acc[ai][bj][m][n], 0, 0, 0); __builtin_amdgcn_s_setprio(0); } while (0)
#ifdef MK_DRAIN
#define PG8_WAIT_V(n) asm volatile("s_waitcnt vmcnt(0)" ::: "memory")
#else
#define PG8_WAIT_V(n) asm volatile("s_waitcnt vmcnt(" #n ")" ::: "memory")
#endif
#define PG8_WAIT_L(n) asm volatile("s_waitcnt lgkmcnt(" #n ")" ::: "memory")
#define PG8_BAR __builtin_amdgcn_s_barrier()
#define PG8_SCHED __builtin_amdgcn_sched_barrier(0)
    Unit cur, nxt; int ui = 0;
    if (!S.next(0, cur)) return;
    if constexpr (Sched::GATHER) S.aoff(cur, tid, voffA);
    f32x4 acc[2][2][4][2];
#pragma unroll
    for (int a = 0; a < 2; ++a)
#pragma unroll
        for (int b = 0; b < 2; ++b)
#pragma unroll
            for (int m = 0; m < 4; ++m)
#pragma unroll
                for (int n = 0; n < 2; ++n) acc[a][b][m][n] = (f32x4){0.f, 0.f, 0.f, 0.f};
    bf16x8 At[4][2], B0[2][2], B1[2][2];
    PG8_STAGE(PG8_SB(0, 0), cur.b, voffB); PG8_STAGE(PG8_SB(0, 1), cur.b + hstep, voffB); PG8_STAGE(PG8_SA(0, 0), cur.a, voffA[0]); PG8_STAGE(PG8_SA(0, 1), cur.a + hstepA, voffA[NVA - 1]);
    if (wr == 1) PG8_BAR;
    PG8_WAIT_V(2); PG8_BAR;
    PG8_STAGE(PG8_SB(1, 0), cur.b + kstep, voffB); PG8_STAGE(PG8_SA(1, 0), cur.a + kstep, voffA[0]); PG8_STAGE(PG8_SB(1, 1), cur.b + hstep + kstep, voffB);
    PG8_WAIT_V(6); PG8_BAR;
    for (;;) {
        const bool has_next = S.next(ui + 1, nxt);
        const char* nA = has_next ? nxt.a : cur.a; const char* nB = has_next ? nxt.b : cur.b;
#pragma nounroll
        for (int t = 0; t < nt; t += 2) {
            const bool last = (t == nt - 2);
            const char* a1 = cur.a + (size_t)(t + 1) * kstep;
            const char* a2 = last ? nA : cur.a + (size_t)(t + 2) * kstep; const char* b2 = last ? nB : cur.b + (size_t)(t + 2) * kstep;
            const char* a3 = a2 + kstep; const char* b3 = b2 + kstep;
            PG8_LDB(B0, 0, 0); PG8_LDB(B1, 0, 1); PG8_SCHED; PG8_LDA(At, 0, 0); PG8_STAGE(PG8_SA(1, 1), a1 + hstepA, voffA[NVA - 1]);
            if constexpr (Sched::GATHER) { if (last && has_next) S.aoff(nxt, tid, voffA); }
            PG8_WAIT_V(8); PG8_WAIT_L(0); PG8_BAR; PG8_MMA(0, 0, At, B0); PG8_MMA(0, 1, At, B1); PG8_BAR; PG8_SCHED;
            PG8_LDA(At, 0, 1); PG8_STAGE(PG8_SB(0, 0), b2, voffB); PG8_STAGE(PG8_SB(0, 1), b2 + hstep, voffB); PG8_STAGE(PG8_SA(0, 0), a2, voffA[0]);
            PG8_WAIT_V(8); PG8_WAIT_L(0); PG8_BAR; PG8_MMA(1, 0, At, B0); PG8_MMA(1, 1, At, B1); PG8_BAR; PG8_SCHED;
            PG8_LDB(B0, 1, 0); PG8_LDB(B1, 1, 1); PG8_SCHED; PG8_LDA(At, 1, 0); PG8_STAGE(PG8_SA(0, 1), a2 + hstepA, voffA[NVA - 1]);
            PG8_WAIT_V(8); PG8_WAIT_L(0); PG8_BAR; PG8_MMA(0, 0, At, B0); PG8_MMA(0, 1, At, B1); PG8_BAR; PG8_SCHED;
            PG8_LDA(At, 1, 1); PG8_STAGE(PG8_SB(1, 0), b3, voffB); PG8_STAGE(PG8_SB(1, 1), b3 + hstep, voffB); PG8_STAGE(PG8_SA(1, 0), a3, voffA[0]);
            PG8_WAIT_V(8); PG8_WAIT_L(0); PG8_BAR; PG8_MMA(1, 0, At, B0); PG8_MMA(1, 1, At, B1); PG8_BAR; PG8_SCHED;
        }
        if constexpr (ALIGN_EPI) { if (wr == 0) PG8_BAR; }
        E(acc, cur, wr, wc, fr, fq);
        if (!has_next) break;
#pragma unroll
        for (int a = 0; a < 2; ++a)
#pragma unroll
            for (int b = 0; b < 2; ++b)
#pragma unroll
                for (int m = 0; m < 4; ++m)
#pragma unroll
                    for (int n = 0; n < 2; ++n) acc[a][b][m][n] = (f32x4){0.f, 0.f, 0.f, 0.f};
        cur = nxt; ++ui;
        if constexpr (ALIGN_EPI) { if (wr == 1) PG8_BAR; }
    }
    PG8_WAIT_V(0);
    if constexpr (!ALIGN_EPI) { if (wr == 0) PG8_BAR; }
    PG8_BAR;
#undef PG8_SA
#undef PG8_SB
#undef PG8_STAGE
#undef PG8_LDA
#undef PG8_LDB
#undef PG8_MMA
#undef PG8_WAIT_V
#undef PG8_WAIT_L
#undef PG8_BAR
#undef PG8_SCHED
}
}

namespace attn_body {
using bf16=__hip_bfloat16;
using bf16x8=__attribute__((ext_vector_type(8)))short;
using s16x4=__attribute__((ext_vector_type(4)))short;
using f32x16=__attribute__((ext_vector_type(16)))float;
using u32x4=__attribute__((ext_vector_type(4)))unsigned;
constexpr int BATCH=8,NHEAD=8,SEQ=4096,D=64,DM=NHEAD*D;
constexpr int NW=8,QBLK=32,QB=QBLK*NW,KVBLK=64,NQB=SEQ/QB;
__device__ __forceinline__ int crow(int r,int hi){return (r&3)+8*(r>>2)+4*hi;}
#define SBAR() __builtin_amdgcn_sched_barrier(0)
__device__ __forceinline__ void cmask(f32x16&p0,f32x16&p1,int qe,int hi){
  const float NEG=-INFINITY; int kb=4*hi;
  #pragma unroll
  for(int r=0;r<16;++r){int kv=kb+(r&3)+8*(r>>2); if(kv>qe)p0[r]=NEG; if(kv+32>qe)p1[r]=NEG;}
}
__device__ __forceinline__ void bmask(f32x16&p0,f32x16&p1,bool keep,float mhat){
  float pen=keep?-mhat:-INFINITY; asm volatile("":"+v"(pen));
  #pragma unroll
  for(int r=0;r<16;++r){p0[r]+=pen; p1[r]+=pen;}
}

constexpr int NSLOT=3, SLOTB=8192;
constexpr int LDS_K=0, LDS_V=NSLOT*SLOTB, LDS_WS=2*NSLOT*SLOTB, LDS_OST=LDS_WS+NW*64*4, LDS_BYTES=LDS_OST+NW*4096;
constexpr float C2=0.125f*1.4426950408889634f;
__device__ __forceinline__ void glds16(const void*gsrc,unsigned lds_dst){unsigned keep;
  asm volatile("s_mov_b32 %0, m0\n\ts_mov_b32 m0, %2\n\ts_nop 0\n\tglobal_load_lds_dwordx4 %1, off\n\ts_mov_b32 m0, %0":"=&s"(keep):"v"(gsrc),"s"(lds_dst):"memory");}
__device__ __forceinline__ float max3f(float a,float b,float c){float r;asm("v_max3_f32 %0, %1, %2, %3":"=v"(r):"v"(a),"v"(b),"v"(c));return r;}
__device__ __forceinline__ float max2f(float a,float b){float r;asm("v_max_f32_e32 %0, %1, %2":"=v"(r):"v"(a),"v"(b));return r;}
__device__ __forceinline__ float fadd_s(float a,float b){float r;asm("v_add_f32_e32 %0, %1, %2":"=v"(r):"v"(a),"v"(b));return r;}
__device__ __forceinline__ float fsub_s(float a,float b){float r;asm("v_sub_f32_e32 %0, %1, %2":"=v"(r):"v"(a),"v"(b));return r;}
typedef float f32x2_t __attribute__((ext_vector_type(2))); typedef __bf16 bf16x2_t __attribute__((ext_vector_type(2)));
__device__ __forceinline__ unsigned cvtpk_s(float lo,float hi){f32x2_t v={lo,hi};bf16x2_t b=__builtin_convertvector(v,bf16x2_t);return __builtin_bit_cast(unsigned,b);}
#define WAIT_BAR(N) asm volatile("s_waitcnt vmcnt(" #N ") lgkmcnt(0)\n\ts_barrier":::"memory")

__device__ __forceinline__ void qkt(f32x16&p0,f32x16&p1,const char*Kslot,const bf16x8*qr,int r32,int hi){
  const char*kb=Kslot+hi*1024+r32*16;
  #pragma unroll
  for(int d0=0;d0<4;++d0){
    const bf16x8 b0=*reinterpret_cast<const bf16x8*>(kb+d0*2048);
    const bf16x8 b1=*reinterpret_cast<const bf16x8*>(kb+d0*2048+512);
    if(d0==0){p0=__builtin_amdgcn_mfma_f32_32x32x16_bf16(b0,qr[0],f32x16{},0,0,0);p1=__builtin_amdgcn_mfma_f32_32x32x16_bf16(b1,qr[0],f32x16{},0,0,0);}
    else{p0=__builtin_amdgcn_mfma_f32_32x32x16_bf16(b0,qr[d0],p0,0,0,0);p1=__builtin_amdgcn_mfma_f32_32x32x16_bf16(b1,qr[d0],p1,0,0,0);}}
}
typedef __attribute__((address_space(3))) const char* lds_cptr;
typedef short v4i16_t __attribute__((ext_vector_type(4)));
__device__ __forceinline__ void kload8(bf16x8*kf,lds_cptr kp){
  kf[0]=*(const __attribute__((address_space(3))) bf16x8*)(kp);      kf[1]=*(const __attribute__((address_space(3))) bf16x8*)(kp+512);
  kf[2]=*(const __attribute__((address_space(3))) bf16x8*)(kp+2048); kf[3]=*(const __attribute__((address_space(3))) bf16x8*)(kp+2560);
  kf[4]=*(const __attribute__((address_space(3))) bf16x8*)(kp+4096); kf[5]=*(const __attribute__((address_space(3))) bf16x8*)(kp+4608);
  kf[6]=*(const __attribute__((address_space(3))) bf16x8*)(kp+6144); kf[7]=*(const __attribute__((address_space(3))) bf16x8*)(kp+6656);
}
__device__ __forceinline__ void kload2(bf16x8*kf,lds_cptr kp,int j){ kf[2*j]=*(const __attribute__((address_space(3))) bf16x8*)(kp+j*2048); kf[2*j+1]=*(const __attribute__((address_space(3))) bf16x8*)(kp+j*2048+512); }
__device__ __forceinline__ s16x4 vtr(lds_cptr p){ return __builtin_bit_cast(s16x4,__builtin_amdgcn_ds_read_tr16_b64_v4i16((__attribute__((address_space(3))) v4i16_t*)p)); }
__device__ __forceinline__ float rowmax(const f32x16&p0,const f32x16&p1){
  float a=max3f(p0[0],p0[1],p1[0]),b=max3f(p0[2],p0[3],p1[1]);a=max3f(a,p1[2],p1[3]);
  #pragma unroll
  for(int r=4;r<16;r+=4){a=max3f(a,p0[r],p0[r+1]);b=max3f(b,p0[r+2],p0[r+3]);a=max3f(a,p1[r],p1[r+1]);b=max3f(b,p1[r+2],p1[r+3]);}
  const float m=max2f(a,b);
  auto rr=__builtin_amdgcn_permlane32_swap(__float_as_uint(m),__float_as_uint(m),false,false);
  return max2f(__uint_as_float(rr[0]),__uint_as_float(rr[1]));
}
__device__ __forceinline__ void pv(f32x16*o,int vb,bf16x8 pa0,bf16x8 pa1,bf16x8 pa2,bf16x8 pa3){
  #pragma unroll
  for(int d0=0;d0<2;++d0){s16x4 lo[4],hi[4];
    #pragma unroll
    for(int ks=0;ks<4;++ks){
      asm volatile("ds_read_b64_tr_b16 %0,%1 offset:%c2":"=&v"(lo[ks]):"v"(vb),"i"(d0*4096+ks*1024):"memory");
      asm volatile("ds_read_b64_tr_b16 %0,%1 offset:%c2":"=&v"(hi[ks]):"v"(vb),"i"(d0*4096+ks*1024+512):"memory");}
    asm volatile("s_waitcnt lgkmcnt(0)":::"memory");SBAR();
    #define PK(k) (bf16x8){lo[k][0],lo[k][1],lo[k][2],lo[k][3],hi[k][0],hi[k][1],hi[k][2],hi[k][3]}
    o[d0]=__builtin_amdgcn_mfma_f32_32x32x16_bf16(pa0,PK(0),o[d0],0,0,0);
    o[d0]=__builtin_amdgcn_mfma_f32_32x32x16_bf16(pa1,PK(1),o[d0],0,0,0);
    o[d0]=__builtin_amdgcn_mfma_f32_32x32x16_bf16(pa2,PK(2),o[d0],0,0,0);
    o[d0]=__builtin_amdgcn_mfma_f32_32x32x16_bf16(pa3,PK(3),o[d0],0,0,0);
    #undef PK
  }
}

#define ATTN_STORE16(p,v) (*(u32x4*)(p)=(v))
template<int THRL> __device__ __forceinline__ void attn_unit(int b,int h,int qb,const bf16*Q,const bf16*__restrict__ K,const bf16*__restrict__ V,bf16*O,const unsigned*SEL,char*shm,const int wid_){
  const int lane=lane_id(),r32=lane&31,hi=lane>>5; const int wid=wid_;
  const long rowbase=(long)b*SEQ; const int q0=qb*QB;
  const bf16*Qw=Q+(rowbase+q0+wid*QBLK)*DM+h*D;
  const bf16*Kh=K+rowbase*DM+h*D,*Vh=V+rowbase*DM+h*D;
  const unsigned lds0=(unsigned)(uintptr_t)shm;
  float*wsf=(float*)(shm+LDS_WS)+wid*64;
  const unsigned selm=SEL[((long)(b*NHEAD+h))*SEQ+q0+wid*QBLK+r32];
  const bf16*ksrc=Kh+(long)lane*DM+wid*8;
  const bf16*vsrc=Vh+(long)(16*(wid&3)+(lane>>2))*DM+(wid>>2)*32+(lane&3)*8;
  const unsigned kdst=lds0+LDS_K+wid*1024, vdst=lds0+LDS_V+wid*1024;
  #define DMA_K(t,slot) glds16(ksrc+(long)(t)*KVBLK*DM,(unsigned)__builtin_amdgcn_readfirstlane(kdst+(slot)))
  #define DMA_V(t,slot) glds16(vsrc+(long)(t)*KVBLK*DM,(unsigned)__builtin_amdgcn_readfirstlane(vdst+(slot)))
  const int vb0=(int)(lds0+LDS_V)+((lane>>4)&1)*32+(lane&3)*8+(4*hi+((lane&15)>>2))*64;
  const char*Kbase=shm+LDS_K; bf16x8 kf[8];
  const lds_cptr shm3=(lds_cptr)shm; const lds_cptr kp0=shm3+LDS_K+hi*1024+r32*16; const lds_cptr vp0=shm3+LDS_V+((lane>>4)&1)*32+(lane&3)*8+(4*hi+((lane&15)>>2))*64;
  const int NT=(q0+QB)/KVBLK;
  DMA_K(0,0);DMA_V(0,0);DMA_K(1,SLOTB);
  bf16x8 qr[4];
  #pragma unroll
  for(int d0=0;d0<4;++d0)qr[d0]=*reinterpret_cast<const bf16x8*>(&Qw[(long)r32*DM+d0*16+hi*8]);
  float mhat=0.f,l_reg=0.f;f32x16 o[2];o[0]=f32x16{};o[1]=f32x16{};
  const int qrel=wid*QBLK+r32;
  #define CMASK(P0,P1,t) do{const int jb_=(t)-(NT-4); if(jb_>=0){cmask(P0,P1,qrel-64*jb_,hi); bmask(P0,P1,true,mhat);} else bmask(P0,P1,((selm>>((t)>>2))&1u)!=0u,mhat);}while(0)
  bool resc=false;
  #define START(P0,P1) do{ const float rm=rowmax(P0,P1); resc=false; \
    { const float dl=__builtin_fmaxf(rm,-60.f); mhat=fadd_s(mhat,dl); \
      _Pragma("unroll") for(int r=0;r<16;++r){P0[r]=fsub_s(P0[r],dl);P1[r]=fsub_s(P1[r],dl);} } \
    _Pragma("unroll") for(int r=0;r<16;++r)P0[r]=__builtin_amdgcn_exp2f(P0[r]); }while(0)
  #define RESC() do{ if(resc){ asm volatile("s_waitcnt lgkmcnt(0)":::"memory"); \
      _Pragma("unroll") for(int d_=0;d_<2;++d_) _Pragma("unroll") for(int r=0;r<16;++r)o[d_][r]*=wsf[crow(r,hi)]; } }while(0)
  f32x16 pA0,pA1,pB0,pB1;
  int sl_prev=0,sl_cur=0,sl_next=SLOTB;
  #define ROT() do{sl_prev=sl_cur;sl_cur=sl_next;sl_next=(sl_next==(NSLOT-1)*SLOTB)?0:sl_next+SLOTB;}while(0)
  DMA_K(2,2*SLOTB);
  WAIT_BAR(3);
  qkt(pA0,pA1,Kbase,qr,r32,hi);asm volatile("s_nop 15\n\ts_nop 7":"+v"(pA0),"+v"(pA1));CMASK(pA0,pA1,0);
  START(pA0,pA1);
  _Pragma("unroll") for(int r=0;r<16;++r)pA1[r]=__builtin_amdgcn_exp2f(pA1[r]);
  WAIT_BAR(0);
  DMA_K(3,0);DMA_V(1,SLOTB);
  ROT();
  kload8(kf,kp0+sl_cur);
  WAIT_BAR(2);
  s16x4 vlo[8],vhi[8]; u32x4 pw0,pw1,pw2,pw3;
  #define PKW(P,B) cvtpk_s(P[B],P[B+1])
  #define PAF(k) __builtin_bit_cast(bf16x8,pw##k)
  #define VFR(i) (bf16x8){vlo[i][0],vlo[i][1],vlo[i][2],vlo[i][3],vhi[i][0],vhi[i][1],vhi[i][2],vhi[i][3]}
  #define PIN(x) asm volatile("":"+v"(x))
  #define MX3(a,b,c) __builtin_fmaxf(__builtin_fmaxf((a),(b)),(c))
  #define GAPA(MF,A0,A1,A2,A3,W0,W1,PW) do{ MF; sacc+=A0; sacc+=A1; sacc+=A2; sacc+=A3; PIN(sacc); W0; W1; PIN(PW); SBAR(); }while(0)
  #define EX(v) __builtin_amdgcn_exp2f(v)
  #define GAPB(MF,X,B) do{ MF; X[B]=EX(X[B]); X[B+1]=EX(X[B+1]); X[B+2]=EX(X[B+2]); X[B+3]=EX(X[B+3]); PIN(X); SBAR(); }while(0)
  #define VRD(i) do{ vlo[i]=vtr(vp_+(((i)>>2)*4096+((i)&3)*1024)); vhi[i]=vtr(vp_+(((i)>>2)*4096+((i)&3)*1024+512)); }while(0)
  #define KRD(G,j) do{ if(G){ kload2(kf,kp0+sl_next,j); SBAR(); } }while(0)
  #define STEP(C0,C1,P0,P1,t,GK,GV,GL) do{ SBAR(); \
    const lds_cptr vp_=vp0+sl_prev; \
    VRD(0); SBAR(); float sacc=(P0[0]+P0[1]); \
    GAPA(C0=__builtin_amdgcn_mfma_f32_32x32x16_bf16(kf[0],qr[0],f32x16{},0,0,0), P0[2],P0[3],P0[4],P0[5],     pw0[0]=PKW(P0,0), pw0[1]=PKW(P0,2), pw0); \
    VRD(4); SBAR(); GAPA(C1=__builtin_amdgcn_mfma_f32_32x32x16_bf16(kf[1],qr[0],f32x16{},0,0,0), P0[6],P0[7],P0[8],P0[9],     pw0[2]=PKW(P0,4), pw0[3]=PKW(P0,6), pw0); \
    VRD(1); SBAR(); GAPA(C0=__builtin_amdgcn_mfma_f32_32x32x16_bf16(kf[2],qr[1],C0,0,0,0),   P0[10],P0[11],P0[12],P0[13], pw1[0]=PKW(P0,8), pw1[1]=PKW(P0,10), pw1); \
    VRD(5); SBAR(); GAPA(C1=__builtin_amdgcn_mfma_f32_32x32x16_bf16(kf[3],qr[1],C1,0,0,0),   P0[14],P0[15],P1[0],P1[1],   pw1[2]=PKW(P0,12),pw1[3]=PKW(P0,14), pw1); \
    VRD(2); SBAR(); GAPA(C0=__builtin_amdgcn_mfma_f32_32x32x16_bf16(kf[4],qr[2],C0,0,0,0),   P1[2],P1[3],P1[4],P1[5],     pw2[0]=PKW(P1,0), pw2[1]=PKW(P1,2), pw2); \
    VRD(6); SBAR(); GAPA(C1=__builtin_amdgcn_mfma_f32_32x32x16_bf16(kf[5],qr[2],C1,0,0,0),   P1[6],P1[7],P1[8],P1[9],     pw2[2]=PKW(P1,4), pw2[3]=PKW(P1,6), pw2); \
    VRD(3); SBAR(); GAPA(C0=__builtin_amdgcn_mfma_f32_32x32x16_bf16(kf[6],qr[3],C0,0,0,0),   P1[10],P1[11],P1[12],P1[13], pw3[0]=PKW(P1,8), pw3[1]=PKW(P1,10), pw3); \
    VRD(7); SBAR(); GAPA(C1=__builtin_amdgcn_mfma_f32_32x32x16_bf16(kf[7],qr[3],C1,0,0,0),   P1[14],P1[15],0.f,0.f,       pw3[2]=PKW(P1,12),pw3[3]=PKW(P1,14), pw3); \
    l_reg+=sacc; \
    if(GK){DMA_K((t)+3,sl_cur);} if(GV){DMA_V((t)+1,sl_next);} \
    CMASK(C0,C1,t); \
    { float a=MX3(C0[0],C0[1],C1[0]),b=MX3(C0[2],C0[3],C1[1]); a=MX3(a,C1[2],C1[3]); \
      _Pragma("unroll") for(int r=4;r<16;r+=4){a=MX3(a,C0[r],C0[r+1]);b=MX3(b,C0[r+2],C0[r+3]);a=MX3(a,C1[r],C1[r+1]);b=MX3(b,C1[r+2],C1[r+3]);} \
      float rm=__builtin_fmaxf(a,b); { auto rr=__builtin_amdgcn_permlane32_swap(__float_as_uint(rm),__float_as_uint(rm),false,false); rm=__builtin_fmaxf(__uint_as_float(rr[0]),__uint_as_float(rr[1])); } \
      resc=false; \
      if(__builtin_expect(__any(rm>(float)THRL),0)){ const float dl=__builtin_fmaxf(rm,0.f); mhat+=dl; \
        _Pragma("unroll") for(int r=0;r<16;++r){C0[r]-=dl;C1[r]-=dl;} \
        const float f=__builtin_amdgcn_exp2f(-dl); l_reg*=f; if(hi==0)wsf[r32]=f; resc=true; } } \
    SBAR(); \
    GAPB(o[0]=__builtin_amdgcn_mfma_f32_32x32x16_bf16(PAF(0),VFR(0),o[0],0,0,0), C0,0); \
    GAPB(o[1]=__builtin_amdgcn_mfma_f32_32x32x16_bf16(PAF(0),VFR(4),o[1],0,0,0), C0,4); \
    KRD(GL,0); GAPB(o[0]=__builtin_amdgcn_mfma_f32_32x32x16_bf16(PAF(1),VFR(1),o[0],0,0,0), C0,8); \
    KRD(GL,1); GAPB(o[1]=__builtin_amdgcn_mfma_f32_32x32x16_bf16(PAF(1),VFR(5),o[1],0,0,0), C0,12); \
    KRD(GL,2); GAPB(o[0]=__builtin_amdgcn_mfma_f32_32x32x16_bf16(PAF(2),VFR(2),o[0],0,0,0), C1,0); \
    KRD(GL,3); GAPB(o[1]=__builtin_amdgcn_mfma_f32_32x32x16_bf16(PAF(2),VFR(6),o[1],0,0,0), C1,4); \
    GAPB(o[0]=__builtin_amdgcn_mfma_f32_32x32x16_bf16(PAF(3),VFR(3),o[0],0,0,0), C1,8); \
    GAPB(o[1]=__builtin_amdgcn_mfma_f32_32x32x16_bf16(PAF(3),VFR(7),o[1],0,0,0), C1,12); \
    }while(0)
  int t=1;
  #undef CMASK
  #define CMASK(P0,P1,t) bmask(P0,P1,((selm>>((t)>>2))&1u)!=0u,mhat)
  for(;t+5<NT;t+=2){
    STEP(pB0,pB1,pA0,pA1,t,true,true,true);     WAIT_BAR(2); RESC(); ROT();
    STEP(pA0,pA1,pB0,pB1,t+1,true,true,true);   WAIT_BAR(2); RESC(); ROT();
  }
  #undef CMASK
  #define CMASK(P0,P1,t) do{const int jb_=(t)-(NT-4); if(jb_>=0){cmask(P0,P1,qrel-64*jb_,hi); bmask(P0,P1,true,mhat);} else bmask(P0,P1,((selm>>((t)>>2))&1u)!=0u,mhat);}while(0)
  #define ENDW(tt) do{ if((tt)+3<NT){WAIT_BAR(2);} else if((tt)+2<NT){WAIT_BAR(1);} else {WAIT_BAR(0);} }while(0)
  for(;t+1<NT;t+=2){
    STEP(pB0,pB1,pA0,pA1,t,(t+3<NT),(t+1<NT),(t+1<NT));       ENDW(t);   RESC(); ROT();
    STEP(pA0,pA1,pB0,pB1,t+1,(t+4<NT),(t+2<NT),(t+2<NT));     ENDW(t+1); RESC(); ROT();
  }
  STEP(pB0,pB1,pA0,pA1,NT-1,false,false,false); RESC();
  { float sacc=pB0[0]+pB0[1]; _Pragma("unroll") for(int r=2;r<16;++r)sacc+=pB0[r]; _Pragma("unroll") for(int r=0;r<16;++r)sacc+=pB1[r]; l_reg+=sacc;
    pw0=(u32x4){PKW(pB0,0),PKW(pB0,2),PKW(pB0,4),PKW(pB0,6)};pw1=(u32x4){PKW(pB0,8),PKW(pB0,10),PKW(pB0,12),PKW(pB0,14)};pw2=(u32x4){PKW(pB1,0),PKW(pB1,2),PKW(pB1,4),PKW(pB1,6)};pw3=(u32x4){PKW(pB1,8),PKW(pB1,10),PKW(pB1,12),PKW(pB1,14)};
    SBAR(); pv(o,vb0+sl_cur,PAF(0),PAF(1),PAF(2),PAF(3)); }
  #undef PKW
  #undef PAF
  #undef VFR
  #undef PIN
  #undef MX3
  #undef GAPA
  #undef GAPB
  #undef EX
  #undef VRD
  #undef KRD
  #undef STEP
  #undef ENDW
  {auto rr=__builtin_amdgcn_permlane32_swap(__float_as_uint(l_reg),__float_as_uint(l_reg),false,false);l_reg=__uint_as_float(rr[0])+__uint_as_float(rr[1]);}
  if(hi==0)wsf[32+r32]=l_reg;asm volatile("s_waitcnt lgkmcnt(0)":::"memory");
  float rli[16];
  #pragma unroll
  for(int r=0;r<16;++r)rli[r]=__builtin_amdgcn_rcpf(wsf[32+crow(r,hi)]);
  bf16*Ow=O+(rowbase+q0+wid*QBLK)*DM+h*D;
  { bf16*stg=(bf16*)(shm+LDS_OST)+wid*2048;
    #pragma unroll
    for(int r=0;r<16;++r){const int orow=crow(r,hi);
      #pragma unroll
      for(int d0=0;d0<2;++d0)stg[orow*64+d0*32+r32]=__float2bfloat16(o[d0][r]*rli[r]);}
    asm volatile("s_waitcnt lgkmcnt(0)":::"memory");
    #pragma unroll
    for(int i=0;i<4;++i){const int row=i*8+(lane>>3),ch=lane&7; const u32x4 v=*(const u32x4*)(stg+row*64+ch*8); ATTN_STORE16(Ow+(long)row*DM+ch*8,v);} }
  asm volatile("s_waitcnt lgkmcnt(0)\n\ts_barrier":::"memory");
  #undef DMA_K
  #undef DMA_V
  #undef CMASK
  #undef START
  #undef RESC
  #undef ROT
}
constexpr int ATTN_LDS_BYTES=LDS_BYTES;
#undef SBAR
#undef WAIT_BAR
}

constexpr int NWAVES = 8;
constexpr int NPH = 15;
constexpr int N_LAUNCHES = MK_N_LAUNCHES;
static_assert(N_LAUNCHES == 1 || N_LAUNCHES == NPH, "MK_N_LAUNCHES is 1 or NPH");

constexpr size_t MiB = 1u << 20;
constexpr size_t WS_CTL = 0, CTL_ZERO_BYTES = 2 * MiB;
constexpr size_t WS_KMEAN = 1 * MiB;
constexpr size_t WS_GCOUNT = 1 * MiB + 512 * 1024;
constexpr size_t WS_WIN = 2 * MiB;
constexpr size_t WS_WAO = 12 * MiB, WS_WCO = 13 * MiB, WS_WOUT = 14 * MiB;
constexpr size_t WS_WSR = 16 * MiB;
constexpr size_t WS_WSD = 18 * MiB;
constexpr size_t WS_WPG = 19 * MiB, WS_WPP = 21 * MiB;
constexpr size_t WS_ROPE = 22 * MiB;
constexpr size_t WS_SEL = 22 * MiB + 512 * 1024;
constexpr size_t WS_PB = 24 * MiB;
constexpr size_t WS_TOPI = 40 * MiB, WS_TOPW = 41 * MiB, WS_LRANK = 42 * MiB;
constexpr size_t WS_ROWTOK = 43 * MiB, WS_ROWDST = 44 * MiB + 512 * 1024, WS_ROWW = 46 * MiB, WS_WGBASE = 47 * MiB + 256 * 1024;
constexpr size_t WS_WD = 48 * MiB;
constexpr size_t WS_WGU = 176 * MiB;
constexpr size_t WS_YLO = 176 * MiB;
constexpr size_t WS_XB = 432 * MiB;
constexpr size_t WS_S6 = 496 * MiB;
constexpr size_t WS_H = 496 * MiB;
constexpr size_t WS_YHI = 656 * MiB;
constexpr size_t WS_G = 688 * MiB;
constexpr size_t WS_P1 = 816 * MiB;
constexpr size_t WS_LOGITS = 912 * MiB;
constexpr size_t WS_HS = 944 * MiB;
constexpr size_t WS_PP = 960 * MiB;
constexpr size_t WS_END = 1024 * MiB;
static_assert(WS_H + (size_t)RMAX_ * 256 * 2 <= WS_YHI && WS_YHI + (size_t)T_ * 4 * 1024 * 2 <= WS_LOGITS && WS_WGU + (size_t)NE_ * 512 * 1024 * 2 <= WS_XB, "ws map");
static_assert(WS_ROWTOK + (size_t)RMAX_ * 4 <= WS_ROWDST && WS_ROWDST + (size_t)RMAX_ * 4 <= WS_ROWW && WS_ROWW + (size_t)RMAX_ * 4 <= WS_WGBASE, "ws tables");
constexpr int CW_BAR = 4096;

constexpr int RING_OFF = 0, RING_BYTES = 131072;
constexpr int LDSCTL_OFF = RING_BYTES, MISC_OFF = LDSCTL_OFF + 320;
constexpr int LX_HIST = LDSCTL_OFF + 512;
constexpr int LX_PST = LX_HIST + 1024;
constexpr int LX_NB = LX_PST + 1040;
constexpr int LX_BLKE = LX_NB + 1024;
constexpr int LDS_BYTES = 147456;
static_assert(LX_BLKE + 2560 <= LDS_BYTES && attn_body::ATTN_LDS_BYTES <= RING_BYTES, "LDS map");

#define XB_TMO      128
#define XB_XCNT(j)  (256  + 64 * (j))
#define XB_XSUB(j)  (1280 + 64 * (j))
#define XB_XGEN(j)  (2304 + 64 * (j))
#define XB_TOP      3328
#define XB_TOPGEN   3392
#define XCD_BAR_WORDS 3456
#define XB_SPIN_CAP (1u << 18)

__device__ __forceinline__ unsigned xb_ld(unsigned* p)              { return __hip_atomic_load(p, __ATOMIC_RELAXED, __HIP_MEMORY_SCOPE_AGENT); }
__device__ __forceinline__ unsigned xb_add(unsigned* p, unsigned v) { return __hip_atomic_fetch_add(p, v, __ATOMIC_RELAXED, __HIP_MEMORY_SCOPE_AGENT); }
__device__ __forceinline__ unsigned xb_xcc_id() { return (unsigned)__builtin_amdgcn_s_getreg((3 << 11) | 20) & 0xFu; }
#define XB_SPIN(cond, bar) do { unsigned _sp = 0; while (cond) { __builtin_amdgcn_s_sleep(1); \
    if ((++_sp & 255u) == 0u) { if (xb_ld(&(bar)[XB_TMO])) break; if (_sp > XB_SPIN_CAP) { atomicAdd(&(bar)[XB_TMO], 1u); break; } } } } while (0)

struct XcdBarrier {
    unsigned* bar; unsigned x;
    volatile LAS unsigned* st;
};
__device__ __forceinline__ XcdBarrier xcd_barrier_post(unsigned* bar, volatile LAS unsigned* st, int wave) {
    XcdBarrier b; b.bar = bar; b.x = xb_xcc_id(); b.st = st;
    if (wave == 0 && lane_id() == 0) (void)xb_add(&bar[XB_XCNT(b.x)], 1u);
    return b;
}
__device__ __forceinline__ void xcd_barrier_complete(unsigned* bar, unsigned x, unsigned& nloc, unsigned& nx) {
    const unsigned G = gridDim.x * gridDim.y * gridDim.z;
    unsigned sum, cnt, mine, sp = 0u;
    for (;;) {
        sum = 0u; cnt = 0u; mine = 0u;
#pragma unroll
        for (unsigned j = 0; j < 16; ++j) { const unsigned c = xb_ld(&bar[XB_XCNT(j)]); sum += c; cnt += (c > 0u) ? 1u : 0u; mine = (j == x) ? c : mine; }
        if (sum == G) break;
        __builtin_amdgcn_s_sleep(1);
        if ((++sp & 255u) == 0u) { if (xb_ld(&bar[XB_TMO])) break; if (sp > XB_SPIN_CAP) { atomicAdd(&bar[XB_TMO], 1u); break; } }
    }
    nloc = mine > 0u ? mine : 1u; nx = cnt > 0u ? cnt : 1u;
}
__device__ __forceinline__ void xcd_barrier(const XcdBarrier& b, int wave) {
    asm volatile("s_waitcnt vmcnt(0)" ::: "memory");
    __syncthreads();
    if (wave == 0 && lane_id() == 0) {
        unsigned* bar = b.bar;
        __builtin_amdgcn_s_waitcnt(0);
        unsigned nloc = b.st[0], nx = b.st[1];
        if (nloc == 0u) { xcd_barrier_complete(bar, b.x, nloc, nx); b.st[0] = nloc; b.st[1] = nx; }
        const unsigned old = xb_add(&bar[XB_XSUB(b.x)], 1u);
        const unsigned gen = old / nloc;
        if (old + 1u == (gen + 1u) * nloc) {
            __builtin_amdgcn_fence(__ATOMIC_RELEASE, "agent");
            asm volatile("s_waitcnt vmcnt(0)" ::: "memory");
            const unsigned og = xb_add(&bar[XB_TOP], 1u);
            const unsigned tg = og / nx;
            if (og + 1u == (tg + 1u) * nx) xb_add(&bar[XB_TOPGEN], 1u);
            else XB_SPIN(xb_ld(&bar[XB_TOPGEN]) == tg, bar);
            __builtin_amdgcn_fence(__ATOMIC_ACQUIRE, "agent");
            xb_add(&bar[XB_XGEN(b.x)], 1u);
            asm volatile("s_waitcnt vmcnt(0)" ::: "memory");
        } else {
            XB_SPIN(xb_ld(&bar[XB_XGEN(b.x)]) == gen, bar);
            __builtin_amdgcn_fence(__ATOMIC_ACQUIRE, "agent");
            asm volatile("s_waitcnt vmcnt(0)" ::: "memory");
        }
    }
    __syncthreads();
}

struct Args { const float* in[23]; float* out; unsigned char* ws; int ph_lo, ph_hi, li, pad; };

struct Frame {
    LAS unsigned char* lds;
    volatile LAS unsigned* MISC;
    gu32* ctl;
    int wave;
    int vcu, G;
    unsigned char* ws; float* out;
};

__device__ __forceinline__ float wave_sum(float v) {
#pragma unroll
    for (int o = 1; o < 64; o <<= 1) v += __shfl_xor(v, o);
    return v;
}

__device__ __forceinline__ void xpose_item(const float* W, int N, int k0, int n0, bf16* dst, int Kd, LAS float* scr, int lane) {
#pragma unroll 8
    for (int i = 0; i < 32; ++i) { const int kk = 2 * i + (lane >> 5); scr[kk * 33 + (lane & 31)] = W[(size_t)(k0 + kk) * N + n0 + (lane & 31)]; }
    LDS_WAIT(); asm volatile("" ::: "memory");
    const int c = lane & 7;
#pragma unroll
    for (int j = 0; j < 4; ++j) { const int n = (lane >> 3) + 8 * j; const LAS float* s = scr + (8 * c) * 33 + n;
        v4u o; o.x = cvt_pk_bf16(s[0 * 33], s[1 * 33]); o.y = cvt_pk_bf16(s[2 * 33], s[3 * 33]); o.z = cvt_pk_bf16(s[4 * 33], s[5 * 33]); o.w = cvt_pk_bf16(s[6 * 33], s[7 * 33]);
        *(v4u*)(dst + (size_t)n * Kd + 8 * c) = o; }
    LDS_WAIT(); asm volatile("" ::: "memory");
}
__device__ __forceinline__ void xpose_mat(const float* W, int K, int N, bf16* WT, int rbase, int mode, int half, int r, LAS float* scr, int lane) {
    const int nblk = N / 32, kb = r / nblk, nb = r % nblk, k0 = 64 * kb, n0 = 32 * nb;
    const int drow = mode ? (rbase + (n0 >> 7) * 256 + half * 128 + (n0 & 127)) : (rbase + n0);
    xpose_item(W, N, k0, n0, WT + (size_t)drow * K + k0, K, scr, lane);
}
__device__ __forceinline__ void p0_prologue(Frame& F, const Args& A) {
    const int lane_ = lane_id(), tid_ = F.wave * 64 + lane_; (void)tid_;
    LAS float* scr = (LAS float*)(F.lds + RING_OFF + F.wave * 16384);
    unsigned char* ws = F.ws;
    const int gw = F.vcu * NWAVES + F.wave, NGW = F.G * NWAVES;
    constexpr int I_IN = 16 * 160, I_AO = 8 * 32, I_CO = 8 * 32, I_OUT = 16 * 32, I_R = 16 * 8, I_SG = 16 * 8, I_SU = 16 * 8, I_SD = 4 * 32, I_PG = 16 * 32, I_PP = 4 * 32;
    constexpr int NSMALL = I_IN + I_AO + I_CO + I_OUT + I_R + I_SG + I_SU + I_SD + I_PG + I_PP;
    for (int it = gw; it < NSMALL; it += NGW) {
        int r = it;
        if (r < I_IN) { xpose_mat(A.in[2], 1024, 5120, (bf16*)(ws + WS_WIN), 0, 0, 0, r, scr, lane_); continue; } r -= I_IN;
        if (r < I_AO) { xpose_mat(A.in[4], 512, 1024, (bf16*)(ws + WS_WAO), 0, 0, 0, r, scr, lane_); continue; } r -= I_AO;
        if (r < I_CO) { xpose_mat(A.in[5], 512, 1024, (bf16*)(ws + WS_WCO), 0, 0, 0, r, scr, lane_); continue; } r -= I_CO;
        if (r < I_OUT) { xpose_mat(A.in[6], 1024, 1024, (bf16*)(ws + WS_WOUT), 0, 0, 0, r, scr, lane_); continue; } r -= I_OUT;
        if (r < I_R) { xpose_mat(A.in[9], 1024, 256, (bf16*)(ws + WS_WSR), 512, 0, 0, r, scr, lane_); continue; } r -= I_R;
        if (r < I_SG) { xpose_mat(A.in[14], 1024, 256, (bf16*)(ws + WS_WSR), 0, 1, 0, r, scr, lane_); continue; } r -= I_SG;
        if (r < I_SU) { xpose_mat(A.in[15], 1024, 256, (bf16*)(ws + WS_WSR), 0, 1, 1, r, scr, lane_); continue; } r -= I_SU;
        if (r < I_SD) { xpose_mat(A.in[16], 256, 1024, (bf16*)(ws + WS_WSD), 0, 0, 0, r, scr, lane_); continue; } r -= I_SD;
        if (r < I_PG) { xpose_mat(A.in[19], 1024, 1024, (bf16*)(ws + WS_WPG), 0, 0, 0, r, scr, lane_); continue; } r -= I_PG;
        xpose_mat(A.in[20], 256, 1024, (bf16*)(ws + WS_WPP), 0, 0, 0, r, scr, lane_);
    }
    for (int it = gw; it < NE_ * 384; it += NGW) {
        const int e = it / 384; int r = it % 384;
        if (r < 128) { xpose_mat(A.in[11] + (size_t)e * 1024 * 256, 1024, 256, (bf16*)(ws + WS_WGU), e * 512, 1, 0, r, scr, lane_); continue; } r -= 128;
        if (r < 128) { xpose_mat(A.in[12] + (size_t)e * 1024 * 256, 1024, 256, (bf16*)(ws + WS_WGU), e * 512, 1, 1, r, scr, lane_); continue; } r -= 128;
        xpose_mat(A.in[13] + (size_t)e * 256 * 1024, 256, 1024, (bf16*)(ws + WS_WD), e * 1024, 0, 0, r, scr, lane_);
    }
    {
        const size_t gt = (size_t)F.vcu * 512 + tid_, NT = (size_t)F.G * 512;
#ifdef MK_FILL_G
        { v4u z; z.x = z.y = z.z = z.w = 0u; unsigned char* gp = ws + WS_G; for (size_t i = gt; i < (size_t)(128u << 20) / 16; i += NT) *(v4u*)(gp + i * 16) = z; }
#endif
        const float* x = A.in[0]; bf16* xb = (bf16*)(ws + WS_XB);
        for (size_t i = gt; i < (size_t)T_ * D_ / 8; i += NT) { const f32x4 a = *(const f32x4*)(x + i * 8), b = *(const f32x4*)(x + i * 8 + 4);
            v4u o; o.x = cvt_pk_bf16(a.x, a.y); o.y = cvt_pk_bf16(a.z, a.w); o.z = cvt_pk_bf16(b.x, b.y); o.w = cvt_pk_bf16(b.z, b.w); *(v4u*)(xb + i * 8) = o; }
        const float* p = A.in[1]; bf16* pb = (bf16*)(ws + WS_PB);
        for (size_t i = gt; i < (size_t)T_ * PLE_ / 8; i += NT) { const f32x4 a = *(const f32x4*)(p + i * 8), b = *(const f32x4*)(p + i * 8 + 4);
            v4u o; o.x = cvt_pk_bf16(a.x, a.y); o.y = cvt_pk_bf16(a.z, a.w); o.z = cvt_pk_bf16(b.x, b.y); o.w = cvt_pk_bf16(b.z, b.w); *(v4u*)(pb + i * 8) = o; }
        float* rope = (float*)(ws + WS_ROPE);
        for (size_t i = gt; i < (size_t)SEQ_ * 8; i += NT) {
            const int pos = (int)(i >> 3), fi = (int)(i & 7);
            const float invf = (float)exp(-(double)fi * 0.125 * log(500000.0));
            const float angf = (float)pos * invf;
            const double ang = (double)angf;
            const double kq = rint(ang * 0.63661977236758134308);
            const double rr = (ang - kq * 1.57079632679489655800) - kq * 6.12323399573676603587e-17;
            const double r2 = rr * rr;
            const double sn = rr * (1.0 + r2 * (-1.0 / 6 + r2 * (1.0 / 120 + r2 * (-1.0 / 5040 + r2 * (1.0 / 362880 + r2 * (-1.0 / 39916800 + r2 * (1.0 / 6227020800.0)))))));
            const double cs = 1.0 + r2 * (-0.5 + r2 * (1.0 / 24 + r2 * (-1.0 / 720 + r2 * (1.0 / 40320 + r2 * (-1.0 / 3628800 + r2 * (1.0 / 479001600.0 + r2 * (-1.0 / 87178291200.0)))))));
            const int q = (int)(((long long)kq) & 3);
            const double c = (q == 0) ? cs : (q == 1) ? -sn : (q == 2) ? -cs : sn;
            const double s = (q == 0) ? sn : (q == 1) ? cs : (q == 2) ? -sn : -cs;
            rope[pos * 16 + fi] = (float)c; rope[pos * 16 + 8 + fi] = (float)s;
        }
    }
}

typedef const f32x4 (&AccRef)[2][2][4][2];

struct EpiZ {
    static constexpr bool PERM = true;
    bf16* S6; bf16* Gt; const float* rope; float* kmean;
    __device__ __forceinline__ void operator()(AccRef acc, const pg8::Unit& u, int wr, int wc, int fr, int fq) const {
        const int pn = u.pn, row0 = u.row0 + wr * 64 + fr, ct0 = wc * 32 + 8 * fq;
        if (pn < 12) {
            bf16* base = S6 + (size_t)(pn >> 1) * T_ * 512 + (pn & 1) * 256 + ct0;
            const bool ropew = (pn < 4) && ((wc & 1) == 0);
            const bool isk = (pn == 2) || (pn == 3);
            const float sc = (pn < 2) ? attn_body::C2 : 1.f;
            float ks[2][8];
#pragma unroll
            for (int bj = 0; bj < 2; ++bj)
#pragma unroll
                for (int i = 0; i < 8; ++i) ks[bj][i] = 0.f;
#pragma unroll
            for (int ai = 0; ai < 2; ++ai)
#pragma unroll
                for (int m = 0; m < 4; ++m) {
                    const int r = row0 + ai * 128 + m * 16;
                    float cs[8], sn[8];
                    if (ropew) { const float* rp = rope + (size_t)(r & (SEQ_ - 1)) * 16; const f32x4 c0 = *(const f32x4*)rp, c1 = *(const f32x4*)(rp + 4), s0 = *(const f32x4*)(rp + 8), s1 = *(const f32x4*)(rp + 12);
                        cs[0] = c0.x; cs[1] = c0.y; cs[2] = c0.z; cs[3] = c0.w; cs[4] = c1.x; cs[5] = c1.y; cs[6] = c1.z; cs[7] = c1.w;
                        sn[0] = s0.x; sn[1] = s0.y; sn[2] = s0.z; sn[3] = s0.w; sn[4] = s1.x; sn[5] = s1.y; sn[6] = s1.z; sn[7] = s1.w; }
#pragma unroll
                    for (int bj = 0; bj < 2; ++bj) {
                        const f32x4 v0 = acc[ai][bj][m][0], v1 = acc[ai][bj][m][1];
                        float x[8] = {v0.x, v0.y, v0.z, v0.w, v1.x, v1.y, v1.z, v1.w};
                        if (ropew) {
#pragma unroll
                            for (int i = 0; i < 8; ++i) { const float o = __shfl_xor(x[i], 16);
                                const float a = x[i] * cs[i] - o * sn[i];
                                const float b = o * sn[i] + x[i] * cs[i];
                                x[i] = (fq == 0) ? a : (fq == 1) ? b : x[i]; }
                        }
                        if (isk) {
#pragma unroll
                            for (int i = 0; i < 8; ++i) ks[bj][i] += x[i];
                        }
                        v4u w; w.x = cvt_pk_bf16(x[0] * sc, x[1] * sc); w.y = cvt_pk_bf16(x[2] * sc, x[3] * sc); w.z = cvt_pk_bf16(x[4] * sc, x[5] * sc); w.w = cvt_pk_bf16(x[6] * sc, x[7] * sc);
                        *(v4u*)(base + (size_t)r * 512 + bj * 128) = w;
                    }
                }
            if (isk) {
                const int b = u.row0 / SEQ_, blk = (u.row0 % SEQ_) / 256;
#pragma unroll
                for (int bj = 0; bj < 2; ++bj)
#pragma unroll
                    for (int i = 0; i < 8; ++i) { float s = ks[bj][i]; s += __shfl_xor(s, 1); s += __shfl_xor(s, 2); s += __shfl_xor(s, 4); s += __shfl_xor(s, 8);
                        if (fr == 0) { const int c = (pn - 2) * 256 + bj * 128 + ct0 + i; atomicAdd(kmean + ((size_t)((b * NH_ + (c >> 6)) * NBLK_ + blk)) * 64 + (c & 63), s * (1.0f / 256.0f)); } }
            }
        } else {
            bf16* base = Gt + (size_t)((pn - 12) >> 2) * T_ * 1024 + (size_t)((pn - 12) & 3) * 256 + ct0;
#pragma unroll
            for (int ai = 0; ai < 2; ++ai)
#pragma unroll
                for (int m = 0; m < 4; ++m) { const int r = row0 + ai * 128 + m * 16;
#pragma unroll
                    for (int bj = 0; bj < 2; ++bj) { const f32x4 v0 = acc[ai][bj][m][0], v1 = acc[ai][bj][m][1];
#ifdef MK_RAW_GATES
                        v4u w; w.x = cvt_pk_bf16(v0.x, v0.y); w.y = cvt_pk_bf16(v0.z, v0.w); w.z = cvt_pk_bf16(v1.x, v1.y); w.w = cvt_pk_bf16(v1.z, v1.w);
#else
                        v4u w; w.x = cvt_pk_bf16(sigmoidf_(v0.x), sigmoidf_(v0.y)); w.y = cvt_pk_bf16(sigmoidf_(v0.z), sigmoidf_(v0.w)); w.z = cvt_pk_bf16(sigmoidf_(v1.x), sigmoidf_(v1.y)); w.w = cvt_pk_bf16(sigmoidf_(v1.z), sigmoidf_(v1.w));
#endif
                        *(v4u*)(base + (size_t)r * 1024 + bj * 128) = w; } }
        }
    }
};

template <bool ADD> struct EpiGate {
    static constexpr bool PERM = true;
    bf16* O; const bf16* gate;
    __device__ __forceinline__ void operator()(AccRef acc, const pg8::Unit& u, int wr, int wc, int fr, int fq) const {
        const int row0 = u.row0 + wr * 64 + fr, col0 = u.pn * 256 + wc * 32 + 8 * fq;
#pragma unroll
        for (int ai = 0; ai < 2; ++ai)
#pragma unroll
            for (int m = 0; m < 4; ++m) { const int r = row0 + ai * 128 + m * 16;
#pragma unroll
                for (int bj = 0; bj < 2; ++bj) { const f32x4 v0 = acc[ai][bj][m][0], v1 = acc[ai][bj][m][1];
                    const v4u g = *(const v4u*)(gate + (size_t)r * 1024 + col0 + bj * 128);
                    float y[8] = {bf_lo(g.x) * v0.x, bf_hi(g.x) * v0.y, bf_lo(g.y) * v0.z, bf_hi(g.y) * v0.w, bf_lo(g.z) * v1.x, bf_hi(g.z) * v1.y, bf_lo(g.w) * v1.z, bf_hi(g.w) * v1.w};
                    bf16* op = O + (size_t)r * 1024 + col0 + bj * 128;
                    if (ADD) { const v4u p = *(const v4u*)op; y[0] += bf_lo(p.x); y[1] += bf_hi(p.x); y[2] += bf_lo(p.y); y[3] += bf_hi(p.y); y[4] += bf_lo(p.z); y[5] += bf_hi(p.z); y[6] += bf_lo(p.w); y[7] += bf_hi(p.w); }
                    v4u w; w.x = cvt_pk_bf16(y[0], y[1]); w.y = cvt_pk_bf16(y[2], y[3]); w.z = cvt_pk_bf16(y[4], y[5]); w.w = cvt_pk_bf16(y[6], y[7]);
                    *(v4u*)op = w; } }
    }
};

struct EpiRes {
    static constexpr bool PERM = false;
    float* C; const float* R;
    __device__ __forceinline__ void operator()(AccRef acc, const pg8::Unit& u, int wr, int wc, int fr, int fq) const {
        const int row0 = u.row0 + wr * 64 + fr, col0 = u.pn * 256 + wc * 32 + 4 * fq;
#pragma unroll
        for (int ai = 0; ai < 2; ++ai)
#pragma unroll
            for (int m = 0; m < 4; ++m) { const size_t ro = (size_t)(row0 + ai * 128 + m * 16) * D_ + col0;
#pragma unroll
                for (int bj = 0; bj < 2; ++bj)
#pragma unroll
                    for (int n = 0; n < 2; ++n) { const f32x4 rv = *(const f32x4*)(R + ro + bj * 128 + n * 16); *(f32x4*)(C + ro + bj * 128 + n * 16) = rv * DN_ALPHA_ + acc[ai][bj][m][n]; } }
    }
};

__device__ __forceinline__ void swiglu_store(AccRef acc, bf16* Hrow0  , int ld, int wr, int wc, int fr, int fq) {
#pragma unroll
    for (int ai = 0; ai < 2; ++ai)
#pragma unroll
        for (int m = 0; m < 4; ++m) { bf16* hp = Hrow0 + (size_t)(wr * 64 + fr + ai * 128 + m * 16) * ld + wc * 32 + 8 * fq;
            float y[8];
#pragma unroll
            for (int n = 0; n < 2; ++n)
#pragma unroll
                for (int j = 0; j < 4; ++j) { const float g = acc[ai][0][m][n][j], up = acc[ai][1][m][n][j]; y[n * 4 + j] = g * sigmoidf_(g) * up; }
            v4u w; w.x = cvt_pk_bf16(y[0], y[1]); w.y = cvt_pk_bf16(y[2], y[3]); w.z = cvt_pk_bf16(y[4], y[5]); w.w = cvt_pk_bf16(y[6], y[7]);
            *(v4u*)hp = w; asm volatile("" ::: "memory"); }
}
struct EpiShRouter {
    static constexpr bool PERM = true;
    bf16* Hs; float* logits;
    __device__ __forceinline__ void operator()(AccRef acc, const pg8::Unit& u, int wr, int wc, int fr, int fq) const {
        if (u.pn < 2) { swiglu_store(acc, Hs + (size_t)u.row0 * 256 + u.pn * 128, 256, wr, wc, fr, fq); return; }
#pragma unroll
        for (int ai = 0; ai < 2; ++ai)
#pragma unroll
            for (int m = 0; m < 4; ++m) { float* lp = logits + (size_t)(u.row0 + wr * 64 + fr + ai * 128 + m * 16) * 256 + wc * 32 + 8 * fq;
#pragma unroll
                for (int bj = 0; bj < 2; ++bj) { *(f32x4*)(lp + bj * 128) = acc[ai][bj][m][0]; *(f32x4*)(lp + bj * 128 + 4) = acc[ai][bj][m][1]; } asm volatile("" ::: "memory"); }
    }
};
struct EpiMoeUp {
    static constexpr bool PERM = true;
    bf16* H;
    __device__ __forceinline__ void operator()(AccRef acc, const pg8::Unit& u, int wr, int wc, int fr, int fq) const { swiglu_store(acc, H + (size_t)u.row0 * 256 + u.pn * 128, 256, wr, wc, fr, fq); }
};
struct EpiMoeDown {
    static constexpr bool PERM = true;
    bf16* Ylo; bf16* Yhi; const int* row_dst; const float* row_w;
    __device__ __forceinline__ void operator()(AccRef acc, const pg8::Unit& u, int wr, int wc, int fr, int fq) const {
        const int s0 = u.row0 + wr * 64 + fr, col0 = u.pn * 256 + wc * 32 + 8 * fq;
#pragma unroll
        for (int ai = 0; ai < 2; ++ai)
#pragma unroll
            for (int m = 0; m < 4; ++m) { const int slot = s0 + ai * 128 + m * 16; const int dst = row_dst[slot]; const float w = row_w[slot];
                if (dst >= 0) { bf16* yp = (dst < T_ * 4 ? Ylo + (size_t)dst * 1024 : Yhi + (size_t)(dst - T_ * 4) * 1024) + col0;
#pragma unroll
                    for (int bj = 0; bj < 2; ++bj) { const f32x4 v0 = acc[ai][bj][m][0] * w, v1 = acc[ai][bj][m][1] * w;
                        v4u o; o.x = cvt_pk_bf16(v0.x, v0.y); o.y = cvt_pk_bf16(v0.z, v0.w); o.z = cvt_pk_bf16(v1.x, v1.y); o.w = cvt_pk_bf16(v1.z, v1.w);
                        *(v4u*)(yp + bj * 128) = o; } } }
    }
};
struct EpiBf16Plain {
    static constexpr bool PERM = true;
    bf16* O; int ldc;
    __device__ __forceinline__ void operator()(AccRef acc, const pg8::Unit& u, int wr, int wc, int fr, int fq) const {
        const int row0 = u.row0 + wr * 64 + fr, col0 = u.pn * 256 + wc * 32 + 8 * fq;
#pragma unroll
        for (int ai = 0; ai < 2; ++ai)
#pragma unroll
            for (int m = 0; m < 4; ++m) { bf16* op = O + (size_t)(row0 + ai * 128 + m * 16) * ldc + col0;
#pragma unroll
                for (int bj = 0; bj < 2; ++bj) { const f32x4 v0 = acc[ai][bj][m][0], v1 = acc[ai][bj][m][1];
                    v4u o; o.x = cvt_pk_bf16(v0.x, v0.y); o.y = cvt_pk_bf16(v0.z, v0.w); o.z = cvt_pk_bf16(v1.x, v1.y); o.w = cvt_pk_bf16(v1.z, v1.w);
                    *(v4u*)(op + bj * 128) = o; } }
    }
};
struct EpiPle {
    static constexpr bool PERM = true;
    float* X; const bf16* PP;
    __device__ __forceinline__ void operator()(AccRef acc, const pg8::Unit& u, int wr, int wc, int fr, int fq) const {
        const int row0 = u.row0 + wr * 64 + fr, col0 = u.pn * 256 + wc * 32 + 8 * fq;
#pragma unroll
        for (int ai = 0; ai < 2; ++ai)
#pragma unroll
            for (int m = 0; m < 4; ++m) { const size_t ro = (size_t)(row0 + ai * 128 + m * 16) * D_ + col0;
#pragma unroll
                for (int bj = 0; bj < 2; ++bj) { const f32x4 v0 = acc[ai][bj][m][0], v1 = acc[ai][bj][m][1];
                    const v4u p = *(const v4u*)(PP + ro + bj * 128);
                    float* xp = X + ro + bj * 128; const f32x4 x0 = *(const f32x4*)xp, x1 = *(const f32x4*)(xp + 4);
                    f32x4 o0, o1;
                    o0.x = x0.x * DN_ALPHA_ + sigmoidf_(v0.x) * bf_lo(p.x); o0.y = x0.y * DN_ALPHA_ + sigmoidf_(v0.y) * bf_hi(p.x); o0.z = x0.z * DN_ALPHA_ + sigmoidf_(v0.z) * bf_lo(p.y); o0.w = x0.w * DN_ALPHA_ + sigmoidf_(v0.w) * bf_hi(p.y);
                    o1.x = x1.x * DN_ALPHA_ + sigmoidf_(v1.x) * bf_lo(p.z); o1.y = x1.y * DN_ALPHA_ + sigmoidf_(v1.y) * bf_hi(p.z); o1.z = x1.z * DN_ALPHA_ + sigmoidf_(v1.z) * bf_lo(p.w); o1.w = x1.w * DN_ALPHA_ + sigmoidf_(v1.w) * bf_hi(p.w);
                    *(f32x4*)xp = o0; *(f32x4*)(xp + 4) = o1; } }
    }
};

__device__ __forceinline__ void moe_tables(Frame& F) {
    const int lane_ = lane_id(), tid_ = F.wave * 64 + lane_; (void)tid_;
    LAS unsigned* PST = (LAS unsigned*)(F.lds + LX_PST); LAS unsigned* NB = (LAS unsigned*)(F.lds + LX_NB); LAS unsigned short* BLKE = (LAS unsigned short*)(F.lds + LX_BLKE);
    const unsigned* gcount = (const unsigned*)(F.ws + WS_GCOUNT);
    __syncthreads();
    if (tid_ < 256) NB[tid_] = (gcount[tid_] + 255u) >> 8;
    __syncthreads();
    if (tid_ < 256) { unsigned s = 0; for (int j = 0; j < tid_; ++j) s += NB[j]; PST[tid_] = s * 256u; if (tid_ == 255) PST[256] = s + NB[255];
        const unsigned nb = NB[tid_]; for (unsigned i = 0; i < nb; ++i) BLKE[s + i] = (unsigned short)tid_; }
    __syncthreads();
}
struct MoeUpOrder {
    static constexpr bool GATHER = true;
    const LAS unsigned short* blke; int nunits; const int* row_tok; const char* A; const char* Bt; int G, c;
    __device__ __forceinline__ bool next(int i, pg8::Unit& u) const {
        const int L = i * G + c; if (L >= nunits) return false;
        const int rb = L >> 1, pn = L & 1; const int e = __builtin_amdgcn_readfirstlane((int)blke[rb]);
        u.a = A; u.b = Bt + ((size_t)e * 512 + pn * 256) * 1024 * 2; u.row0 = rb * 256; u.pn = pn; u.e = e; return true;
    }
    __device__ __forceinline__ void aoff(const pg8::Unit& u, int tid, unsigned (&v)[2][2]) const {
#pragma unroll
        for (int i = 0; i < 2; ++i) { int R, C; pg8::stage_rc(tid * 16 + i * 8192, R, C);
#pragma unroll
            for (int h = 0; h < 2; ++h) { const int tok = row_tok[u.row0 + h * 128 + R]; v[h][i] = (unsigned)(tok * 1024 + C) * 2u; } }
    }
};
struct MoeDownOrder {
    static constexpr bool GATHER = false;
    const LAS unsigned short* blke; int nunits; const char* A; const char* Bt; int G, c;
    __device__ __forceinline__ bool next(int i, pg8::Unit& u) const {
        const int L = i * G + c; if (L >= nunits) return false;
        const int rb = L >> 2, pn = L & 3; const int e = __builtin_amdgcn_readfirstlane((int)blke[rb]);
        u.a = A + (size_t)rb * 256 * 256 * 2; u.b = Bt + ((size_t)e * 1024 + pn * 256) * 256 * 2; u.row0 = rb * 256; u.pn = pn; u.e = e; return true;
    }
};

__device__ __forceinline__ void p_conv(Frame& F, const float* conv_w) {
    const int lane_ = lane_id(), tid_ = F.wave * 64 + lane_; (void)tid_;
    bf16* cb = (bf16*)(F.ws + WS_S6) + (size_t)3 * T_ * 512; const bf16* cc = (const bf16*)(F.ws + WS_S6) + (size_t)4 * T_ * 512; const bf16* ch = (const bf16*)(F.ws + WS_S6) + (size_t)5 * T_ * 512;
    const int gw = F.vcu * NWAVES + F.wave, NGW = F.G * NWAVES, c0 = lane_ * 8;
    float w0[8], w1[8], w2[8];
#pragma unroll
    for (int i = 0; i < 8; ++i) { w0[i] = conv_w[c0 + i]; w1[i] = conv_w[512 + c0 + i]; w2[i] = conv_w[1024 + c0 + i]; }
    for (int ck = gw; ck < T_ / 32; ck += NGW) {
        const int t0 = ck * 32;
        float u1[8], u2[8];
#pragma unroll
        for (int i = 0; i < 8; ++i) { u1[i] = 0.f; u2[i] = 0.f; }
        if ((t0 & (SEQ_ - 1)) != 0) {
            const v4u a2 = *(const v4u*)(cc + (size_t)(t0 - 2) * 512 + c0), b2 = *(const v4u*)(ch + (size_t)(t0 - 2) * 512 + c0);
            const v4u a1 = *(const v4u*)(cc + (size_t)(t0 - 1) * 512 + c0), b1 = *(const v4u*)(ch + (size_t)(t0 - 1) * 512 + c0);
            u2[0] = bf_lo(a2.x) * bf_lo(b2.x); u2[1] = bf_hi(a2.x) * bf_hi(b2.x); u2[2] = bf_lo(a2.y) * bf_lo(b2.y); u2[3] = bf_hi(a2.y) * bf_hi(b2.y);
            u2[4] = bf_lo(a2.z) * bf_lo(b2.z); u2[5] = bf_hi(a2.z) * bf_hi(b2.z); u2[6] = bf_lo(a2.w) * bf_lo(b2.w); u2[7] = bf_hi(a2.w) * bf_hi(b2.w);
            u1[0] = bf_lo(a1.x) * bf_lo(b1.x); u1[1] = bf_hi(a1.x) * bf_hi(b1.x); u1[2] = bf_lo(a1.y) * bf_lo(b1.y); u1[3] = bf_hi(a1.y) * bf_hi(b1.y);
            u1[4] = bf_lo(a1.z) * bf_lo(b1.z); u1[5] = bf_hi(a1.z) * bf_hi(b1.z); u1[6] = bf_lo(a1.w) * bf_lo(b1.w); u1[7] = bf_hi(a1.w) * bf_hi(b1.w);
        }
#pragma unroll 4
        for (int t = t0; t < t0 + 32; ++t) {
            const v4u a = *(const v4u*)(cc + (size_t)t * 512 + c0), b = *(const v4u*)(ch + (size_t)t * 512 + c0), g = *(const v4u*)(cb + (size_t)t * 512 + c0);
            float u0[8] = {bf_lo(a.x) * bf_lo(b.x), bf_hi(a.x) * bf_hi(b.x), bf_lo(a.y) * bf_lo(b.y), bf_hi(a.y) * bf_hi(b.y), bf_lo(a.z) * bf_lo(b.z), bf_hi(a.z) * bf_hi(b.z), bf_lo(a.w) * bf_lo(b.w), bf_hi(a.w) * bf_hi(b.w)};
            const float gb[8] = {bf_lo(g.x), bf_hi(g.x), bf_lo(g.y), bf_hi(g.y), bf_lo(g.z), bf_hi(g.z), bf_lo(g.w), bf_hi(g.w)};
            float y[8];
#pragma unroll
            for (int i = 0; i < 8; ++i) { y[i] = gb[i] * (w0[i] * u2[i] + w1[i] * u1[i] + w2[i] * u0[i]); u2[i] = u1[i]; u1[i] = u0[i]; }
            v4u o; o.x = cvt_pk_bf16(y[0], y[1]); o.y = cvt_pk_bf16(y[2], y[3]); o.z = cvt_pk_bf16(y[4], y[5]); o.w = cvt_pk_bf16(y[6], y[7]);
            *(v4u*)(cb + (size_t)t * 512 + c0) = o;
        }
    }
}
__device__ __forceinline__ void p_select(Frame& F) {
    const int lane_ = lane_id(), tid_ = F.wave * 64 + lane_; (void)tid_;
    const bf16* Q = (const bf16*)(F.ws + WS_S6); const float* kmean = (const float*)(F.ws + WS_KMEAN); unsigned* SEL = (unsigned*)(F.ws + WS_SEL);
    const int gt = F.vcu * 512 + tid_, NT = F.G * 512;
    for (int it = gt; it < NB_ * NH_ * SEQ_; it += NT) {
        const int s = it & (SEQ_ - 1), bh = it >> 12, b = bh >> 3, h = bh & 7;
        const int own = __builtin_amdgcn_readfirstlane(s >> 8);
        const int bhu = __builtin_amdgcn_readfirstlane(bh);
        float q[64];
        const bf16* qp = Q + ((size_t)(b * SEQ_ + s)) * 512 + h * 64;
#pragma unroll
        for (int i = 0; i < 8; ++i) { const v4u w = *(const v4u*)(qp + i * 8); q[i * 8 + 0] = bf_lo(w.x); q[i * 8 + 1] = bf_hi(w.x); q[i * 8 + 2] = bf_lo(w.y); q[i * 8 + 3] = bf_hi(w.y); q[i * 8 + 4] = bf_lo(w.z); q[i * 8 + 5] = bf_hi(w.z); q[i * 8 + 6] = bf_lo(w.w); q[i * 8 + 7] = bf_hi(w.w); }
        float v0 = -INFINITY, v1 = -INFINITY, v2 = -INFINITY; int i0 = -1, i1 = -1, i2 = -1;
        for (int j = 0; j < own; ++j) {
            const float* km = kmean + ((size_t)(bhu * NBLK_ + j)) * 64;
            float d = 0.f;
#pragma unroll
            for (int i = 0; i < 64; ++i) d += q[i] * km[i];
            if (d > v0) { v2 = v1; i2 = i1; v1 = v0; i1 = i0; v0 = d; i0 = j; }
            else if (d > v1) { v2 = v1; i2 = i1; v1 = d; i1 = j; }
            else if (d > v2) { v2 = d; i2 = j; }
        }
        unsigned m = 0u; if (i0 >= 0) m |= 1u << i0; if (i1 >= 0) m |= 1u << i1; if (i2 >= 0) m |= 1u << i2;
        SEL[it] = m;
    }
}

struct AttnOrder {
    int vcu;
    __device__ __forceinline__ bool next(int i, int& bh, int& qb) const { if (i >= 4 || vcu >= 256) return false; const int j = vcu & 3; bh = vcu >> 2; qb = (i == 0) ? 15 - j : (i == 1) ? 8 + j : (i == 2) ? 7 - j : j; return true; }
};

template <bool ADD_Y, bool WRITE_BF>
__device__ __forceinline__ void ln_row(Frame& F, const float* src, float* dst, bf16* dstb, const float* gam, const float* bet, const bf16* y0, const bf16* y1, int row) {
    const int lane_ = lane_id(), tid_ = F.wave * 64 + lane_; (void)tid_;
    const f32x4* xr = (const f32x4*)(src + (size_t)row * D_) + lane_;
    f32x4 v[4];
#pragma unroll
    for (int j = 0; j < 4; ++j) v[j] = xr[64 * j];
    if (ADD_Y) {
        const bf16* yb = (row < T_ / 2) ? y0 + (size_t)row * 8 * 1024 : y1 + (size_t)(row - T_ / 2) * 8 * 1024;
#pragma unroll
        for (int k = 0; k < 8; ++k)
#pragma unroll
            for (int j = 0; j < 4; ++j) { const u32x2 w = *(const u32x2*)(yb + (size_t)k * 1024 + 256 * j + lane_ * 4); const unsigned w0 = w.x, w1 = w.y;
                v[j].x += bf_lo(w0); v[j].y += bf_hi(w0); v[j].z += bf_lo(w1); v[j].w += bf_hi(w1); }
    }
    float s = 0.f;
#pragma unroll
    for (int j = 0; j < 4; ++j) s += (v[j].x + v[j].y) + (v[j].z + v[j].w);
    const float mean = wave_sum(s) * (1.f / D_); float s2 = 0.f;
#pragma unroll
    for (int j = 0; j < 4; ++j) { v[j] = v[j] - mean; s2 += (v[j].x * v[j].x + v[j].y * v[j].y) + (v[j].z * v[j].z + v[j].w * v[j].w); }
    const float rstd = 1.f / sqrtf(wave_sum(s2) * (1.f / D_) + LN_EPS_);
    f32x4* od = (f32x4*)(dst + (size_t)row * D_) + lane_;
#pragma unroll
    for (int j = 0; j < 4; ++j) { const f32x4 g = *((const f32x4*)gam + 64 * j + lane_), bb = *((const f32x4*)bet + 64 * j + lane_);
        const f32x4 o = v[j] * rstd * g + bb; od[64 * j] = o;
        if (WRITE_BF) { u32x2 w; w.x = cvt_pk_bf16(o.x, o.y); w.y = cvt_pk_bf16(o.z, o.w); *(u32x2*)(dstb + (size_t)row * D_ + 256 * j + lane_ * 4) = w; } }
}

__device__ __forceinline__ void p_route(Frame& F, const float* router_bias) {
    const int lane_ = lane_id(), tid_ = F.wave * 64 + lane_; (void)tid_;
    LAS unsigned* hist = (LAS unsigned*)(F.lds + LX_HIST);
    const float* logits = (const float*)(F.ws + WS_LOGITS);
    int* topi = (int*)(F.ws + WS_TOPI); float* topw = (float*)(F.ws + WS_TOPW); int* lrank = (int*)(F.ws + WS_LRANK);
    unsigned* gcount = (unsigned*)(F.ws + WS_GCOUNT); unsigned* wgbase = (unsigned*)(F.ws + WS_WGBASE);
    { int* row_tok = (int*)(F.ws + WS_ROWTOK); int* row_dst = (int*)(F.ws + WS_ROWDST); float* row_w = (float*)(F.ws + WS_ROWW);
      for (int i = blockIdx.x * 512 + tid_; i < RMAX_; i += F.G * 512) { row_tok[i] = 0; row_dst[i] = -1; row_w[i] = 0.f; } }
    if (tid_ < 256) hist[tid_] = 0u;
    __syncthreads();
    const int lane = lane_;
    const f32x4 bias = *(const f32x4*)(router_bias + lane * 4);
    for (int tok = blockIdx.x * 8 + F.wave; tok < T_; tok += F.G * 8) {
        const f32x4 lg = *(const f32x4*)(logits + (size_t)tok * 256 + lane * 4);
        const float s0 = sigmoidf_(lg.x), s1 = sigmoidf_(lg.y), s2 = sigmoidf_(lg.z), s3 = sigmoidf_(lg.w);
        float c0 = s0 + bias.x, c1 = s1 + bias.y, c2 = s2 + bias.z, c3 = s3 + bias.w;
        float a1 = fmaxf(c0, c1), a2 = fminf(c0, c1); { const float b1 = fmaxf(c2, c3), b2 = fminf(c2, c3); const float n1 = fmaxf(a1, b1), n2 = fmaxf(fminf(a1, b1), fmaxf(a2, b2)); a1 = n1; a2 = n2; }
#pragma unroll
        for (int off = 1; off < 8; off <<= 1) { const float b1 = __shfl_xor(a1, off), b2 = __shfl_xor(a2, off); const float n1 = fmaxf(a1, b1), n2 = fmaxf(fminf(a1, b1), fmaxf(a2, b2)); a1 = n1; a2 = n2; }
        const float gs = a1 + a2; const int g = lane >> 3;
        int rank = 0;
#pragma unroll
        for (int j = 0; j < 8; ++j) { const float sj = __shfl(gs, j * 8); rank += (sj > gs || (sj == gs && j < g)) ? 1 : 0; }
        if (rank >= 4) { c0 = -INFINITY; c1 = -INFINITY; c2 = -INFINITY; c3 = -INFINITY; }
        int ridx = 0; float rs = 0.f;
#pragma unroll
        for (int k = 0; k < 8; ++k) {
            float bv = c0; int bi = 0; if (c1 > bv) { bv = c1; bi = 1; } if (c2 > bv) { bv = c2; bi = 2; } if (c3 > bv) { bv = c3; bi = 3; }
            float v = bv; int ix = lane * 4 + bi;
#pragma unroll
            for (int off = 1; off < 64; off <<= 1) { const float ov = __shfl_xor(v, off); const int oi = __shfl_xor(ix, off); if (ov > v || (ov == v && oi < ix)) { v = ov; ix = oi; } }
            const int ol = ix >> 2, oj = ix & 3;
            const float ssel = (oj == 0) ? s0 : (oj == 1) ? s1 : (oj == 2) ? s2 : s3;
            const float sv = __shfl(ssel, ol);
            if (lane == ol) { if (oj == 0) c0 = -INFINITY; else if (oj == 1) c1 = -INFINITY; else if (oj == 2) c2 = -INFINITY; else c3 = -INFINITY; }
            if (lane == k) { ridx = ix; rs = sv; }
        }
        float sum = (lane < 8) ? rs : 0.f; sum += __shfl_xor(sum, 1); sum += __shfl_xor(sum, 2); sum += __shfl_xor(sum, 4);
        if (lane < 8) { const float w = rs / sum * ROUTED_SCALE_;
            topi[tok * 8 + lane] = ridx; topw[tok * 8 + lane] = w;
            const unsigned lr = __hip_atomic_fetch_add(&hist[ridx], 1u, __ATOMIC_RELAXED, __HIP_MEMORY_SCOPE_WORKGROUP);
            lrank[tok * 8 + lane] = (int)lr; }
    }
    __syncthreads();
    if (tid_ < 256) { const unsigned hc = hist[tid_]; const unsigned base = __hip_atomic_fetch_add(gcount + tid_, hc, RLX_AGENT); wgbase[blockIdx.x * 256 + tid_] = base; }
}
__device__ __forceinline__ void p_assign(Frame& F) {
    const int lane_ = lane_id(), tid_ = F.wave * 64 + lane_; (void)tid_;
    moe_tables(F);
    LAS unsigned* PST = (LAS unsigned*)(F.lds + LX_PST);
    const int* topi = (const int*)(F.ws + WS_TOPI); const float* topw = (const float*)(F.ws + WS_TOPW); const int* lrank = (const int*)(F.ws + WS_LRANK);
    const unsigned* wgbase = (const unsigned*)(F.ws + WS_WGBASE);
    int* row_tok = (int*)(F.ws + WS_ROWTOK); int* row_dst = (int*)(F.ws + WS_ROWDST); float* row_w = (float*)(F.ws + WS_ROWW);
    for (int tok = blockIdx.x * 8 + F.wave; tok < T_; tok += F.G * 8) {
        if (lane_ < 8) { const int e = topi[tok * 8 + lane_]; const unsigned slot = PST[e] + wgbase[blockIdx.x * 256 + e] + (unsigned)lrank[tok * 8 + lane_];
            row_tok[slot] = tok; row_dst[slot] = tok * 8 + lane_; row_w[slot] = topw[tok * 8 + lane_]; }
    }
}

__global__ void __launch_bounds__(NWAVES * 64, 2) fwd_kernel(Args args) {
    extern __shared__ __attribute__((aligned(16))) unsigned char lds[];
    Frame F;
    F.lds = (LAS unsigned char*)lds;
    F.MISC = (volatile LAS unsigned*)(F.lds + MISC_OFF);
    F.wave = __builtin_amdgcn_readfirstlane((int)threadIdx.x >> 6);
    F.G = gridDim.x; { const int bx = blockIdx.x; F.vcu = (F.G % 8 == 0) ? (bx % 8) * (F.G / 8) + bx / 8 : bx; }
    F.ws = args.ws; F.out = args.out;
    F.ctl = (gu32*)(args.ws + WS_CTL);
    unsigned char* ws = args.ws;
    { const int tid_ = F.wave * 64 + lane_id(); for (int u = tid_; u < (LDS_BYTES - LDSCTL_OFF) / 4; u += NWAVES * 64) ((LAS unsigned*)(F.lds + LDSCTL_OFF))[u] = 0u; }
    __syncthreads();
    XcdBarrier bar; bar.bar = (unsigned*)(F.ctl + CW_BAR); bar.x = 0; bar.st = nullptr;
    if (N_LAUNCHES == 1) bar = xcd_barrier_post((unsigned*)(F.ctl + CW_BAR), F.MISC + 8, F.wave);
#define GRID_BAR() do { if (N_LAUNCHES == 1) xcd_barrier(bar, F.wave); } while (0)
    const int lo = args.ph_lo, hi = args.ph_hi;
#ifndef MK_PHMASK
#define MK_PHMASK 0x7fff
#endif
#define IN(k) ((((MK_PHMASK) >> (k)) & 1) && lo <= (k) && (k) < hi)
#define BOTH(k) (IN(k) && IN((k) + 1))
    bf16* S6 = (bf16*)(ws + WS_S6);
    float* X1 = args.out;

    if (IN(0)) { p0_prologue(F, args); if (BOTH(0)) GRID_BAR(); }

    if (IN(1)) {
        pg8::DenseOrder S; S.init(ws + WS_XB, ws + WS_WIN, T_, INW_, D_, F.G, (int)blockIdx.x);
        EpiZ E{S6, (bf16*)(ws + WS_G), (const float*)(ws + WS_ROPE), (float*)(ws + WS_KMEAN)};
        pg8::gemm_phase<EpiZ, pg8::DenseOrder, true>(F.lds + RING_OFF, D_, S, E, F.wave);
        if (BOTH(1)) GRID_BAR();
    }
    if (IN(2)) { p_conv(F, args.in[3]); p_select(F); if (BOTH(2)) GRID_BAR(); }

    if (IN(3)) {
        const AttnOrder S{F.vcu};
        int bh, qb;
        for (int i = 0; S.next(i, bh, qb); ++i)
            attn_body::attn_unit<8>(bh >> 3, bh & 7, qb, (const attn_body::bf16*)S6, (const attn_body::bf16*)(S6 + (size_t)T_ * 512), (const attn_body::bf16*)(S6 + (size_t)2 * T_ * 512),
                                    (attn_body::bf16*)S6, (const unsigned*)(ws + WS_SEL), (char*)lds + RING_OFF, F.wave);
        if (BOTH(3)) GRID_BAR();
    }
    if (IN(4)) {
        { pg8::DenseOrder S; S.init(S6, ws + WS_WAO, T_, D_, AW_, F.G, (int)blockIdx.x);
#ifdef MK_P4A_PLAIN
          EpiBf16Plain E{(bf16*)(ws + WS_P1), D_};
          pg8::gemm_phase<EpiBf16Plain, pg8::DenseOrder, true>(F.lds + RING_OFF, AW_, S, E, F.wave); }
#else
          EpiGate<false> E{(bf16*)(ws + WS_P1), (const bf16*)(ws + WS_G)};
          pg8::gemm_phase<EpiGate<false>, pg8::DenseOrder, true>(F.lds + RING_OFF, AW_, S, E, F.wave); }
#endif
        VM_WAIT(); __syncthreads();
#ifndef MK_SKIP_P4B
        { pg8::DenseOrder S; S.init(S6 + (size_t)3 * T_ * 512, ws + WS_WCO, T_, D_, CW_, F.G, (int)blockIdx.x);
          EpiGate<true> E{(bf16*)(ws + WS_P1), (const bf16*)(ws + WS_G) + (size_t)T_ * 1024};
          pg8::gemm_phase<EpiGate<true>, pg8::DenseOrder, true>(F.lds + RING_OFF, CW_, S, E, F.wave); }
#endif
        if (BOTH(4)) GRID_BAR();
    }
    if (IN(5)) {
        pg8::DenseOrder S; S.init(ws + WS_P1, ws + WS_WOUT, T_, D_, D_, F.G, (int)blockIdx.x);
        EpiRes E{X1, args.in[0]};
        pg8::gemm_phase<EpiRes, pg8::DenseOrder, true>(F.lds + RING_OFF, D_, S, E, F.wave);
        if (BOTH(5)) GRID_BAR();
    }
    if (IN(6)) {
        const int gw = F.vcu * NWAVES + F.wave, NGW = F.G * NWAVES;
        for (int m = gw; m < T_; m += NGW) ln_row<false, true>(F, X1, X1, (bf16*)(ws + WS_XB), args.in[7], args.in[8], nullptr, nullptr, m);
        if (BOTH(6)) GRID_BAR();
    }
    if (IN(7)) {
        { pg8::DenseOrder S; S.init(ws + WS_XB, ws + WS_WSR, T_, 768, D_, F.G, (int)blockIdx.x);
          EpiShRouter E{(bf16*)(ws + WS_HS), (float*)(ws + WS_LOGITS)};
          pg8::gemm_phase<EpiShRouter, pg8::DenseOrder, true>(F.lds + RING_OFF, D_, S, E, F.wave); }
        { pg8::DenseOrder S; S.init(ws + WS_PB, ws + WS_WPP, T_, D_, PLE_, F.G, (int)blockIdx.x);
          EpiBf16Plain E{(bf16*)(ws + WS_PP), D_};
          pg8::gemm_phase<EpiBf16Plain, pg8::DenseOrder, true>(F.lds + RING_OFF, PLE_, S, E, F.wave); }
        if (BOTH(7)) GRID_BAR();
    }
    if (IN(8)) {
        p_route(F, args.in[10]);
        { pg8::DenseOrder S; S.init(ws + WS_HS, ws + WS_WSD, T_, D_, 256, F.G, (int)blockIdx.x);
          EpiRes E{X1, X1};
          pg8::gemm_phase<EpiRes, pg8::DenseOrder, true>(F.lds + RING_OFF, 256, S, E, F.wave); }
        if (BOTH(8)) GRID_BAR();
    }
    if (IN(9)) { p_assign(F); if (BOTH(9)) GRID_BAR(); }

    if (IN(10)) {
        moe_tables(F);
        const int nblk = (int)((LAS unsigned*)(F.lds + LX_PST))[256];
        MoeUpOrder S{(const LAS unsigned short*)(F.lds + LX_BLKE), nblk * 2, (const int*)(ws + WS_ROWTOK), (const char*)(ws + WS_XB), (const char*)(ws + WS_WGU), F.G, (int)blockIdx.x};
        EpiMoeUp E{(bf16*)(ws + WS_H)};
        pg8::gemm_phase<EpiMoeUp, MoeUpOrder, true>(F.lds + RING_OFF, D_, S, E, F.wave);
        if (BOTH(10)) GRID_BAR();
    }
    if (IN(11)) {
        moe_tables(F);
        const int nblk = (int)((LAS unsigned*)(F.lds + LX_PST))[256];
        MoeDownOrder S{(const LAS unsigned short*)(F.lds + LX_BLKE), nblk * 4, (const char*)(ws + WS_H), (const char*)(ws + WS_WD), F.G, (int)blockIdx.x};
        EpiMoeDown E{(bf16*)(ws + WS_YLO), (bf16*)(ws + WS_YHI), (const int*)(ws + WS_ROWDST), (const float*)(ws + WS_ROWW)};
        pg8::gemm_phase<EpiMoeDown, MoeDownOrder, true>(F.lds + RING_OFF, 256, S, E, F.wave);
        if (BOTH(11)) GRID_BAR();
    }
    if (IN(12)) {
        const int gw = F.vcu * NWAVES + F.wave, NGW = F.G * NWAVES;
        for (int m = gw; m < T_; m += NGW) ln_row<true, true>(F, X1, X1, (bf16*)(ws + WS_XB), args.in[17], args.in[18], (const bf16*)(ws + WS_YLO), (const bf16*)(ws + WS_YHI), m);
        if (BOTH(12)) GRID_BAR();
    }
    if (IN(13)) {
        pg8::DenseOrder S; S.init(ws + WS_XB, ws + WS_WPG, T_, D_, D_, F.G, (int)blockIdx.x);
        EpiPle E{X1, (const bf16*)(ws + WS_PP)};
        pg8::gemm_phase<EpiPle, pg8::DenseOrder, true>(F.lds + RING_OFF, D_, S, E, F.wave);
        if (BOTH(13)) GRID_BAR();
    }
    if (IN(14)) {
        const int gw = F.vcu * NWAVES + F.wave, NGW = F.G * NWAVES;
        for (int m = gw; m < T_; m += NGW) ln_row<false, false>(F, X1, X1, nullptr, args.in[21], args.in[22], nullptr, nullptr, m);
    }
#if defined(MK_DBG_OFF)
    if (lo <= 14 && 14 < hi) { const int lane_ = lane_id(), tid_ = F.wave * 64 + lane_; const bf16* src = (const bf16*)(ws + (size_t)(MK_DBG_OFF));
        for (size_t i = (size_t)F.vcu * 512 + tid_; i < (size_t)T_ * D_ / 8; i += (size_t)F.G * 512) { const v4u w = *(const v4u*)(src + (i % (size_t)(MK_DBG_WRAP)) * 8);
            f32x4 a, b; a.x = bf_lo(w.x); a.y = bf_hi(w.x); a.z = bf_lo(w.y); a.w = bf_hi(w.y); b.x = bf_lo(w.z); b.y = bf_hi(w.z); b.z = bf_lo(w.w); b.w = bf_hi(w.w);
            *(f32x4*)(args.out + i * 8) = a; *(f32x4*)(args.out + i * 8 + 4) = b; } }
#endif
#undef IN
#undef BOTH
#undef GRID_BAR
}

extern "C" void kernel_launch(void* const* d_in, const int* in_sizes, int n_in, void* d_out, int out_size, void* d_ws, size_t ws_size, hipStream_t stream) {
    static int grid = 0;
    if (grid == 0) {
        if (n_in != 23 || in_sizes[0] != T_ * D_ || out_size != T_ * D_ || ws_size < WS_END) { fprintf(stderr, "kernel_launch: unexpected shapes (n_in %d, in0 %d, out %d, ws %zu); nothing launched\n", n_in, n_in > 0 ? in_sizes[0] : -1, out_size, ws_size); grid = -1; return; }
        int dev = 0, cus = 0, per_cu = 0;
        if (hipGetDevice(&dev) != hipSuccess || hipDeviceGetAttribute(&cus, hipDeviceAttributeMultiprocessorCount, dev) != hipSuccess) { fprintf(stderr, "kernel_launch: device query failed\n"); grid = -1; return; }
        if (hipFuncSetAttribute((const void*)fwd_kernel, hipFuncAttributeMaxDynamicSharedMemorySize, LDS_BYTES) != hipSuccess) { fprintf(stderr, "kernel_launch: hipFuncSetAttribute failed\n"); grid = -1; return; }
        if (hipOccupancyMaxActiveBlocksPerMultiprocessor(&per_cu, (const void*)fwd_kernel, NWAVES * 64, LDS_BYTES) != hipSuccess || per_cu < 1)
            fprintf(stderr, "kernel_launch: note: occupancy query reports %d workgroups per CU\n", per_cu);
        (void)hipGetLastError();
        grid = cus;
    }
    if (grid < 0) return;
    if (hipMemsetAsync((char*)d_ws + WS_CTL, 0, CTL_ZERO_BYTES, stream) != hipSuccess) { fprintf(stderr, "kernel_launch: memset failed\n"); return; }
    Args a{};
    for (int i = 0; i < 23; ++i) a.in[i] = (const float*)d_in[i];
    a.out = (float*)d_out; a.ws = (unsigned char*)d_ws; a.pad = 0;
    for (int li = 0; li < N_LAUNCHES; ++li) {
        a.ph_lo = (N_LAUNCHES == 1) ? 0 : li; a.ph_hi = (N_LAUNCHES == 1) ? NPH : li + 1; a.li = li;
        hipLaunchKernelGGL(fwd_kernel, dim3(grid), dim3(NWAVES * 64), LDS_BYTES, stream, a);
        const hipError_t le = hipPeekAtLastError();
        if (le != hipSuccess) { fprintf(stderr, "kernel_launch: launch %d failed: %s\n", li, hipGetErrorName(le)); break; }
    }
}
```

```cpp
#include <hip/hip_runtime.h>
#include <hip/hip_bf16.h>
#include <cstdio>
#include <cstdint>
#include <cmath>

#ifndef MK_N_LAUNCHES
#define MK_N_LAUNCHES 1
#endif

constexpr int NB_ = 8, SEQ_ = 4096, T_ = NB_ * SEQ_, D_ = 1024;
constexpr int NH_ = 8, HD_ = 64, AW_ = 512, CW_ = 512, INW_ = 5120;
constexpr int NE_ = 256, ED_ = 256, TOPK_ = 8, PLE_ = 256;
constexpr int NBLK_ = 16;
constexpr float LN_EPS_ = 1e-5f;
constexpr float DN_ALPHA_ = 1.189207115002721f;
constexpr float ROUTED_SCALE_ = 2.5f;
constexpr int RMAX_ = T_ * TOPK_ + NE_ * 256;

#define GAS __attribute__((address_space(1)))
#define LAS __attribute__((address_space(3)))
typedef unsigned short bf16;
typedef unsigned v4u __attribute__((ext_vector_type(4)));
typedef float f32x4 __attribute__((ext_vector_type(4)));
typedef float f32x2 __attribute__((ext_vector_type(2)));
typedef unsigned u32x2 __attribute__((ext_vector_type(2)));
typedef short bf16x8 __attribute__((ext_vector_type(8)));
typedef GAS unsigned gu32;
#define RLX_AGENT __ATOMIC_RELAXED, __HIP_MEMORY_SCOPE_AGENT
#define LDS_WAIT() asm volatile("s_waitcnt lgkmcnt(0)" ::: "memory")
#define VM_WAIT() asm volatile("s_waitcnt vmcnt(0)" ::: "memory")

typedef float cvt_f32x2_t __attribute__((ext_vector_type(2))); typedef __bf16 cvt_bf16x2_t __attribute__((ext_vector_type(2)));
__device__ __forceinline__ unsigned cvt_pk_bf16(float lo, float hi) { cvt_f32x2_t v = {lo, hi}; cvt_bf16x2_t b = __builtin_convertvector(v, cvt_bf16x2_t); return __builtin_bit_cast(unsigned, b); }
__device__ __forceinline__ float bf_lo(unsigned w) { return __builtin_bit_cast(float, w << 16); }
__device__ __forceinline__ float bf_hi(unsigned w) { return __builtin_bit_cast(float, w & 0xffff0000u); }
__device__ __forceinline__ int lane_id() { unsigned ones = ~0u; asm volatile("" : "+s"(ones)); return (int)__builtin_amdgcn_mbcnt_hi(ones, __builtin_amdgcn_mbcnt_lo(ones, 0u)); }
__device__ __forceinline__ float sigmoidf_(float x) { return __builtin_amdgcn_rcpf(1.0f + __builtin_amdgcn_exp2f(-1.4426950408889634f * x)); }

namespace pg8 {
#define PG8_LAS __attribute__((address_space(3)))
constexpr int BM = 256, BK = 64, HALF = 128, HTB = HALF * BK * 2  , STAGE_BYTES = 8 * HTB, NXCD = 8, WGM = 8;

__host__ __device__ __forceinline__ int lds_byte(int r, int c) { const int st = (r >> 4) * 2 + (c >> 5), rr = r & 15, cc = c & 31, ob = rr * 64 + cc * 2; return st * 1024 + (ob ^ (((ob >> 9) & 1) << 5)); }
__host__ __device__ __forceinline__ void stage_rc(int b, int& R, int& C) { const int st = b / 1024, sb = b % 1024, swz = sb ^ (((sb >> 9) & 1) << 5); R = (st >> 1) * 16 + swz / 64; C = (st & 1) * 32 + (swz % 64) / 2; }
__host__ __device__ __forceinline__ int perm32(int rho) { const int n = rho >> 4, i = rho & 15; return 8 * (i >> 2) + 4 * n + (i & 3); }

struct Unit { const char* a; const char* b; int row0, pn, e; };

struct DenseOrder {
    const char* A; const char* Bt; int K, nM, nN, nwg, G, c;
    static constexpr bool GATHER = false;
    __device__ __forceinline__ void init(const void* A_, const void* Bt_, int M, int N, int K_, int G_, int c_) { A = (const char*)A_; Bt = (const char*)Bt_; K = K_; nM = M / BM; nN = N / BM; nwg = nM * nN; G = G_; c = c_; }
    __device__ __forceinline__ bool next(int i, Unit& u) const {
        const long L = (long)i * G + c; if (L >= nwg) return false;
        int wgid = (int)L; { const int q = nwg / NXCD, r = nwg % NXCD, xcd = wgid % NXCD, off = wgid / NXCD; wgid = (xcd < r ? xcd * (q + 1) : r * (q + 1) + (xcd - r) * q) + off; }
        const int nig = WGM * nN, gid = wgid / nig, fm = gid * WGM, gsz = (nM - fm) < WGM ? (nM - fm) : WGM;
        const int pm = fm + ((wgid % nig) % gsz); int pn = (wgid % nig) / gsz;
#ifdef MK_REV_PN
        if (nN == 20) pn = 19 - pn;
#endif
        u.a = A + (size_t)pm * BM * K * 2; u.b = Bt + (size_t)pn * BM * K * 2; u.row0 = pm * BM; u.pn = pn; u.e = 0; return true;
    }
};

template <class Epi, class Sched, bool ALIGN_EPI>
__device__ __forceinline__ void gemm_phase(PG8_LAS unsigned char* lds, const int K, const Sched& S, const Epi& E, const int wid) {
    const int lane = lane_id(), tid = wid * 64 + lane, wr = wid >> 2, wc = wid & 3, fr = lane & 15, fq = lane >> 4;
    const int nt = K / BK;
    constexpr int NVA = Sched::GATHER ? 2 : 1;
    unsigned voffA[NVA][2], voffB[2];
#pragma unroll
    for (int i = 0; i < 2; ++i) { int R, C; stage_rc(tid * 16 + i * 8192, R, C); const int Rb = Epi::PERM ? ((R & ~31) + perm32(R & 31)) : R;
        voffB[i] = (unsigned)(Rb * K + C) * 2u; if constexpr (!Sched::GATHER) voffA[0][i] = (unsigned)(R * K + C) * 2u; }
    const size_t kstep = (size_t)(BK * 2);
    const size_t hstep = (size_t)HALF * K * 2;
    const size_t hstepA = Sched::GATHER ? 0 : hstep;
    const unsigned ldsw = (unsigned)wid * 1024u;
    const int aoff = lds_byte(wr * 64 + fr, fq * 8), boff = lds_byte(wc * 32 + fr, fq * 8);
#define PG8_SA(b, h) (((b) * 2 + (h)) * HTB)
#define PG8_SB(b, h) ((4 + (b) * 2 + (h)) * HTB)
#define PG8_STAGE(bufoff, gbase, voff) do { _Pragma("unroll") for (int _i = 0; _i < 2; ++_i) \
        __builtin_amdgcn_global_load_lds((const unsigned*)((const char*)(gbase) + (voff)[_i]), (PG8_LAS unsigned*)(lds + (bufoff) + ldsw + _i * 8192), 16, 0, 0); } while (0)
#define PG8_LDA(dst, b, h) do { _Pragma("unroll") for (int m = 0; m < 4; ++m) _Pragma("unroll") for (int k = 0; k < 2; ++k) dst[m][k] = *(const PG8_LAS bf16x8*)(lds + PG8_SA(b, h) + aoff + m * 2048 + k * 1024); } while (0)
#define PG8_LDB(dst, b, h) do { _Pragma("unroll") for (int n = 0; n < 2; ++n) _Pragma("unroll") for (int k = 0; k < 2; ++k) dst[n][k] = *(const PG8_LAS bf16x8*)(lds + PG8_SB(b, h) + boff + n * 2048 + k * 1024); } while (0)
#define PG8_MMA(ai, bj, At, Bt) do { __builtin_amdgcn_s_setprio(1); _Pragma("unroll") for (int m = 0; m < 4; ++m) _Pragma("unroll") for (int n = 0; n < 2; ++n) _Pragma("unroll") for (int k = 0; k < 2; ++k) \
        acc[ai][bj][m][n] = __builtin_amdgcn_mfma_f32_16x16x32_bf16(Bt[n][k], At[m][k], acc[ai][bj][m][n], 0, 0, 0); __builtin_amdgcn_s_setprio(0); } while (0)
#ifdef MK_DRAIN
#define PG8_WAIT_V(n) asm volatile("s_waitcnt vmcnt(0)" ::: "memory")
#else
#define PG8_WAIT_V(n) asm volatile("s_waitcnt vmcnt(" #n ")" ::: "memory")
#endif
#define PG8_WAIT_L(n) asm volatile("s_waitcnt lgkmcnt(" #n ")" ::: "memory")
#define PG8_BAR __builtin_amdgcn_s_barrier()
#define PG8_SCHED __builtin_amdgcn_sched_barrier(0)
    Unit cur, nxt; int ui = 0;
    if (!S.next(0, cur)) return;
    if constexpr (Sched::GATHER) S.aoff(cur, tid, voffA);
    f32x4 acc[2][2][4][2];
#pragma unroll
    for (int a = 0; a < 2; ++a)
#pragma unroll
        for (int b = 0; b < 2; ++b)
#pragma unroll
            for (int m = 0; m < 4; ++m)
#pragma unroll
                for (int n = 0; n < 2; ++n) acc[a][b][m][n] = (f32x4){0.f, 0.f, 0.f, 0.f};
    bf16x8 At[4][2], B0[2][2], B1[2][2];
    PG8_STAGE(PG8_SB(0, 0), cur.b, voffB); PG8_STAGE(PG8_SB(0, 1), cur.b + hstep, voffB); PG8_STAGE(PG8_SA(0, 0), cur.a, voffA[0]); PG8_STAGE(PG8_SA(0, 1), cur.a + hstepA, voffA[NVA - 1]);
    if (wr == 1) PG8_BAR;
    PG8_WAIT_V(2); PG8_BAR;
    PG8_STAGE(PG8_SB(1, 0), cur.b + kstep, voffB); PG8_STAGE(PG8_SA(1, 0), cur.a + kstep, voffA[0]); PG8_STAGE(PG8_SB(1, 1), cur.b + hstep + kstep, voffB);
    PG8_WAIT_V(6); PG8_BAR;
    for (;;) {
        const bool has_next = S.next(ui + 1, nxt);
        const char* nA = has_next ? nxt.a : cur.a; const char* nB = has_next ? nxt.b : cur.b;
#pragma nounroll
        for (int t = 0; t < nt; t += 2) {
            const bool last = (t == nt - 2);
            const char* a1 = cur.a + (size_t)(t + 1) * kstep;
            const char* a2 = last ? nA : cur.a + (size_t)(t + 2) * kstep; const char* b2 = last ? nB : cur.b + (size_t)(t + 2) * kstep;
            const char* a3 = a2 + kstep; const char* b3 = b2 + kstep;
            PG8_LDB(B0, 0, 0); PG8_LDB(B1, 0, 1); PG8_SCHED; PG8_LDA(At, 0, 0); PG8_STAGE(PG8_SA(1, 1), a1 + hstepA, voffA[NVA - 1]);
            if constexpr (Sched::GATHER) { if (last && has_next) S.aoff(nxt, tid, voffA); }
            PG8_WAIT_V(8); PG8_WAIT_L(0); PG8_BAR; PG8_MMA(0, 0, At, B0); PG8_MMA(0, 1, At, B1); PG8_BAR; PG8_SCHED;
            PG8_LDA(At, 0, 1); PG8_STAGE(PG8_SB(0, 0), b2, voffB); PG8_STAGE(PG8_SB(0, 1), b2 + hstep, voffB); PG8_STAGE(PG8_SA(0, 0), a2, voffA[0]);
            PG8_WAIT_V(8); PG8_WAIT_L(0); PG8_BAR; PG8_MMA(1, 0, At, B0); PG8_MMA(1, 1, At, B1); PG8_BAR; PG8_SCHED;
            PG8_LDB(B0, 1, 0); PG8_LDB(B1, 1, 1); PG8_SCHED; PG8_LDA(At, 1, 0); PG8_STAGE(PG8_SA(0, 1), a2 + hstepA, voffA[NVA - 1]);
            PG8_WAIT_V(8); PG8_WAIT_L(0); PG8_BAR; PG8_MMA(0, 0, At, B0); PG8_MMA(0, 1, At, B1); PG8_BAR; PG8_SCHED;
            PG8_LDA(At, 1, 1); PG8_STAGE(PG8_SB(1, 0), b3, voffB); PG8_STAGE(PG8_SB(1, 1), b3 + hstep, voffB); PG8_STAGE(PG8_SA(1, 0), a3, voffA[0]);
            PG8_WAIT_V(8); PG8_WAIT_L(0); PG8_BAR; PG8_MMA(1, 0, At, B0); PG8_MMA(1, 1, At, B1); PG8_BAR; PG8_SCHED;
        }
        if constexpr (ALIGN_EPI) { if (wr == 0) PG8_BAR; }
        E(acc, cur, wr, wc, fr, fq);
        if (!has_next) break;
#pragma unroll
        for (int a = 0; a < 2; ++a)
#pragma unroll
            for (int b = 0; b < 2; ++b)
#pragma unroll
                for (int m = 0; m < 4; ++m)
#pragma unroll
                    for (int n = 0; n < 2; ++n) acc[a][b][m][n] = (f32x4){0.f, 0.f, 0.f, 0.f};
        cur = nxt; ++ui;
        if constexpr (ALIGN_EPI) { if (wr == 1) PG8_BAR; }
    }
    PG8_WAIT_V(0);
    if constexpr (!ALIGN_EPI) { if (wr == 0) PG8_BAR; }
    PG8_BAR;
#undef PG8_SA
#undef PG8_SB
#undef PG8_STAGE
#undef PG8_LDA
#undef PG8_LDB
#undef PG8_MMA
#undef PG8_WAIT_V
#undef PG8_WAIT_L
#undef PG8_BAR
#undef PG8_SCHED
}
}

namespace attn_body {
using bf16=__hip_bfloat16;
using bf16x8=__attribute__((ext_vector_type(8)))short;
using s16x4=__attribute__((ext_vector_type(4)))short;
using f32x16=__attribute__((ext_vector_type(16)))float;
using u32x4=__attribute__((ext_vector_type(4)))unsigned;
constexpr int BATCH=8,NHEAD=8,SEQ=4096,D=64,DM=NHEAD*D;
constexpr int NW=8,QBLK=32,QB=QBLK*NW,KVBLK=64,NQB=SEQ/QB;
__device__ __forceinline__ int crow(int r,int hi){return (r&3)+8*(r>>2)+4*hi;}
#define SBAR() __builtin_amdgcn_sched_barrier(0)
__device__ __forceinline__ void cmask(f32x16&p0,f32x16&p1,int qe,int hi){
  const float NEG=-INFINITY; int kb=4*hi;
  #pragma unroll
  for(int r=0;r<16;++r){int kv=kb+(r&3)+8*(r>>2); if(kv>qe)p0[r]=NEG; if(kv+32>qe)p1[r]=NEG;}
}
__device__ __forceinline__ void bmask(f32x16&p0,f32x16&p1,bool keep,float mhat){
  float pen=keep?-mhat:-INFINITY; asm volatile("":"+v"(pen));
  #pragma unroll
  for(int r=0;r<16;++r){p0[r]+=pen; p1[r]+=pen;}
}

constexpr int NSLOT=3, SLOTB=8192;
constexpr int LDS_K=0, LDS_V=NSLOT*SLOTB, LDS_WS=2*NSLOT*SLOTB, LDS_OST=LDS_WS+NW*64*4, LDS_BYTES=LDS_OST+NW*4096;
constexpr float C2=0.125f*1.4426950408889634f;
__device__ __forceinline__ void glds16(const void*gsrc,unsigned lds_dst){unsigned keep;
  asm volatile("s_mov_b32 %0, m0\n\ts_mov_b32 m0, %2\n\ts_nop 0\n\tglobal_load_lds_dwordx4 %1, off\n\ts_mov_b32 m0, %0":"=&s"(keep):"v"(gsrc),"s"(lds_dst):"memory");}
__device__ __forceinline__ float max3f(float a,float b,float c){float r;asm("v_max3_f32 %0, %1, %2, %3":"=v"(r):"v"(a),"v"(b),"v"(c));return r;}
__device__ __forceinline__ float max2f(float a,float b){float r;asm("v_max_f32_e32 %0, %1, %2":"=v"(r):"v"(a),"v"(b));return r;}
__device__ __forceinline__ float fadd_s(float a,float b){float r;asm("v_add_f32_e32 %0, %1, %2":"=v"(r):"v"(a),"v"(b));return r;}
__device__ __forceinline__ float fsub_s(float a,float b){float r;asm("v_sub_f32_e32 %0, %1, %2":"=v"(r):"v"(a),"v"(b));return r;}
typedef float f32x2_t __attribute__((ext_vector_type(2))); typedef __bf16 bf16x2_t __attribute__((ext_vector_type(2)));
__device__ __forceinline__ unsigned cvtpk_s(float lo,float hi){f32x2_t v={lo,hi};bf16x2_t b=__builtin_convertvector(v,bf16x2_t);return __builtin_bit_cast(unsigned,b);}
#define WAIT_BAR(N) asm volatile("s_waitcnt vmcnt(" #N ") lgkmcnt(0)\n\ts_barrier":::"memory")

__device__ __forceinline__ void qkt(f32x16&p0,f32x16&p1,const char*Kslot,const bf16x8*qr,int r32,int hi){
  const char*kb=Kslot+hi*1024+r32*16;
  #pragma unroll
  for(int d0=0;d0<4;++d0){
    const bf16x8 b0=*reinterpret_cast<const bf16x8*>(kb+d0*2048);
    const bf16x8 b1=*reinterpret_cast<const bf16x8*>(kb+d0*2048+512);
    if(d0==0){p0=__builtin_amdgcn_mfma_f32_32x32x16_bf16(b0,qr[0],f32x16{},0,0,0);p1=__builtin_amdgcn_mfma_f32_32x32x16_bf16(b1,qr[0],f32x16{},0,0,0);}
    else{p0=__builtin_amdgcn_mfma_f32_32x32x16_bf16(b0,qr[d0],p0,0,0,0);p1=__builtin_amdgcn_mfma_f32_32x32x16_bf16(b1,qr[d0],p1,0,0,0);}}
}
typedef __attribute__((address_space(3))) const char* lds_cptr;
typedef short v4i16_t __attribute__((ext_vector_type(4)));
__device__ __forceinline__ void kload8(bf16x8*kf,lds_cptr kp){
  kf[0]=*(const __attribute__((address_space(3))) bf16x8*)(kp);      kf[1]=*(const __attribute__((address_space(3))) bf16x8*)(kp+512);
  kf[2]=*(const __attribute__((address_space(3))) bf16x8*)(kp+2048); kf[3]=*(const __attribute__((address_space(3))) bf16x8*)(kp+2560);
  kf[4]=*(const __attribute__((address_space(3))) bf16x8*)(kp+4096); kf[5]=*(const __attribute__((address_space(3))) bf16x8*)(kp+4608);
  kf[6]=*(const __attribute__((address_space(3))) bf16x8*)(kp+6144); kf[7]=*(const __attribute__((address_space(3))) bf16x8*)(kp+6656);
}
__device__ __forceinline__ void kload2(bf16x8*kf,lds_cptr kp,int j){ kf[2*j]=*(const __attribute__((address_space(3))) bf16x8*)(kp+j*2048); kf[2*j+1]=*(const __attribute__((address_space(3))) bf16x8*)(kp+j*2048+512); }
__device__ __forceinline__ s16x4 vtr(lds_cptr p){ return __builtin_bit_cast(s16x4,__builtin_amdgcn_ds_read_tr16_b64_v4i16((__attribute__((address_space(3))) v4i16_t*)p)); }
__device__ __forceinline__ float rowmax(const f32x16&p0,const f32x16&p1){
  float a=max3f(p0[0],p0[1],p1[0]),b=max3f(p0[2],p0[3],p1[1]);a=max3f(a,p1[2],p1[3]);
  #pragma unroll
  for(int r=4;r<16;r+=4){a=max3f(a,p0[r],p0[r+1]);b=max3f(b,p0[r+2],p0[r+3]);a=max3f(a,p1[r],p1[r+1]);b=max3f(b,p1[r+2],p1[r+3]);}
  const float m=max2f(a,b);
  auto rr=__builtin_amdgcn_permlane32_swap(__float_as_uint(m),__float_as_uint(m),false,false);
  return max2f(__uint_as_float(rr[0]),__uint_as_float(rr[1]));
}
__device__ __forceinline__ void pv(f32x16*o,int vb,bf16x8 pa0,bf16x8 pa1,bf16x8 pa2,bf16x8 pa3){
  #pragma unroll
  for(int d0=0;d0<2;++d0){s16x4 lo[4],hi[4];
    #pragma unroll
    for(int ks=0;ks<4;++ks){
      asm volatile("ds_read_b64_tr_b16 %0,%1 offset:%c2":"=&v"(lo[ks]):"v"(vb),"i"(d0*4096+ks*1024):"memory");
      asm volatile("ds_read_b64_tr_b16 %0,%1 offset:%c2":"=&v"(hi[ks]):"v"(vb),"i"(d0*4096+ks*1024+512):"memory");}
    asm volatile("s_waitcnt lgkmcnt(0)":::"memory");SBAR();
    #define PK(k) (bf16x8){lo[k][0],lo[k][1],lo[k][2],lo[k][3],hi[k][0],hi[k][1],hi[k][2],hi[k][3]}
    o[d0]=__builtin_amdgcn_mfma_f32_32x32x16_bf16(pa0,PK(0),o[d0],0,0,0);
    o[d0]=__builtin_amdgcn_mfma_f32_32x32x16_bf16(pa1,PK(1),o[d0],0,0,0);
    o[d0]=__builtin_amdgcn_mfma_f32_32x32x16_bf16(pa2,PK(2),o[d0],0,0,0);
    o[d0]=__builtin_amdgcn_mfma_f32_32x32x16_bf16(pa3,PK(3),o[d0],0,0,0);
    #undef PK
  }
}

#define ATTN_STORE16(p,v) (*(u32x4*)(p)=(v))
template<int THRL> __device__ __forceinline__ void attn_unit(int b,int h,int qb,const bf16*Q,const bf16*__restrict__ K,const bf16*__restrict__ V,bf16*O,const unsigned*SEL,char*shm,const int wid_){
  const int lane=lane_id(),r32=lane&31,hi=lane>>5; const int wid=wid_;
  const long rowbase=(long)b*SEQ; const int q0=qb*QB;
  const bf16*Qw=Q+(rowbase+q0+wid*QBLK)*DM+h*D;
  const bf16*Kh=K+rowbase*DM+h*D,*Vh=V+rowbase*DM+h*D;
  const unsigned lds0=(unsigned)(uintptr_t)shm;
  float*wsf=(float*)(shm+LDS_WS)+wid*64;
  const unsigned selm=SEL[((long)(b*NHEAD+h))*SEQ+q0+wid*QBLK+r32];
  const bf16*ksrc=Kh+(long)lane*DM+wid*8;
  const bf16*vsrc=Vh+(long)(16*(wid&3)+(lane>>2))*DM+(wid>>2)*32+(lane&3)*8;
  const unsigned kdst=lds0+LDS_K+wid*1024, vdst=lds0+LDS_V+wid*1024;
  #define DMA_K(t,slot) glds16(ksrc+(long)(t)*KVBLK*DM,(unsigned)__builtin_amdgcn_readfirstlane(kdst+(slot)))
  #define DMA_V(t,slot) glds16(vsrc+(long)(t)*KVBLK*DM,(unsigned)__builtin_amdgcn_readfirstlane(vdst+(slot)))
  const int vb0=(int)(lds0+LDS_V)+((lane>>4)&1)*32+(lane&3)*8+(4*hi+((lane&15)>>2))*64;
  const char*Kbase=shm+LDS_K; bf16x8 kf[8];
  const lds_cptr shm3=(lds_cptr)shm; const lds_cptr kp0=shm3+LDS_K+hi*1024+r32*16; const lds_cptr vp0=shm3+LDS_V+((lane>>4)&1)*32+(lane&3)*8+(4*hi+((lane&15)>>2))*64;
  const int NT=(q0+QB)/KVBLK;
  DMA_K(0,0);DMA_V(0,0);DMA_K(1,SLOTB);
  bf16x8 qr[4];
  #pragma unroll
  for(int d0=0;d0<4;++d0)qr[d0]=*reinterpret_cast<const bf16x8*>(&Qw[(long)r32*DM+d0*16+hi*8]);
  float mhat=0.f,l_reg=0.f;f32x16 o[2];o[0]=f32x16{};o[1]=f32x16{};
  const int qrel=wid*QBLK+r32;
  #define CMASK(P0,P1,t) do{const int jb_=(t)-(NT-4); if(jb_>=0){cmask(P0,P1,qrel-64*jb_,hi); bmask(P0,P1,true,mhat);} else bmask(P0,P1,((selm>>((t)>>2))&1u)!=0u,mhat);}while(0)
  bool resc=false;
  #define START(P0,P1) do{ const float rm=rowmax(P0,P1); resc=false; \
    { const float dl=__builtin_fmaxf(rm,-60.f); mhat=fadd_s(mhat,dl); \
      _Pragma("unroll") for(int r=0;r<16;++r){P0[r]=fsub_s(P0[r],dl);P1[r]=fsub_s(P1[r],dl);} } \
    _Pragma("unroll") for(int r=0;r<16;++r)P0[r]=__builtin_amdgcn_exp2f(P0[r]); }while(0)
  #define RESC() do{ if(resc){ asm volatile("s_waitcnt lgkmcnt(0)":::"memory"); \
      _Pragma("unroll") for(int d_=0;d_<2;++d_) _Pragma("unroll") for(int r=0;r<16;++r)o[d_][r]*=wsf[crow(r,hi)]; } }while(0)
  f32x16 pA0,pA1,pB0,pB1;
  int sl_prev=0,sl_cur=0,sl_next=SLOTB;
  #define ROT() do{sl_prev=sl_cur;sl_cur=sl_next;sl_next=(sl_next==(NSLOT-1)*SLOTB)?0:sl_next+SLOTB;}while(0)
  DMA_K(2,2*SLOTB);
  WAIT_BAR(3);
  qkt(pA0,pA1,Kbase,qr,r32,hi);asm volatile("s_nop 15\n\ts_nop 7":"+v"(pA0),"+v"(pA1));CMASK(pA0,pA1,0);
  START(pA0,pA1);
  _Pragma("unroll") for(int r=0;r<16;++r)pA1[r]=__builtin_amdgcn_exp2f(pA1[r]);
  WAIT_BAR(0);
  DMA_K(3,0);DMA_V(1,SLOTB);
  ROT();
  kload8(kf,kp0+sl_cur);
  WAIT_BAR(2);
  s16x4 vlo[8],vhi[8]; u32x4 pw0,pw1,pw2,pw3;
  #define PKW(P,B) cvtpk_s(P[B],P[B+1])
  #define PAF(k) __builtin_bit_cast(bf16x8,pw##k)
  #define VFR(i) (bf16x8){vlo[i][0],vlo[i][1],vlo[i][2],vlo[i][3],vhi[i][0],vhi[i][1],vhi[i][2],vhi[i][3]}
  #define PIN(x) asm volatile("":"+v"(x))
  #define MX3(a,b,c) __builtin_fmaxf(__builtin_fmaxf((a),(b)),(c))
  #define GAPA(MF,A0,A1,A2,A3,W0,W1,PW) do{ MF; sacc+=A0; sacc+=A1; sacc+=A2; sacc+=A3; PIN(sacc); W0; W1; PIN(PW); SBAR(); }while(0)
  #define EX(v) __builtin_amdgcn_exp2f(v)
  #define GAPB(MF,X,B) do{ MF; X[B]=EX(X[B]); X[B+1]=EX(X[B+1]); X[B+2]=EX(X[B+2]); X[B+3]=EX(X[B+3]); PIN(X); SBAR(); }while(0)
  #define VRD(i) do{ vlo[i]=vtr(vp_+(((i)>>2)*4096+((i)&3)*1024)); vhi[i]=vtr(vp_+(((i)>>2)*4096+((i)&3)*1024+512)); }while(0)
  #define KRD(G,j) do{ if(G){ kload2(kf,kp0+sl_next,j); SBAR(); } }while(0)
  #define STEP(C0,C1,P0,P1,t,GK,GV,GL) do{ SBAR(); \
    const lds_cptr vp_=vp0+sl_prev; \
    VRD(0); SBAR(); float sacc=(P0[0]+P0[1]); \
    GAPA(C0=__builtin_amdgcn_mfma_f32_32x32x16_bf16(kf[0],qr[0],f32x16{},0,0,0), P0[2],P0[3],P0[4],P0[5],     pw0[0]=PKW(P0,0), pw0[1]=PKW(P0,2), pw0); \
    VRD(4); SBAR(); GAPA(C1=__builtin_amdgcn_mfma_f32_32x32x16_bf16(kf[1],qr[0],f32x16{},0,0,0), P0[6],P0[7],P0[8],P0[9],     pw0[2]=PKW(P0,4), pw0[3]=PKW(P0,6), pw0); \
    VRD(1); SBAR(); GAPA(C0=__builtin_amdgcn_mfma_f32_32x32x16_bf16(kf[2],qr[1],C0,0,0,0),   P0[10],P0[11],P0[12],P0[13], pw1[0]=PKW(P0,8), pw1[1]=PKW(P0,10), pw1); \
    VRD(5); SBAR(); GAPA(C1=__builtin_amdgcn_mfma_f32_32x32x16_bf16(kf[3],qr[1],C1,0,0,0),   P0[14],P0[15],P1[0],P1[1],   pw1[2]=PKW(P0,12),pw1[3]=PKW(P0,14), pw1); \
    VRD(2); SBAR(); GAPA(C0=__builtin_amdgcn_mfma_f32_32x32x16_bf16(kf[4],qr[2],C0,0,0,0),   P1[2],P1[3],P1[4],P1[5],     pw2[0]=PKW(P1,0), pw2[1]=PKW(P1,2), pw2); \
    VRD(6); SBAR(); GAPA(C1=__builtin_amdgcn_mfma_f32_32x32x16_bf16(kf[5],qr[2],C1,0,0,0),   P1[6],P1[7],P1[8],P1[9],     pw2[2]=PKW(P1,4), pw2[3]=PKW(P1,6), pw2); \
    VRD(3); SBAR(); GAPA(C0=__builtin_amdgcn_mfma_f32_32x32x16_bf16(kf[6],qr[3],C0,0,0,0),   P1[10],P1[11],P1[12],P1[13], pw3[0]=PKW(P1,8), pw3[1]=PKW(P1,10), pw3); \
    VRD(7); SBAR(); GAPA(C1=__builtin_amdgcn_mfma_f32_32x32x16_bf16(kf[7],qr[3],C1,0,0,0),   P1[14],P1[15],0.f,0.f,       pw3[2]=PKW(P1,12),pw3[3]=PKW(P1,14), pw3); \
    l_reg+=sacc; \
    if(GK){DMA_K((t)+3,sl_cur);} if(GV){DMA_V((t)+1,sl_next);} \
    CMASK(C0,C1,t); \
    { float a=MX3(C0[0],C0[1],C1[0]),b=MX3(C0[2],C0[3],C1[1]); a=MX3(a,C1[2],C1[3]); \
      _Pragma("unroll") for(int r=4;r<16;r+=4){a=MX3(a,C0[r],C0[r+1]);b=MX3(b,C0[r+2],C0[r+3]);a=MX3(a,C1[r],C1[r+1]);b=MX3(b,C1[r+2],C1[r+3]);} \
      float rm=__builtin_fmaxf(a,b); { auto rr=__builtin_amdgcn_permlane32_swap(__float_as_uint(rm),__float_as_uint(rm),false,false); rm=__builtin_fmaxf(__uint_as_float(rr[0]),__uint_as_float(rr[1])); } \
      resc=false; \
      if(__builtin_expect(__any(rm>(float)THRL),0)){ const float dl=__builtin_fmaxf(rm,0.f); mhat+=dl; \
        _Pragma("unroll") for(int r=0;r<16;++r){C0[r]-=dl;C1[r]-=dl;} \
        const float f=__builtin_amdgcn_exp2f(-dl); l_reg*=f; if(hi==0)wsf[r32]=f; resc=true; } } \
    SBAR(); \
    GAPB(o[0]=__builtin_amdgcn_mfma_f32_32x32x16_bf16(PAF(0),VFR(0),o[0],0,0,0), C0,0); \
    GAPB(o[1]=__builtin_amdgcn_mfma_f32_32x32x16_bf16(PAF(0),VFR(4),o[1],0,0,0), C0,4); \
    KRD(GL,0); GAPB(o[0]=__builtin_amdgcn_mfma_f32_32x32x16_bf16(PAF(1),VFR(1),o[0],0,0,0), C0,8); \
    KRD(GL,1); GAPB(o[1]=__builtin_amdgcn_mfma_f32_32x32x16_bf16(PAF(1),VFR(5),o[1],0,0,0), C0,12); \
    KRD(GL,2); GAPB(o[0]=__builtin_amdgcn_mfma_f32_32x32x16_bf16(PAF(2),VFR(2),o[0],0,0,0), C1,0); \
    KRD(GL,3); GAPB(o[1]=__builtin_amdgcn_mfma_f32_32x32x16_bf16(PAF(2),VFR(6),o[1],0,0,0), C1,4); \
    GAPB(o[0]=__builtin_amdgcn_mfma_f32_32x32x16_bf16(PAF(3),VFR(3),o[0],0,0,0), C1,8); \
    GAPB(o[1]=__builtin_amdgcn_mfma_f32_32x32x16_bf16(PAF(3),VFR(7),o[1],0,0,0), C1,12); \
    }while(0)
  int t=1;
  #undef CMASK
  #define CMASK(P0,P1,t) bmask(P0,P1,((selm>>((t)>>2))&1u)!=0u,mhat)
  for(;t+5<NT;t+=2){
    STEP(pB0,pB1,pA0,pA1,t,true,true,true);     WAIT_BAR(2); RESC(); ROT();
    STEP(pA0,pA1,pB0,pB1,t+1,true,true,true);   WAIT_BAR(2); RESC(); ROT();
  }
  #undef CMASK
  #define CMASK(P0,P1,t) do{const int jb_=(t)-(NT-4); if(jb_>=0){cmask(P0,P1,qrel-64*jb_,hi); bmask(P0,P1,true,mhat);} else bmask(P0,P1,((selm>>((t)>>2))&1u)!=0u,mhat);}while(0)
  #define ENDW(tt) do{ if((tt)+3<NT){WAIT_BAR(2);} else if((tt)+2<NT){WAIT_BAR(1);} else {WAIT_BAR(0);} }while(0)
  for(;t+1<NT;t+=2){
    STEP(pB0,pB1,pA0,pA1,t,(t+3<NT),(t+1<NT),(t+1<NT));       ENDW(t);   RESC(); ROT();
    STEP(pA0,pA1,pB0,pB1,t+1,(t+4<NT),(t+2<NT),(t+2<NT));     ENDW(t+1); RESC(); ROT();
  }
  STEP(pB0,pB1,pA0,pA1,NT-1,false,false,false); RESC();
  { float sacc=pB0[0]+pB0[1]; _Pragma("unroll") for(int r=2;r<16;++r)sacc+=pB0[r]; _Pragma("unroll") for(int r=0;r<16;++r)sacc+=pB1[r]; l_reg+=sacc;
    pw0=(u32x4){PKW(pB0,0),PKW(pB0,2),PKW(pB0,4),PKW(pB0,6)};pw1=(u32x4){PKW(pB0,8),PKW(pB0,10),PKW(pB0,12),PKW(pB0,14)};pw2=(u32x4){PKW(pB1,0),PKW(pB1,2),PKW(pB1,4),PKW(pB1,6)};pw3=(u32x4){PKW(pB1,8),PKW(pB1,10),PKW(pB1,12),PKW(pB1,14)};
    SBAR(); pv(o,vb0+sl_cur,PAF(0),PAF(1),PAF(2),PAF(3)); }
  #undef PKW
  #undef PAF
  #undef VFR
  #undef PIN
  #undef MX3
  #undef GAPA
  #undef GAPB
  #undef EX
  #undef VRD
  #undef KRD
  #undef STEP
  #undef ENDW
  {auto rr=__builtin_amdgcn_permlane32_swap(__float_as_uint(l_reg),__float_as_uint(l_reg),false,false);l_reg=__uint_as_float(rr[0])+__uint_as_float(rr[1]);}
  if(hi==0)wsf[32+r32]=l_reg;asm volatile("s_waitcnt lgkmcnt(0)":::"memory");
  float rli[16];
  #pragma unroll
  for(int r=0;r<16;++r)rli[r]=__builtin_amdgcn_rcpf(wsf[32+crow(r,hi)]);
  bf16*Ow=O+(rowbase+q0+wid*QBLK)*DM+h*D;
  { bf16*stg=(bf16*)(shm+LDS_OST)+wid*2048;
    #pragma unroll
    for(int r=0;r<16;++r){const int orow=crow(r,hi);
      #pragma unroll
      for(int d0=0;d0<2;++d0)stg[orow*64+d0*32+r32]=__float2bfloat16(o[d0][r]*rli[r]);}
    asm volatile("s_waitcnt lgkmcnt(0)":::"memory");
    #pragma unroll
    for(int i=0;i<4;++i){const int row=i*8+(lane>>3),ch=lane&7; const u32x4 v=*(const u32x4*)(stg+row*64+ch*8); ATTN_STORE16(Ow+(long)row*DM+ch*8,v);} }
  asm volatile("s_waitcnt lgkmcnt(0)\n\ts_barrier":::"memory");
  #undef DMA_K
  #undef DMA_V
  #undef CMASK
  #undef START
  #undef RESC
  #undef ROT
}
constexpr int ATTN_LDS_BYTES=LDS_BYTES;
#undef SBAR
#undef WAIT_BAR
}

constexpr int NWAVES = 8;
constexpr int NPH = 15;
constexpr int N_LAUNCHES = MK_N_LAUNCHES;
static_assert(N_LAUNCHES == 1 || N_LAUNCHES == NPH, "MK_N_LAUNCHES is 1 or NPH");

constexpr size_t MiB = 1u << 20;
constexpr size_t WS_CTL = 0, CTL_ZERO_BYTES = 2 * MiB;
constexpr size_t WS_KMEAN = 1 * MiB;
constexpr size_t WS_GCOUNT = 1 * MiB + 512 * 1024;
constexpr size_t WS_WIN = 2 * MiB;
constexpr size_t WS_WAO = 12 * MiB, WS_WCO = 13 * MiB, WS_WOUT = 14 * MiB;
constexpr size_t WS_WSR = 16 * MiB;
constexpr size_t WS_WSD = 18 * MiB;
constexpr size_t WS_WPG = 19 * MiB, WS_WPP = 21 * MiB;
constexpr size_t WS_ROPE = 22 * MiB;
constexpr size_t WS_SEL = 22 * MiB + 512 * 1024;
constexpr size_t WS_PB = 24 * MiB;
constexpr size_t WS_TOPI = 40 * MiB, WS_TOPW = 41 * MiB, WS_LRANK = 42 * MiB;
constexpr size_t WS_ROWTOK = 43 * MiB, WS_ROWDST = 44 * MiB + 512 * 1024, WS_ROWW = 46 * MiB, WS_WGBASE = 47 * MiB + 256 * 1024;
constexpr size_t WS_WD = 48 * MiB;
constexpr size_t WS_WGU = 176 * MiB;
constexpr size_t WS_YLO = 176 * MiB;
constexpr size_t WS_XB = 432 * MiB;
constexpr size_t WS_S6 = 496 * MiB;
constexpr size_t WS_H = 496 * MiB;
constexpr size_t WS_YHI = 656 * MiB;
constexpr size_t WS_G = 688 * MiB;
constexpr size_t WS_P1 = 816 * MiB;
constexpr size_t WS_LOGITS = 912 * MiB;
constexpr size_t WS_HS = 944 * MiB;
constexpr size_t WS_PP = 960 * MiB;
constexpr size_t WS_END = 1024 * MiB;
static_assert(WS_H + (size_t)RMAX_ * 256 * 2 <= WS_YHI && WS_YHI + (size_t)T_ * 4 * 1024 * 2 <= WS_LOGITS && WS_WGU + (size_t)NE_ * 512 * 1024 * 2 <= WS_XB, "ws map");
static_assert(WS_ROWTOK + (size_t)RMAX_ * 4 <= WS_ROWDST && WS_ROWDST + (size_t)RMAX_ * 4 <= WS_ROWW && WS_ROWW + (size_t)RMAX_ * 4 <= WS_WGBASE, "ws tables");
constexpr int CW_BAR = 4096;

constexpr int RING_OFF = 0, RING_BYTES = 131072;
constexpr int LDSCTL_OFF = RING_BYTES, MISC_OFF = LDSCTL_OFF + 320;
constexpr int LX_HIST = LDSCTL_OFF + 512;
constexpr int LX_PST = LX_HIST + 1024;
constexpr int LX_NB = LX_PST + 1040;
constexpr int LX_BLKE = LX_NB + 1024;
constexpr int LX_XS = LX_BLKE + 2560;
constexpr int LDS_BYTES = 147456;
static_assert(LX_XS + 64 <= LDS_BYTES && attn_body::ATTN_LDS_BYTES <= RING_BYTES, "LDS map");

#define XB_TMO      128
#define XB_XCNT(j)  (256  + 64 * (j))
#define XB_XSUB(j)  (1280 + 64 * (j))
#define XB_XGEN(j)  (2304 + 64 * (j))
#define XB_TOP      3328
#define XB_TOPGEN   3392
#define XCD_BAR_WORDS 3456
#define XB_SPIN_CAP (1u << 18)

__device__ __forceinline__ unsigned xb_ld(unsigned* p)              { return __hip_atomic_load(p, __ATOMIC_RELAXED, __HIP_MEMORY_SCOPE_AGENT); }
__device__ __forceinline__ unsigned xb_add(unsigned* p, unsigned v) { return __hip_atomic_fetch_add(p, v, __ATOMIC_RELAXED, __HIP_MEMORY_SCOPE_AGENT); }
__device__ __forceinline__ unsigned xb_xcc_id() { return (unsigned)__builtin_amdgcn_s_getreg((3 << 11) | 20) & 0xFu; }
#define XB_SPIN(cond, bar) do { unsigned _sp = 0; while (cond) { __builtin_amdgcn_s_sleep(1); \
    if ((++_sp & 255u) == 0u) { if (xb_ld(&(bar)[XB_TMO])) break; if (_sp > XB_SPIN_CAP) { atomicAdd(&(bar)[XB_TMO], 1u); break; } } } } while (0)

struct XcdBarrier {
    unsigned* bar; unsigned x;
    volatile LAS unsigned* st;
};
__device__ __forceinline__ XcdBarrier xcd_barrier_post(unsigned* bar, volatile LAS unsigned* st, int wave) {
    XcdBarrier b; b.bar = bar; b.x = xb_xcc_id(); b.st = st;
    if (wave == 0 && lane_id() == 0) (void)xb_add(&bar[XB_XCNT(b.x)], 1u);
    return b;
}
__device__ __forceinline__ void xcd_barrier_complete(unsigned* bar, unsigned x, unsigned& nloc, unsigned& nx) {
    const unsigned G = gridDim.x * gridDim.y * gridDim.z;
    unsigned sum, cnt, mine, sp = 0u;
    for (;;) {
        sum = 0u; cnt = 0u; mine = 0u;
#pragma unroll
        for (unsigned j = 0; j < 16; ++j) { const unsigned c = xb_ld(&bar[XB_XCNT(j)]); sum += c; cnt += (c > 0u) ? 1u : 0u; mine = (j == x) ? c : mine; }
        if (sum == G) break;
        __builtin_amdgcn_s_sleep(1);
        if ((++sp & 255u) == 0u) { if (xb_ld(&bar[XB_TMO])) break; if (sp > XB_SPIN_CAP) { atomicAdd(&bar[XB_TMO], 1u); break; } }
    }
    nloc = mine > 0u ? mine : 1u; nx = cnt > 0u ? cnt : 1u;
}
__device__ __forceinline__ void xcd_barrier(const XcdBarrier& b, int wave) {
    asm volatile("s_waitcnt vmcnt(0)" ::: "memory");
    __syncthreads();
    if (wave == 0 && lane_id() == 0) {
        unsigned* bar = b.bar;
        __builtin_amdgcn_s_waitcnt(0);
        unsigned nloc = b.st[0], nx = b.st[1];
        if (nloc == 0u) { xcd_barrier_complete(bar, b.x, nloc, nx); b.st[0] = nloc; b.st[1] = nx; }
        const unsigned old = xb_add(&bar[XB_XSUB(b.x)], 1u);
        const unsigned gen = old / nloc;
        if (old + 1u == (gen + 1u) * nloc) {
            __builtin_amdgcn_fence(__ATOMIC_RELEASE, "agent");
            asm volatile("s_waitcnt vmcnt(0)" ::: "memory");
            const unsigned og = xb_add(&bar[XB_TOP], 1u);
            const unsigned tg = og / nx;
            if (og + 1u == (tg + 1u) * nx) xb_add(&bar[XB_TOPGEN], 1u);
            else XB_SPIN(xb_ld(&bar[XB_TOPGEN]) == tg, bar);
            __builtin_amdgcn_fence(__ATOMIC_ACQUIRE, "agent");
            xb_add(&bar[XB_XGEN(b.x)], 1u);
            asm volatile("s_waitcnt vmcnt(0)" ::: "memory");
        } else {
            XB_SPIN(xb_ld(&bar[XB_XGEN(b.x)]) == gen, bar);
            __builtin_amdgcn_fence(__ATOMIC_ACQUIRE, "agent");
            asm volatile("s_waitcnt vmcnt(0)" ::: "memory");
        }
    }
    __syncthreads();
}

struct Args { const float* in[23]; float* out; unsigned char* ws; int ph_lo, ph_hi, li, pad; };

struct Frame {
    LAS unsigned char* lds;
    volatile LAS unsigned* MISC;
    gu32* ctl;
    int wave;
    int vcu, G;
    unsigned char* ws; float* out;
};

__device__ __forceinline__ float wave_sum(float v) {
#pragma unroll
    for (int o = 1; o < 64; o <<= 1) v += __shfl_xor(v, o);
    return v;
}

__device__ __forceinline__ void xpose_item(const float* W, int N, int k0, int n0, bf16* dst, int Kd, LAS float* scr, int lane) {
#pragma unroll 8
    for (int i = 0; i < 32; ++i) { const int kk = 2 * i + (lane >> 5); scr[kk * 33 + (lane & 31)] = W[(size_t)(k0 + kk) * N + n0 + (lane & 31)]; }
    LDS_WAIT(); asm volatile("" ::: "memory");
    const int c = lane & 7;
#pragma unroll
    for (int j = 0; j < 4; ++j) { const int n = (lane >> 3) + 8 * j; const LAS float* s = scr + (8 * c) * 33 + n;
        v4u o; o.x = cvt_pk_bf16(s[0 * 33], s[1 * 33]); o.y = cvt_pk_bf16(s[2 * 33], s[3 * 33]); o.z = cvt_pk_bf16(s[4 * 33], s[5 * 33]); o.w = cvt_pk_bf16(s[6 * 33], s[7 * 33]);
        *(v4u*)(dst + (size_t)n * Kd + 8 * c) = o; }
    LDS_WAIT(); asm volatile("" ::: "memory");
}
__device__ __forceinline__ void xpose_mat(const float* W, int K, int N, bf16* WT, int rbase, int mode, int half, int r, LAS float* scr, int lane) {
    const int nblk = N / 32, kb = r / nblk, nb = r % nblk, k0 = 64 * kb, n0 = 32 * nb;
    const int drow = mode ? (rbase + (n0 >> 7) * 256 + half * 128 + (n0 & 127)) : (rbase + n0);
    xpose_item(W, N, k0, n0, WT + (size_t)drow * K + k0, K, scr, lane);
}
__device__ __forceinline__ void p0_prologue(Frame& F, const Args& A) {
    const int lane_ = lane_id(), tid_ = F.wave * 64 + lane_; (void)tid_;
    LAS float* scr = (LAS float*)(F.lds + RING_OFF + F.wave * 16384);
    unsigned char* ws = F.ws;
    const int gw = F.vcu * NWAVES + F.wave, NGW = F.G * NWAVES;
    constexpr int I_IN = 16 * 160, I_AO = 8 * 32, I_CO = 8 * 32, I_OUT = 16 * 32, I_R = 16 * 8, I_SG = 16 * 8, I_SU = 16 * 8, I_SD = 4 * 32, I_PG = 16 * 32, I_PP = 4 * 32;
    constexpr int NSMALL = I_IN + I_AO + I_CO + I_OUT + I_R + I_SG + I_SU + I_SD + I_PG + I_PP;
    for (int it = gw; it < NSMALL; it += NGW) {
        int r = it;
        if (r < I_IN) { xpose_mat(A.in[2], 1024, 5120, (bf16*)(ws + WS_WIN), 0, 0, 0, r, scr, lane_); continue; } r -= I_IN;
        if (r < I_AO) { xpose_mat(A.in[4], 512, 1024, (bf16*)(ws + WS_WAO), 0, 0, 0, r, scr, lane_); continue; } r -= I_AO;
        if (r < I_CO) { xpose_mat(A.in[5], 512, 1024, (bf16*)(ws + WS_WCO), 0, 0, 0, r, scr, lane_); continue; } r -= I_CO;
        if (r < I_OUT) { xpose_mat(A.in[6], 1024, 1024, (bf16*)(ws + WS_WOUT), 0, 0, 0, r, scr, lane_); continue; } r -= I_OUT;
        if (r < I_R) { xpose_mat(A.in[9], 1024, 256, (bf16*)(ws + WS_WSR), 512, 0, 0, r, scr, lane_); continue; } r -= I_R;
        if (r < I_SG) { xpose_mat(A.in[14], 1024, 256, (bf16*)(ws + WS_WSR), 0, 1, 0, r, scr, lane_); continue; } r -= I_SG;
        if (r < I_SU) { xpose_mat(A.in[15], 1024, 256, (bf16*)(ws + WS_WSR), 0, 1, 1, r, scr, lane_); continue; } r -= I_SU;
        if (r < I_SD) { xpose_mat(A.in[16], 256, 1024, (bf16*)(ws + WS_WSD), 0, 0, 0, r, scr, lane_); continue; } r -= I_SD;
        if (r < I_PG) { xpose_mat(A.in[19], 1024, 1024, (bf16*)(ws + WS_WPG), 0, 0, 0, r, scr, lane_); continue; } r -= I_PG;
        xpose_mat(A.in[20], 256, 1024, (bf16*)(ws + WS_WPP), 0, 0, 0, r, scr, lane_);
    }
    for (int it = gw; it < NE_ * 384; it += NGW) {
        const int e = it / 384; int r = it % 384;
        if (r < 128) { xpose_mat(A.in[11] + (size_t)e * 1024 * 256, 1024, 256, (bf16*)(ws + WS_WGU), e * 512, 1, 0, r, scr, lane_); continue; } r -= 128;
        if (r < 128) { xpose_mat(A.in[12] + (size_t)e * 1024 * 256, 1024, 256, (bf16*)(ws + WS_WGU), e * 512, 1, 1, r, scr, lane_); continue; } r -= 128;
        xpose_mat(A.in[13] + (size_t)e * 256 * 1024, 256, 1024, (bf16*)(ws + WS_WD), e * 1024, 0, 0, r, scr, lane_);
    }
    {
        const size_t gt = (size_t)F.vcu * 512 + tid_, NT = (size_t)F.G * 512;
#ifdef MK_FILL_G
        { v4u z; z.x = z.y = z.z = z.w = 0u; unsigned char* gp = ws + WS_G; for (size_t i = gt; i < (size_t)(128u << 20) / 16; i += NT) *(v4u*)(gp + i * 16) = z; }
#endif
        const float* x = A.in[0]; bf16* xb = (bf16*)(ws + WS_XB);
        for (size_t i = gt; i < (size_t)T_ * D_ / 8; i += NT) { const f32x4 a = *(const f32x4*)(x + i * 8), b = *(const f32x4*)(x + i * 8 + 4);
            v4u o; o.x = cvt_pk_bf16(a.x, a.y); o.y = cvt_pk_bf16(a.z, a.w); o.z = cvt_pk_bf16(b.x, b.y); o.w = cvt_pk_bf16(b.z, b.w); *(v4u*)(xb + i * 8) = o; }
        const float* p = A.in[1]; bf16* pb = (bf16*)(ws + WS_PB);
        for (size_t i = gt; i < (size_t)T_ * PLE_ / 8; i += NT) { const f32x4 a = *(const f32x4*)(p + i * 8), b = *(const f32x4*)(p + i * 8 + 4);
            v4u o; o.x = cvt_pk_bf16(a.x, a.y); o.y = cvt_pk_bf16(a.z, a.w); o.z = cvt_pk_bf16(b.x, b.y); o.w = cvt_pk_bf16(b.z, b.w); *(v4u*)(pb + i * 8) = o; }
        float* rope = (float*)(ws + WS_ROPE);
        for (size_t i = gt; i < (size_t)SEQ_ * 8; i += NT) {
            const int pos = (int)(i >> 3), fi = (int)(i & 7);
            const float invf = (float)exp(-(double)fi * 0.125 * log(500000.0));
            const float angf = (float)pos * invf;
            const double ang = (double)angf;
            const double kq = rint(ang * 0.63661977236758134308);
            const double rr = (ang - kq * 1.57079632679489655800) - kq * 6.12323399573676603587e-17;
            const double r2 = rr * rr;
            const double sn = rr * (1.0 + r2 * (-1.0 / 6 + r2 * (1.0 / 120 + r2 * (-1.0 / 5040 + r2 * (1.0 / 362880 + r2 * (-1.0 / 39916800 + r2 * (1.0 / 6227020800.0)))))));
            const double cs = 1.0 + r2 * (-0.5 + r2 * (1.0 / 24 + r2 * (-1.0 / 720 + r2 * (1.0 / 40320 + r2 * (-1.0 / 3628800 + r2 * (1.0 / 479001600.0 + r2 * (-1.0 / 87178291200.0)))))));
            const int q = (int)(((long long)kq) & 3);
            const double c = (q == 0) ? cs : (q == 1) ? -sn : (q == 2) ? -cs : sn;
            const double s = (q == 0) ? sn : (q == 1) ? cs : (q == 2) ? -sn : -cs;
            rope[pos * 16 + fi] = (float)c; rope[pos * 16 + 8 + fi] = (float)s;
        }
    }
}

typedef const f32x4 (&AccRef)[2][2][4][2];

struct EpiZ {
    static constexpr bool PERM = true;
    bf16* S6; bf16* Gt; const float* rope; float* kmean;
    __device__ __forceinline__ void operator()(AccRef acc, const pg8::Unit& u, int wr, int wc, int fr, int fq) const {
        const int pn = u.pn, row0 = u.row0 + wr * 64 + fr, ct0 = wc * 32 + 8 * fq;
        if (pn < 12) {
            bf16* base = S6 + (size_t)(pn >> 1) * T_ * 512 + (pn & 1) * 256 + ct0;
            const bool ropew = (pn < 4) && ((wc & 1) == 0);
            const bool isk = (pn == 2) || (pn == 3);
            const float sc = (pn < 2) ? attn_body::C2 : 1.f;
            float ks[2][8];
#pragma unroll
            for (int bj = 0; bj < 2; ++bj)
#pragma unroll
                for (int i = 0; i < 8; ++i) ks[bj][i] = 0.f;
#pragma unroll
            for (int ai = 0; ai < 2; ++ai)
#pragma unroll
                for (int m = 0; m < 4; ++m) {
                    const int r = row0 + ai * 128 + m * 16;
                    float cs[8], sn[8];
                    if (ropew) { const float* rp = rope + (size_t)(r & (SEQ_ - 1)) * 16; const f32x4 c0 = *(const f32x4*)rp, c1 = *(const f32x4*)(rp + 4), s0 = *(const f32x4*)(rp + 8), s1 = *(const f32x4*)(rp + 12);
                        cs[0] = c0.x; cs[1] = c0.y; cs[2] = c0.z; cs[3] = c0.w; cs[4] = c1.x; cs[5] = c1.y; cs[6] = c1.z; cs[7] = c1.w;
                        sn[0] = s0.x; sn[1] = s0.y; sn[2] = s0.z; sn[3] = s0.w; sn[4] = s1.x; sn[5] = s1.y; sn[6] = s1.z; sn[7] = s1.w; }
#pragma unroll
                    for (int bj = 0; bj < 2; ++bj) {
                        const f32x4 v0 = acc[ai][bj][m][0], v1 = acc[ai][bj][m][1];
                        float x[8] = {v0.x, v0.y, v0.z, v0.w, v1.x, v1.y, v1.z, v1.w};
                        if (ropew) {
#pragma unroll
                            for (int i = 0; i < 8; ++i) { const float o = __shfl_xor(x[i], 16);
                                const float a = x[i] * cs[i] - o * sn[i];
                                const float b = o * sn[i] + x[i] * cs[i];
                                x[i] = (fq == 0) ? a : (fq == 1) ? b : x[i]; }
                        }
                        if (isk) {
#pragma unroll
                            for (int i = 0; i < 8; ++i) ks[bj][i] += x[i];
                        }
                        v4u w; w.x = cvt_pk_bf16(x[0] * sc, x[1] * sc); w.y = cvt_pk_bf16(x[2] * sc, x[3] * sc); w.z = cvt_pk_bf16(x[4] * sc, x[5] * sc); w.w = cvt_pk_bf16(x[6] * sc, x[7] * sc);
                        *(v4u*)(base + (size_t)r * 512 + bj * 128) = w;
                    }
                }
            if (isk) {
                const int b = u.row0 / SEQ_, blk = (u.row0 % SEQ_) / 256;
#pragma unroll
                for (int bj = 0; bj < 2; ++bj)
#pragma unroll
                    for (int i = 0; i < 8; ++i) { float s = ks[bj][i]; s += __shfl_xor(s, 1); s += __shfl_xor(s, 2); s += __shfl_xor(s, 4); s += __shfl_xor(s, 8);
                        if (fr == 0) { const int c = (pn - 2) * 256 + bj * 128 + ct0 + i; atomicAdd(kmean + ((size_t)((b * NH_ + (c >> 6)) * NBLK_ + blk)) * 64 + (c & 63), s * (1.0f / 256.0f)); } }
            }
        } else {
            bf16* base = Gt + (size_t)((pn - 12) >> 2) * T_ * 1024 + (size_t)((pn - 12) & 3) * 256 + ct0;
#pragma unroll
            for (int ai = 0; ai < 2; ++ai)
#pragma unroll
                for (int m = 0; m < 4; ++m) { const int r = row0 + ai * 128 + m * 16;
#pragma unroll
                    for (int bj = 0; bj < 2; ++bj) { const f32x4 v0 = acc[ai][bj][m][0], v1 = acc[ai][bj][m][1];
#ifdef MK_RAW_GATES
                        v4u w; w.x = cvt_pk_bf16(v0.x, v0.y); w.y = cvt_pk_bf16(v0.z, v0.w); w.z = cvt_pk_bf16(v1.x, v1.y); w.w = cvt_pk_bf16(v1.z, v1.w);
#else
                        v4u w; w.x = cvt_pk_bf16(sigmoidf_(v0.x), sigmoidf_(v0.y)); w.y = cvt_pk_bf16(sigmoidf_(v0.z), sigmoidf_(v0.w)); w.z = cvt_pk_bf16(sigmoidf_(v1.x), sigmoidf_(v1.y)); w.w = cvt_pk_bf16(sigmoidf_(v1.z), sigmoidf_(v1.w));
#endif
                        *(v4u*)(base + (size_t)r * 1024 + bj * 128) = w; } }
        }
    }
};

template <bool ADD> struct EpiGate {
    static constexpr bool PERM = true;
    bf16* O; const bf16* gate;
    __device__ __forceinline__ void operator()(AccRef acc, const pg8::Unit& u, int wr, int wc, int fr, int fq) const {
        const int row0 = u.row0 + wr * 64 + fr, col0 = u.pn * 256 + wc * 32 + 8 * fq;
#pragma unroll
        for (int ai = 0; ai < 2; ++ai) {
            v4u g[4][2], p[4][2];
#pragma unroll
            for (int m = 0; m < 4; ++m)
#pragma unroll
                for (int bj = 0; bj < 2; ++bj) { const size_t off = (size_t)(row0 + ai * 128 + m * 16) * 1024 + col0 + bj * 128; g[m][bj] = *(const v4u*)(gate + off); if (ADD) p[m][bj] = *(const v4u*)(O + off); }
            asm volatile("" ::: "memory");
#pragma unroll
            for (int m = 0; m < 4; ++m)
#pragma unroll
                for (int bj = 0; bj < 2; ++bj) { const f32x4 v0 = acc[ai][bj][m][0], v1 = acc[ai][bj][m][1]; const v4u gg = g[m][bj];
                    float y[8] = {bf_lo(gg.x) * v0.x, bf_hi(gg.x) * v0.y, bf_lo(gg.y) * v0.z, bf_hi(gg.y) * v0.w, bf_lo(gg.z) * v1.x, bf_hi(gg.z) * v1.y, bf_lo(gg.w) * v1.z, bf_hi(gg.w) * v1.w};
                    if (ADD) { const v4u pp = p[m][bj]; y[0] += bf_lo(pp.x); y[1] += bf_hi(pp.x); y[2] += bf_lo(pp.y); y[3] += bf_hi(pp.y); y[4] += bf_lo(pp.z); y[5] += bf_hi(pp.z); y[6] += bf_lo(pp.w); y[7] += bf_hi(pp.w); }
                    v4u w; w.x = cvt_pk_bf16(y[0], y[1]); w.y = cvt_pk_bf16(y[2], y[3]); w.z = cvt_pk_bf16(y[4], y[5]); w.w = cvt_pk_bf16(y[6], y[7]);
                    *(v4u*)(O + (size_t)(row0 + ai * 128 + m * 16) * 1024 + col0 + bj * 128) = w; }
            asm volatile("" ::: "memory");
        }
    }
};

template <bool RBF> struct EpiRes {
    static constexpr bool PERM = true;
    bf16* O; const void* R;
    __device__ __forceinline__ void operator()(AccRef acc, const pg8::Unit& u, int wr, int wc, int fr, int fq) const {
        const int row0 = u.row0 + wr * 64 + fr, col0 = u.pn * 256 + wc * 32 + 8 * fq;
#pragma unroll
        for (int ai = 0; ai < 2; ++ai) {
            f32x4 ra[4][2], rb[4][2]; v4u rh[4][2];
#pragma unroll
            for (int m = 0; m < 4; ++m)
#pragma unroll
                for (int bj = 0; bj < 2; ++bj) { const size_t off = (size_t)(row0 + ai * 128 + m * 16) * D_ + col0 + bj * 128;
                    if (RBF) rh[m][bj] = *(const v4u*)((const bf16*)R + off); else { ra[m][bj] = *(const f32x4*)((const float*)R + off); rb[m][bj] = *(const f32x4*)((const float*)R + off + 4); } }
            asm volatile("" ::: "memory");
#pragma unroll
            for (int m = 0; m < 4; ++m)
#pragma unroll
                for (int bj = 0; bj < 2; ++bj) { const size_t off = (size_t)(row0 + ai * 128 + m * 16) * D_ + col0 + bj * 128; const f32x4 v0 = acc[ai][bj][m][0], v1 = acc[ai][bj][m][1];
                    float r[8];
                    if (RBF) { const v4u h = rh[m][bj]; r[0] = bf_lo(h.x); r[1] = bf_hi(h.x); r[2] = bf_lo(h.y); r[3] = bf_hi(h.y); r[4] = bf_lo(h.z); r[5] = bf_hi(h.z); r[6] = bf_lo(h.w); r[7] = bf_hi(h.w); }
                    else { const f32x4 a = ra[m][bj], b = rb[m][bj]; r[0] = a.x; r[1] = a.y; r[2] = a.z; r[3] = a.w; r[4] = b.x; r[5] = b.y; r[6] = b.z; r[7] = b.w; }
                    v4u w; w.x = cvt_pk_bf16(r[0] * DN_ALPHA_ + v0.x, r[1] * DN_ALPHA_ + v0.y); w.y = cvt_pk_bf16(r[2] * DN_ALPHA_ + v0.z, r[3] * DN_ALPHA_ + v0.w);
                    w.z = cvt_pk_bf16(r[4] * DN_ALPHA_ + v1.x, r[5] * DN_ALPHA_ + v1.y); w.w = cvt_pk_bf16(r[6] * DN_ALPHA_ + v1.z, r[7] * DN_ALPHA_ + v1.w);
                    *(v4u*)(O + off) = w; }
            asm volatile("" ::: "memory");
        }
    }
};

__device__ __forceinline__ void swiglu_store(AccRef acc, bf16* Hrow0  , int ld, int wr, int wc, int fr, int fq) {
#pragma unroll
    for (int ai = 0; ai < 2; ++ai)
#pragma unroll
        for (int m = 0; m < 4; ++m) { bf16* hp = Hrow0 + (size_t)(wr * 64 + fr + ai * 128 + m * 16) * ld + wc * 32 + 8 * fq;
            float y[8];
#pragma unroll
            for (int n = 0; n < 2; ++n)
#pragma unroll
                for (int j = 0; j < 4; ++j) { const float g = acc[ai][0][m][n][j], up = acc[ai][1][m][n][j]; y[n * 4 + j] = g * sigmoidf_(g) * up; }
            v4u w; w.x = cvt_pk_bf16(y[0], y[1]); w.y = cvt_pk_bf16(y[2], y[3]); w.z = cvt_pk_bf16(y[4], y[5]); w.w = cvt_pk_bf16(y[6], y[7]);
            *(v4u*)hp = w; asm volatile("" ::: "memory"); }
}
struct EpiShRouter {
    static constexpr bool PERM = true;
    bf16* Hs; float* logits;
    __device__ __forceinline__ void operator()(AccRef acc, const pg8::Unit& u, int wr, int wc, int fr, int fq) const {
        if (u.pn < 2) { swiglu_store(acc, Hs + (size_t)u.row0 * 256 + u.pn * 128, 256, wr, wc, fr, fq); return; }
#pragma unroll
        for (int ai = 0; ai < 2; ++ai)
#pragma unroll
            for (int m = 0; m < 4; ++m) { float* lp = logits + (size_t)(u.row0 + wr * 64 + fr + ai * 128 + m * 16) * 256 + wc * 32 + 8 * fq;
#pragma unroll
                for (int bj = 0; bj < 2; ++bj) { *(f32x4*)(lp + bj * 128) = acc[ai][bj][m][0]; *(f32x4*)(lp + bj * 128 + 4) = acc[ai][bj][m][1]; } asm volatile("" ::: "memory"); }
    }
};
struct EpiMoeUp {
    static constexpr bool PERM = true;
    bf16* H;
    __device__ __forceinline__ void operator()(AccRef acc, const pg8::Unit& u, int wr, int wc, int fr, int fq) const { swiglu_store(acc, H + (size_t)u.row0 * 256 + u.pn * 128, 256, wr, wc, fr, fq); }
};
struct EpiMoeDown {
    static constexpr bool PERM = true;
    bf16* Ylo; bf16* Yhi; const int* row_dst; const float* row_w;
    __device__ __forceinline__ void operator()(AccRef acc, const pg8::Unit& u, int wr, int wc, int fr, int fq) const {
        const int s0 = u.row0 + wr * 64 + fr, col0 = u.pn * 256 + wc * 32 + 8 * fq;
        int dsts[2][4]; float ws_[2][4];
#pragma unroll
        for (int ai = 0; ai < 2; ++ai)
#pragma unroll
            for (int m = 0; m < 4; ++m) { const int slot = s0 + ai * 128 + m * 16; dsts[ai][m] = row_dst[slot]; ws_[ai][m] = row_w[slot]; }
        asm volatile("" ::: "memory");
#pragma unroll
        for (int ai = 0; ai < 2; ++ai)
#pragma unroll
            for (int m = 0; m < 4; ++m) { const int dst = dsts[ai][m]; const float w = ws_[ai][m];
                if (dst >= 0) { bf16* yp = (dst < T_ * 4 ? Ylo + (size_t)dst * 1024 : Yhi + (size_t)(dst - T_ * 4) * 1024) + col0;
#pragma unroll
                    for (int bj = 0; bj < 2; ++bj) { const f32x4 v0 = acc[ai][bj][m][0] * w, v1 = acc[ai][bj][m][1] * w;
                        v4u o; o.x = cvt_pk_bf16(v0.x, v0.y); o.y = cvt_pk_bf16(v0.z, v0.w); o.z = cvt_pk_bf16(v1.x, v1.y); o.w = cvt_pk_bf16(v1.z, v1.w);
                        *(v4u*)(yp + bj * 128) = o; } } }
    }
};
struct EpiBf16Plain {
    static constexpr bool PERM = true;
    bf16* O; int ldc;
    __device__ __forceinline__ void operator()(AccRef acc, const pg8::Unit& u, int wr, int wc, int fr, int fq) const {
        const int row0 = u.row0 + wr * 64 + fr, col0 = u.pn * 256 + wc * 32 + 8 * fq;
#pragma unroll
        for (int ai = 0; ai < 2; ++ai)
#pragma unroll
            for (int m = 0; m < 4; ++m) { bf16* op = O + (size_t)(row0 + ai * 128 + m * 16) * ldc + col0;
#pragma unroll
                for (int bj = 0; bj < 2; ++bj) { const f32x4 v0 = acc[ai][bj][m][0], v1 = acc[ai][bj][m][1];
                    v4u o; o.x = cvt_pk_bf16(v0.x, v0.y); o.y = cvt_pk_bf16(v0.z, v0.w); o.z = cvt_pk_bf16(v1.x, v1.y); o.w = cvt_pk_bf16(v1.z, v1.w);
                    *(v4u*)(op + bj * 128) = o; } }
    }
};
struct EpiPle {
    static constexpr bool PERM = true;
    float* X; const bf16* Hres; const bf16* PP;
    __device__ __forceinline__ void operator()(AccRef acc, const pg8::Unit& u, int wr, int wc, int fr, int fq) const {
        const int row0 = u.row0 + wr * 64 + fr, col0 = u.pn * 256 + wc * 32 + 8 * fq;
#pragma unroll
        for (int ai = 0; ai < 2; ++ai) {
            v4u pv[4][2], hv[4][2];
#pragma unroll
            for (int m = 0; m < 4; ++m)
#pragma unroll
                for (int bj = 0; bj < 2; ++bj) { const size_t ro = (size_t)(row0 + ai * 128 + m * 16) * D_ + col0 + bj * 128; pv[m][bj] = *(const v4u*)(PP + ro); hv[m][bj] = *(const v4u*)(Hres + ro); }
            asm volatile("" ::: "memory");
#pragma unroll
            for (int m = 0; m < 4; ++m)
#pragma unroll
                for (int bj = 0; bj < 2; ++bj) { const size_t ro = (size_t)(row0 + ai * 128 + m * 16) * D_ + col0 + bj * 128; const f32x4 v0 = acc[ai][bj][m][0], v1 = acc[ai][bj][m][1];
                    const v4u p = pv[m][bj], h = hv[m][bj];
                    f32x4 o0, o1;
                    o0.x = bf_lo(h.x) * DN_ALPHA_ + sigmoidf_(v0.x) * bf_lo(p.x); o0.y = bf_hi(h.x) * DN_ALPHA_ + sigmoidf_(v0.y) * bf_hi(p.x); o0.z = bf_lo(h.y) * DN_ALPHA_ + sigmoidf_(v0.z) * bf_lo(p.y); o0.w = bf_hi(h.y) * DN_ALPHA_ + sigmoidf_(v0.w) * bf_hi(p.y);
                    o1.x = bf_lo(h.z) * DN_ALPHA_ + sigmoidf_(v1.x) * bf_lo(p.z); o1.y = bf_hi(h.z) * DN_ALPHA_ + sigmoidf_(v1.y) * bf_hi(p.z); o1.z = bf_lo(h.w) * DN_ALPHA_ + sigmoidf_(v1.z) * bf_lo(p.w); o1.w = bf_hi(h.w) * DN_ALPHA_ + sigmoidf_(v1.w) * bf_hi(p.w);
                    *(f32x4*)(X + ro) = o0; *(f32x4*)(X + ro + 4) = o1; }
            asm volatile("" ::: "memory");
        }
    }
};

struct EpiNull { static constexpr bool PERM = true; __device__ __forceinline__ void operator()(AccRef acc, const pg8::Unit& u, int, int, int, int) const { if (u.row0 == -12345) { float* p = nullptr; p[0] = acc[0][0][0][0].x; } } };
__device__ __forceinline__ void moe_tables(Frame& F) {
    const int lane_ = lane_id(), tid_ = F.wave * 64 + lane_; (void)tid_;
    LAS unsigned* PST = (LAS unsigned*)(F.lds + LX_PST); LAS unsigned* NB = (LAS unsigned*)(F.lds + LX_NB); LAS unsigned short* BLKE = (LAS unsigned short*)(F.lds + LX_BLKE);
    const unsigned* gcount = (const unsigned*)(F.ws + WS_GCOUNT);
    __syncthreads();
    if (tid_ < 256) NB[tid_] = (gcount[tid_] + 255u) >> 8;
    __syncthreads();
    if (tid_ < 256) { const int pe = (tid_ & 7) * 32 + (tid_ >> 3); unsigned s = 0, tot = 0; for (int j = 0; j < 256; ++j) { const unsigned nbj = NB[j]; tot += nbj; if (((j & 7) * 32 + (j >> 3)) < pe) s += nbj; }
        PST[tid_] = s * 256u; if (tid_ == 255) PST[256] = tot;
        LAS unsigned* XS = (LAS unsigned*)(F.lds + LX_XS); if (tid_ < 8) XS[tid_] = s; if (tid_ == 8) XS[8] = tot;
        const unsigned nb = NB[tid_]; for (unsigned i = 0; i < nb; ++i) BLKE[s + i] = (unsigned short)tid_; }
    __syncthreads();
}
struct MoeUpOrder {
    static constexpr bool GATHER = true;
    const LAS unsigned short* blke; const LAS unsigned* xs; const int* row_tok; const char* A; const char* Bt; int wpl, vcu;
    __device__ __forceinline__ bool next(int i, pg8::Unit& u) const {
        const int x = vcu / wpl, n = i * wpl + (vcu % wpl); if (x >= 8) return false;
        const int b0 = (int)xs[x], b1 = (int)xs[x + 1], rbl = n >> 1, pn = n & 1; if (rbl >= b1 - b0) return false;
        const int rb = b0 + rbl; const int e = __builtin_amdgcn_readfirstlane((int)blke[rb]);
        u.a = A; u.b = Bt + ((size_t)e * 512 + pn * 256) * 1024 * 2; u.row0 = rb * 256; u.pn = pn; u.e = e; return true;
    }
    __device__ __forceinline__ void aoff(const pg8::Unit& u, int tid, unsigned (&v)[2][2]) const {
#pragma unroll
        for (int i = 0; i < 2; ++i) { int R, C; pg8::stage_rc(tid * 16 + i * 8192, R, C);
#pragma unroll
            for (int h = 0; h < 2; ++h) { const int tok = row_tok[u.row0 + h * 128 + R]; v[h][i] = (unsigned)(tok * 1024 + C) * 2u; } }
    }
};
struct MoeDownOrder {
    static constexpr bool GATHER = false;
    const LAS unsigned short* blke; const LAS unsigned* xs; const char* A; const char* Bt; int wpl, vcu;
    __device__ __forceinline__ bool next(int i, pg8::Unit& u) const {
        const int x = vcu / wpl, n = i * wpl + (vcu % wpl); if (x >= 8) return false;
        const int b0 = (int)xs[x], b1 = (int)xs[x + 1], rbl = n >> 2, pn = n & 3; if (rbl >= b1 - b0) return false;
        const int rb = b0 + rbl; const int e = __builtin_amdgcn_readfirstlane((int)blke[rb]);
        u.a = A + (size_t)rb * 256 * 256 * 2; u.b = Bt + ((size_t)e * 1024 + pn * 256) * 256 * 2; u.row0 = rb * 256; u.pn = pn; u.e = e; return true;
    }
};

__device__ __forceinline__ void p_conv(Frame& F, const float* conv_w) {
    const int lane_ = lane_id(), tid_ = F.wave * 64 + lane_; (void)tid_;
    bf16* cb = (bf16*)(F.ws + WS_S6) + (size_t)3 * T_ * 512; const bf16* cc = (const bf16*)(F.ws + WS_S6) + (size_t)4 * T_ * 512; const bf16* ch = (const bf16*)(F.ws + WS_S6) + (size_t)5 * T_ * 512;
    const int gw = F.vcu * NWAVES + F.wave, NGW = F.G * NWAVES, c0 = lane_ * 8;
    float w0[8], w1[8], w2[8];
#pragma unroll
    for (int i = 0; i < 8; ++i) { w0[i] = conv_w[c0 + i]; w1[i] = conv_w[512 + c0 + i]; w2[i] = conv_w[1024 + c0 + i]; }
    for (int ck = gw; ck < T_ / 32; ck += NGW) {
        const int t0 = ck * 32;
        float u1[8], u2[8];
#pragma unroll
        for (int i = 0; i < 8; ++i) { u1[i] = 0.f; u2[i] = 0.f; }
        if ((t0 & (SEQ_ - 1)) != 0) {
            const v4u a2 = *(const v4u*)(cc + (size_t)(t0 - 2) * 512 + c0), b2 = *(const v4u*)(ch + (size_t)(t0 - 2) * 512 + c0);
            const v4u a1 = *(const v4u*)(cc + (size_t)(t0 - 1) * 512 + c0), b1 = *(const v4u*)(ch + (size_t)(t0 - 1) * 512 + c0);
            u2[0] = bf_lo(a2.x) * bf_lo(b2.x); u2[1] = bf_hi(a2.x) * bf_hi(b2.x); u2[2] = bf_lo(a2.y) * bf_lo(b2.y); u2[3] = bf_hi(a2.y) * bf_hi(b2.y);
            u2[4] = bf_lo(a2.z) * bf_lo(b2.z); u2[5] = bf_hi(a2.z) * bf_hi(b2.z); u2[6] = bf_lo(a2.w) * bf_lo(b2.w); u2[7] = bf_hi(a2.w) * bf_hi(b2.w);
            u1[0] = bf_lo(a1.x) * bf_lo(b1.x); u1[1] = bf_hi(a1.x) * bf_hi(b1.x); u1[2] = bf_lo(a1.y) * bf_lo(b1.y); u1[3] = bf_hi(a1.y) * bf_hi(b1.y);
            u1[4] = bf_lo(a1.z) * bf_lo(b1.z); u1[5] = bf_hi(a1.z) * bf_hi(b1.z); u1[6] = bf_lo(a1.w) * bf_lo(b1.w); u1[7] = bf_hi(a1.w) * bf_hi(b1.w);
        }
#pragma unroll 4
        for (int t = t0; t < t0 + 32; ++t) {
            const v4u a = *(const v4u*)(cc + (size_t)t * 512 + c0), b = *(const v4u*)(ch + (size_t)t * 512 + c0), g = *(const v4u*)(cb + (size_t)t * 512 + c0);
            float u0[8] = {bf_lo(a.x) * bf_lo(b.x), bf_hi(a.x) * bf_hi(b.x), bf_lo(a.y) * bf_lo(b.y), bf_hi(a.y) * bf_hi(b.y), bf_lo(a.z) * bf_lo(b.z), bf_hi(a.z) * bf_hi(b.z), bf_lo(a.w) * bf_lo(b.w), bf_hi(a.w) * bf_hi(b.w)};
            const float gb[8] = {bf_lo(g.x), bf_hi(g.x), bf_lo(g.y), bf_hi(g.y), bf_lo(g.z), bf_hi(g.z), bf_lo(g.w), bf_hi(g.w)};
            float y[8];
#pragma unroll
            for (int i = 0; i < 8; ++i) { y[i] = gb[i] * (w0[i] * u2[i] + w1[i] * u1[i] + w2[i] * u0[i]); u2[i] = u1[i]; u1[i] = u0[i]; }
            v4u o; o.x = cvt_pk_bf16(y[0], y[1]); o.y = cvt_pk_bf16(y[2], y[3]); o.z = cvt_pk_bf16(y[4], y[5]); o.w = cvt_pk_bf16(y[6], y[7]);
            *(v4u*)(cb + (size_t)t * 512 + c0) = o;
        }
    }
}
__device__ __forceinline__ void p_select(Frame& F) {
    const int lane_ = lane_id(), tid_ = F.wave * 64 + lane_; (void)tid_;
    const bf16* Q = (const bf16*)(F.ws + WS_S6); const float* kmean = (const float*)(F.ws + WS_KMEAN); unsigned* SEL = (unsigned*)(F.ws + WS_SEL);
    const int gt = F.vcu * 512 + tid_, NT = F.G * 512;
    for (int it = gt; it < NB_ * NH_ * SEQ_; it += NT) {
        const int s = it & (SEQ_ - 1), bh = it >> 12, b = bh >> 3, h = bh & 7;
        const int own = __builtin_amdgcn_readfirstlane(s >> 8);
        const int bhu = __builtin_amdgcn_readfirstlane(bh);
        float q[64];
        const bf16* qp = Q + ((size_t)(b * SEQ_ + s)) * 512 + h * 64;
#pragma unroll
        for (int i = 0; i < 8; ++i) { const v4u w = *(const v4u*)(qp + i * 8); q[i * 8 + 0] = bf_lo(w.x); q[i * 8 + 1] = bf_hi(w.x); q[i * 8 + 2] = bf_lo(w.y); q[i * 8 + 3] = bf_hi(w.y); q[i * 8 + 4] = bf_lo(w.z); q[i * 8 + 5] = bf_hi(w.z); q[i * 8 + 6] = bf_lo(w.w); q[i * 8 + 7] = bf_hi(w.w); }
        float v0 = -INFINITY, v1 = -INFINITY, v2 = -INFINITY; int i0 = -1, i1 = -1, i2 = -1;
        for (int j = 0; j < own; ++j) {
            const float* km = kmean + ((size_t)(bhu * NBLK_ + j)) * 64;
            float d = 0.f;
#pragma unroll
            for (int i = 0; i < 64; ++i) d += q[i] * km[i];
            if (d > v0) { v2 = v1; i2 = i1; v1 = v0; i1 = i0; v0 = d; i0 = j; }
            else if (d > v1) { v2 = v1; i2 = i1; v1 = d; i1 = j; }
            else if (d > v2) { v2 = d; i2 = j; }
        }
        unsigned m = 0u; if (i0 >= 0) m |= 1u << i0; if (i1 >= 0) m |= 1u << i1; if (i2 >= 0) m |= 1u << i2;
        SEL[it] = m;
    }
}

struct AttnOrder {
    int vcu;
    __device__ __forceinline__ bool next(int i, int& bh, int& qb) const { if (i >= 4 || vcu >= 256) return false; const int j = vcu & 3; bh = vcu >> 2; qb = (i == 0) ? 15 - j : (i == 1) ? 8 + j : (i == 2) ? 7 - j : j; return true; }
};

template <bool SRC_BF, bool ADD_Y, bool WRITE_F32, bool WRITE_BF>
__device__ __forceinline__ void ln_row(Frame& F, const void* src, float* dst, bf16* dstb, const float* gam, const float* bet, const bf16* y0, const bf16* y1, int row) {
    const int lane_ = lane_id();
    f32x4 v[4];
    if (SRC_BF) {
#pragma unroll
        for (int j = 0; j < 4; ++j) { const u32x2 w = *(const u32x2*)((const bf16*)src + (size_t)row * D_ + 256 * j + lane_ * 4); v[j].x = bf_lo(w.x); v[j].y = bf_hi(w.x); v[j].z = bf_lo(w.y); v[j].w = bf_hi(w.y); }
    } else {
        const f32x4* xr = (const f32x4*)((const float*)src + (size_t)row * D_) + lane_;
#pragma unroll
        for (int j = 0; j < 4; ++j) v[j] = xr[64 * j];
    }
    if (ADD_Y) {
        const bf16* yb = (row < T_ / 2) ? y0 + (size_t)row * 8 * 1024 : y1 + (size_t)(row - T_ / 2) * 8 * 1024;
#pragma unroll
        for (int k = 0; k < 8; ++k)
#pragma unroll
            for (int j = 0; j < 4; ++j) { const u32x2 w = *(const u32x2*)(yb + (size_t)k * 1024 + 256 * j + lane_ * 4); const unsigned w0 = w.x, w1 = w.y;
                v[j].x += bf_lo(w0); v[j].y += bf_hi(w0); v[j].z += bf_lo(w1); v[j].w += bf_hi(w1); }
    }
    float s = 0.f;
#pragma unroll
    for (int j = 0; j < 4; ++j) s += (v[j].x + v[j].y) + (v[j].z + v[j].w);
    const float mean = wave_sum(s) * (1.f / D_); float s2 = 0.f;
#pragma unroll
    for (int j = 0; j < 4; ++j) { v[j] = v[j] - mean; s2 += (v[j].x * v[j].x + v[j].y * v[j].y) + (v[j].z * v[j].z + v[j].w * v[j].w); }
    const float rstd = 1.f / sqrtf(wave_sum(s2) * (1.f / D_) + LN_EPS_);
#pragma unroll
    for (int j = 0; j < 4; ++j) { const f32x4 g = *((const f32x4*)gam + 64 * j + lane_), bb = *((const f32x4*)bet + 64 * j + lane_);
        const f32x4 o = v[j] * rstd * g + bb;
        if (WRITE_F32) *((f32x4*)(dst + (size_t)row * D_) + lane_ + 64 * j) = o;
        if (WRITE_BF) { u32x2 w; w.x = cvt_pk_bf16(o.x, o.y); w.y = cvt_pk_bf16(o.z, o.w); *(u32x2*)(dstb + (size_t)row * D_ + 256 * j + lane_ * 4) = w; } }
}

__device__ __forceinline__ void p_route(Frame& F, const float* router_bias) {
    const int lane_ = lane_id(), tid_ = F.wave * 64 + lane_; (void)tid_;
    LAS unsigned* hist = (LAS unsigned*)(F.lds + LX_HIST);
    const float* logits = (const float*)(F.ws + WS_LOGITS);
    int* topi = (int*)(F.ws + WS_TOPI); float* topw = (float*)(F.ws + WS_TOPW); int* lrank = (int*)(F.ws + WS_LRANK);
    unsigned* gcount = (unsigned*)(F.ws + WS_GCOUNT); unsigned* wgbase = (unsigned*)(F.ws + WS_WGBASE);
    { int* row_tok = (int*)(F.ws + WS_ROWTOK); int* row_dst = (int*)(F.ws + WS_ROWDST); float* row_w = (float*)(F.ws + WS_ROWW);
      for (int i = blockIdx.x * 512 + tid_; i < RMAX_; i += F.G * 512) { row_tok[i] = 0; row_dst[i] = -1; row_w[i] = 0.f; } }
    if (tid_ < 256) hist[tid_] = 0u;
    __syncthreads();
    const int lane = lane_;
    const f32x4 bias = *(const f32x4*)(router_bias + lane * 4);
    for (int tok = blockIdx.x * 8 + F.wave; tok < T_; tok += F.G * 8) {
        const f32x4 lg = *(const f32x4*)(logits + (size_t)tok * 256 + lane * 4);
        const float s0 = sigmoidf_(lg.x), s1 = sigmoidf_(lg.y), s2 = sigmoidf_(lg.z), s3 = sigmoidf_(lg.w);
        float c0 = s0 + bias.x, c1 = s1 + bias.y, c2 = s2 + bias.z, c3 = s3 + bias.w;
        float a1 = fmaxf(c0, c1), a2 = fminf(c0, c1); { const float b1 = fmaxf(c2, c3), b2 = fminf(c2, c3); const float n1 = fmaxf(a1, b1), n2 = fmaxf(fminf(a1, b1), fmaxf(a2, b2)); a1 = n1; a2 = n2; }
#pragma unroll
        for (int off = 1; off < 8; off <<= 1) { const float b1 = __shfl_xor(a1, off), b2 = __shfl_xor(a2, off); const float n1 = fmaxf(a1, b1), n2 = fmaxf(fminf(a1, b1), fmaxf(a2, b2)); a1 = n1; a2 = n2; }
        const float gs = a1 + a2; const int g = lane >> 3;
        int rank = 0;
#pragma unroll
        for (int j = 0; j < 8; ++j) { const float sj = __shfl(gs, j * 8); rank += (sj > gs || (sj == gs && j < g)) ? 1 : 0; }
        if (rank >= 4) { c0 = -INFINITY; c1 = -INFINITY; c2 = -INFINITY; c3 = -INFINITY; }
        int ridx = 0; float rs = 0.f;
#pragma unroll
        for (int k = 0; k < 8; ++k) {
            float bv = c0; int bi = 0; if (c1 > bv) { bv = c1; bi = 1; } if (c2 > bv) { bv = c2; bi = 2; } if (c3 > bv) { bv = c3; bi = 3; }
            float v = bv; int ix = lane * 4 + bi;
#pragma unroll
            for (int off = 1; off < 64; off <<= 1) { const float ov = __shfl_xor(v, off); const int oi = __shfl_xor(ix, off); if (ov > v || (ov == v && oi < ix)) { v = ov; ix = oi; } }
            const int ol = ix >> 2, oj = ix & 3;
            const float ssel = (oj == 0) ? s0 : (oj == 1) ? s1 : (oj == 2) ? s2 : s3;
            const float sv = __shfl(ssel, ol);
            if (lane == ol) { if (oj == 0) c0 = -INFINITY; else if (oj == 1) c1 = -INFINITY; else if (oj == 2) c2 = -INFINITY; else c3 = -INFINITY; }
            if (lane == k) { ridx = ix; rs = sv; }
        }
        float sum = (lane < 8) ? rs : 0.f; sum += __shfl_xor(sum, 1); sum += __shfl_xor(sum, 2); sum += __shfl_xor(sum, 4);
        if (lane < 8) { const float w = rs / sum * ROUTED_SCALE_;
            topi[tok * 8 + lane] = ridx; topw[tok * 8 + lane] = w;
            const unsigned lr = __hip_atomic_fetch_add(&hist[ridx], 1u, __ATOMIC_RELAXED, __HIP_MEMORY_SCOPE_WORKGROUP);
            lrank[tok * 8 + lane] = (int)lr; }
    }
    __syncthreads();
    if (tid_ < 256) { const unsigned hc = hist[tid_]; const unsigned base = __hip_atomic_fetch_add(gcount + tid_, hc, RLX_AGENT); wgbase[blockIdx.x * 256 + tid_] = base; }
}
__device__ __forceinline__ void p_assign(Frame& F) {
    const int lane_ = lane_id(), tid_ = F.wave * 64 + lane_; (void)tid_;
    moe_tables(F);
    LAS unsigned* PST = (LAS unsigned*)(F.lds + LX_PST);
    const int* topi = (const int*)(F.ws + WS_TOPI); const float* topw = (const float*)(F.ws + WS_TOPW); const int* lrank = (const int*)(F.ws + WS_LRANK);
    const unsigned* wgbase = (const unsigned*)(F.ws + WS_WGBASE);
    int* row_tok = (int*)(F.ws + WS_ROWTOK); int* row_dst = (int*)(F.ws + WS_ROWDST); float* row_w = (float*)(F.ws + WS_ROWW);
    for (int tok = blockIdx.x * 8 + F.wave; tok < T_; tok += F.G * 8) {
        if (lane_ < 8) { const int e = topi[tok * 8 + lane_]; const unsigned slot = PST[e] + wgbase[blockIdx.x * 256 + e] + (unsigned)lrank[tok * 8 + lane_];
            row_tok[slot] = tok; row_dst[slot] = tok * 8 + lane_; row_w[slot] = topw[tok * 8 + lane_]; }
    }
}

__global__ void __launch_bounds__(NWAVES * 64, 2) fwd_kernel(Args args) {
    extern __shared__ __attribute__((aligned(16))) unsigned char lds[];
    Frame F;
    F.lds = (LAS unsigned char*)lds;
    F.MISC = (volatile LAS unsigned*)(F.lds + MISC_OFF);
    F.wave = __builtin_amdgcn_readfirstlane((int)threadIdx.x >> 6);
    F.G = gridDim.x; { const int bx = blockIdx.x; F.vcu = (F.G % 8 == 0) ? (bx % 8) * (F.G / 8) + bx / 8 : bx; }
    F.ws = args.ws; F.out = args.out;
    F.ctl = (gu32*)(args.ws + WS_CTL);
    unsigned char* ws = args.ws;
    { const int tid_ = F.wave * 64 + lane_id(); for (int u = tid_; u < (LDS_BYTES - LDSCTL_OFF) / 4; u += NWAVES * 64) ((LAS unsigned*)(F.lds + LDSCTL_OFF))[u] = 0u; }
    __syncthreads();
    XcdBarrier bar; bar.bar = (unsigned*)(F.ctl + CW_BAR); bar.x = 0; bar.st = nullptr;
    if (N_LAUNCHES == 1) bar = xcd_barrier_post((unsigned*)(F.ctl + CW_BAR), F.MISC + 8, F.wave);
#define GRID_BAR() do { if (N_LAUNCHES == 1) xcd_barrier(bar, F.wave); } while (0)
    const int lo = args.ph_lo, hi = args.ph_hi;
#ifndef MK_PHMASK
#define MK_PHMASK 0x7fff
#endif
#ifndef MK_DOUBLE
#define MK_DOUBLE -1
#endif
#define REP(k) _Pragma("unroll") for (int rep_ = 0; rep_ < ((MK_DOUBLE) == (k) ? 2 : 1); ++rep_)
#define IN(k) ((((MK_PHMASK) >> (k)) & 1) && lo <= (k) && (k) < hi)
#define BOTH(k) (IN(k) && IN((k) + 1))
    bf16* S6 = (bf16*)(ws + WS_S6);
    float* X1 = args.out;
    bf16* TB = (bf16*)args.out;

    REP(0) if (IN(0)) { p0_prologue(F, args); if (BOTH(0)) GRID_BAR(); }

    REP(1) if (IN(1)) {
        pg8::DenseOrder S; S.init(ws + WS_XB, ws + WS_WIN, T_, INW_, D_, F.G, (int)blockIdx.x);
        EpiZ E{S6, (bf16*)(ws + WS_G), (const float*)(ws + WS_ROPE), (float*)(ws + WS_KMEAN)};
        pg8::gemm_phase<EpiZ, pg8::DenseOrder, true>(F.lds + RING_OFF, D_, S, E, F.wave);
        if (BOTH(1)) GRID_BAR();
    }
    if (IN(2)) { p_conv(F, args.in[3]); p_select(F); if (BOTH(2)) GRID_BAR(); }

    if (IN(3)) {
        const AttnOrder S{F.vcu};
        int bh, qb;
        for (int i = 0; S.next(i, bh, qb); ++i)
            attn_body::attn_unit<8>(bh >> 3, bh & 7, qb, (const attn_body::bf16*)S6, (const attn_body::bf16*)(S6 + (size_t)T_ * 512), (const attn_body::bf16*)(S6 + (size_t)2 * T_ * 512),
                                    (attn_body::bf16*)S6, (const unsigned*)(ws + WS_SEL), (char*)lds + RING_OFF, F.wave);
        if (BOTH(3)) GRID_BAR();
    }
    REP(4) if (IN(4)) {
        { pg8::DenseOrder S; S.init(S6, ws + WS_WAO, T_, D_, AW_, F.G, (int)blockIdx.x);
#ifdef MK_P4A_PLAIN
          EpiBf16Plain E{(bf16*)(ws + WS_P1), D_};
          pg8::gemm_phase<EpiBf16Plain, pg8::DenseOrder, true>(F.lds + RING_OFF, AW_, S, E, F.wave); }
#else
          EpiGate<false> E{(bf16*)(ws + WS_P1), (const bf16*)(ws + WS_G)};
          pg8::gemm_phase<EpiGate<false>, pg8::DenseOrder, true>(F.lds + RING_OFF, AW_, S, E, F.wave); }
#endif
        VM_WAIT(); __syncthreads();
#ifndef MK_SKIP_P4B
        { pg8::DenseOrder S; S.init(S6 + (size_t)3 * T_ * 512, ws + WS_WCO, T_, D_, CW_, F.G, (int)blockIdx.x);
          EpiGate<true> E{(bf16*)(ws + WS_P1), (const bf16*)(ws + WS_G) + (size_t)T_ * 1024};
          pg8::gemm_phase<EpiGate<true>, pg8::DenseOrder, true>(F.lds + RING_OFF, CW_, S, E, F.wave); }
#endif
        if (BOTH(4)) GRID_BAR();
    }
    REP(5) if (IN(5)) {
        pg8::DenseOrder S; S.init(ws + WS_P1, ws + WS_WOUT, T_, D_, D_, F.G, (int)blockIdx.x);
        EpiRes<false> E{TB, args.in[0]};
        pg8::gemm_phase<EpiRes<false>, pg8::DenseOrder, true>(F.lds + RING_OFF, D_, S, E, F.wave);
        if (BOTH(5)) GRID_BAR();
    }
    if (IN(6)) {
        const int gw = F.vcu * NWAVES + F.wave, NGW = F.G * NWAVES;
        for (int m = gw; m < T_; m += NGW) ln_row<true, false, false, true>(F, TB, nullptr, (bf16*)(ws + WS_XB), args.in[7], args.in[8], nullptr, nullptr, m);
        if (BOTH(6)) GRID_BAR();
    }
    REP(7) if (IN(7)) {
        { pg8::DenseOrder S; S.init(ws + WS_XB, ws + WS_WSR, T_, 768, D_, F.G, (int)blockIdx.x);
          EpiShRouter E{(bf16*)(ws + WS_HS), (float*)(ws + WS_LOGITS)};
          pg8::gemm_phase<EpiShRouter, pg8::DenseOrder, true>(F.lds + RING_OFF, D_, S, E, F.wave); }
        { pg8::DenseOrder S; S.init(ws + WS_PB, ws + WS_WPP, T_, D_, PLE_, F.G, (int)blockIdx.x);
          EpiBf16Plain E{(bf16*)(ws + WS_PP), D_};
          pg8::gemm_phase<EpiBf16Plain, pg8::DenseOrder, true>(F.lds + RING_OFF, PLE_, S, E, F.wave); }
        if (BOTH(7)) GRID_BAR();
    }
    if (IN(8)) {
        p_route(F, args.in[10]);
        { pg8::DenseOrder S; S.init(ws + WS_HS, ws + WS_WSD, T_, D_, 256, F.G, (int)blockIdx.x);
          EpiRes<true> E{TB, (const void*)(ws + WS_XB)};
          pg8::gemm_phase<EpiRes<true>, pg8::DenseOrder, true>(F.lds + RING_OFF, 256, S, E, F.wave); }
        if (BOTH(8)) GRID_BAR();
    }
    if (IN(9)) { p_assign(F); if (BOTH(9)) GRID_BAR(); }

    REP(10) if (IN(10)) {
        moe_tables(F);
        MoeUpOrder S{(const LAS unsigned short*)(F.lds + LX_BLKE), (const LAS unsigned*)(F.lds + LX_XS), (const int*)(ws + WS_ROWTOK), (const char*)(ws + WS_XB), (const char*)(ws + WS_WGU), F.G >= 8 ? F.G / 8 : 1, F.vcu};
        EpiMoeUp E{(bf16*)(ws + WS_H)};
        pg8::gemm_phase<EpiMoeUp, MoeUpOrder, true>(F.lds + RING_OFF, D_, S, E, F.wave);
        if (BOTH(10)) GRID_BAR();
    }
    REP(11) if (IN(11)) {
        moe_tables(F);
        MoeDownOrder S{(const LAS unsigned short*)(F.lds + LX_BLKE), (const LAS unsigned*)(F.lds + LX_XS), (const char*)(ws + WS_H), (const char*)(ws + WS_WD), F.G >= 8 ? F.G / 8 : 1, F.vcu};
        EpiMoeDown E{(bf16*)(ws + WS_YLO), (bf16*)(ws + WS_YHI), (const int*)(ws + WS_ROWDST), (const float*)(ws + WS_ROWW)};
        pg8::gemm_phase<EpiMoeDown, MoeDownOrder, true>(F.lds + RING_OFF, 256, S, E, F.wave);
#ifdef MK_P11_NULL
        { EpiNull E0; pg8::gemm_phase<EpiNull, MoeDownOrder, true>(F.lds + RING_OFF, 256, S, E0, F.wave); }
#endif
        if (BOTH(11)) GRID_BAR();
    }
    if (IN(12)) {
        const int gw = F.vcu * NWAVES + F.wave, NGW = F.G * NWAVES;
        for (int m = gw; m < T_; m += NGW) ln_row<true, true, false, true>(F, TB, nullptr, (bf16*)(ws + WS_XB), args.in[17], args.in[18], (const bf16*)(ws + WS_YLO), (const bf16*)(ws + WS_YHI), m);
        if (BOTH(12)) GRID_BAR();
    }
    if (IN(13)) {
        pg8::DenseOrder S; S.init(ws + WS_XB, ws + WS_WPG, T_, D_, D_, F.G, (int)blockIdx.x);
        EpiPle E{X1, (const bf16*)(ws + WS_XB), (const bf16*)(ws + WS_PP)};
        pg8::gemm_phase<EpiPle, pg8::DenseOrder, true>(F.lds + RING_OFF, D_, S, E, F.wave);
        if (BOTH(13)) GRID_BAR();
    }
    if (IN(14)) {
        const int gw = F.vcu * NWAVES + F.wave, NGW = F.G * NWAVES;
        for (int m = gw; m < T_; m += NGW) ln_row<false, false, true, false>(F, X1, X1, nullptr, args.in[21], args.in[22], nullptr, nullptr, m);
    }
#if defined(MK_DBG_OFF)
    if (lo <= 14 && 14 < hi) { const int lane_ = lane_id(), tid_ = F.wave * 64 + lane_; const bf16* src = (const bf16*)(ws + (size_t)(MK_DBG_OFF));
        for (size_t i = (size_t)F.vcu * 512 + tid_; i < (size_t)T_ * D_ / 8; i += (size_t)F.G * 512) { const v4u w = *(const v4u*)(src + (i % (size_t)(MK_DBG_WRAP)) * 8);
            f32x4 a, b; a.x = bf_lo(w.x); a.y = bf_hi(w.x); a.z = bf_lo(w.y); a.w = bf_hi(w.y); b.x = bf_lo(w.z); b.y = bf_hi(w.z); b.z = bf_lo(w.w); b.w = bf_hi(w.w);
            *(f32x4*)(args.out + i * 8) = a; *(f32x4*)(args.out + i * 8 + 4) = b; } }
#endif
#undef IN
#undef BOTH
#undef GRID_BAR
}

extern "C" void kernel_launch(void* const* d_in, const int* in_sizes, int n_in, void* d_out, int out_size, void* d_ws, size_t ws_size, hipStream_t stream) {
    static int grid = 0;
    if (grid == 0) {
        if (n_in != 23 || in_sizes[0] != T_ * D_ || out_size != T_ * D_ || ws_size < WS_END) { fprintf(stderr, "kernel_launch: unexpected shapes (n_in %d, in0 %d, out %d, ws %zu); nothing launched\n", n_in, n_in > 0 ? in_sizes[0] : -1, out_size, ws_size); grid = -1; return; }
        int dev = 0, cus = 0, per_cu = 0;
        if (hipGetDevice(&dev) != hipSuccess || hipDeviceGetAttribute(&cus, hipDeviceAttributeMultiprocessorCount, dev) != hipSuccess) { fprintf(stderr, "kernel_launch: device query failed\n"); grid = -1; return; }
        if (hipFuncSetAttribute((const void*)fwd_kernel, hipFuncAttributeMaxDynamicSharedMemorySize, LDS_BYTES) != hipSuccess) { fprintf(stderr, "kernel_launch: hipFuncSetAttribute failed\n"); grid = -1; return; }
        if (hipOccupancyMaxActiveBlocksPerMultiprocessor(&per_cu, (const void*)fwd_kernel, NWAVES * 64, LDS_BYTES) != hipSuccess || per_cu < 1)
            fprintf(stderr, "kernel_launch: note: occupancy query reports %d workgroups per CU\n", per_cu);
        (void)hipGetLastError();
        grid = cus;
    }
    if (grid < 0) return;
    if (hipMemsetAsync((char*)d_ws + WS_CTL, 0, CTL_ZERO_BYTES, stream) != hipSuccess) { fprintf(stderr, "kernel_launch: memset failed\n"); return; }
    Args a{};
    for (int i = 0; i < 23; ++i) a.in[i] = (const float*)d_in[i];
    a.out = (float*)d_out; a.ws = (unsigned char*)d_ws; a.pad = 0;
    for (int li = 0; li < N_LAUNCHES; ++li) {
        a.ph_lo = (N_LAUNCHES == 1) ? 0 : li; a.ph_hi = (N_LAUNCHES == 1) ? NPH : li + 1; a.li = li;
        hipLaunchKernelGGL(fwd_kernel, dim3(grid), dim3(NWAVES * 64), LDS_BYTES, stream, a);
        const hipError_t le = hipPeekAtLastError();
        if (le != hipSuccess) { fprintf(stderr, "kernel_launch: launch %d failed: %s\n", li, hipGetErrorName(le)); break; }
    }
}
```

```cpp
#include <hip/hip_runtime.h>
#include <hip/hip_bf16.h>
#include <cstdio>
#include <cstdint>
#include <cmath>

#ifndef MK_N_LAUNCHES
#define MK_N_LAUNCHES 1
#endif

constexpr int NB_ = 8, SEQ_ = 4096, T_ = NB_ * SEQ_, D_ = 1024;
constexpr int NH_ = 8, HD_ = 64, AW_ = 512, CW_ = 512, INW_ = 5120;
constexpr int NE_ = 256, ED_ = 256, TOPK_ = 8, PLE_ = 256;
constexpr int NBLK_ = 16;
constexpr float LN_EPS_ = 1e-5f;
constexpr float DN_ALPHA_ = 1.189207115002721f;
constexpr float ROUTED_SCALE_ = 2.5f;
constexpr int RMAX_ = T_ * TOPK_ + NE_ * 256;

#define GAS __attribute__((address_space(1)))
#define LAS __attribute__((address_space(3)))
typedef unsigned short bf16;
typedef unsigned v4u __attribute__((ext_vector_type(4)));
typedef float f32x4 __attribute__((ext_vector_type(4)));
typedef float f32x2 __attribute__((ext_vector_type(2)));
typedef unsigned u32x2 __attribute__((ext_vector_type(2)));
typedef short bf16x8 __attribute__((ext_vector_type(8)));
typedef GAS unsigned gu32;
#define RLX_AGENT __ATOMIC_RELAXED, __HIP_MEMORY_SCOPE_AGENT
#define LDS_WAIT() asm volatile("s_waitcnt lgkmcnt(0)" ::: "memory")
#define VM_WAIT() asm volatile("s_waitcnt vmcnt(0)" ::: "memory")

typedef float cvt_f32x2_t __attribute__((ext_vector_type(2))); typedef __bf16 cvt_bf16x2_t __attribute__((ext_vector_type(2)));
__device__ __forceinline__ unsigned cvt_pk_bf16(float lo, float hi) { cvt_f32x2_t v = {lo, hi}; cvt_bf16x2_t b = __builtin_convertvector(v, cvt_bf16x2_t); return __builtin_bit_cast(unsigned, b); }
__device__ __forceinline__ float bf_lo(unsigned w) { return __builtin_bit_cast(float, w << 16); }
__device__ __forceinline__ float bf_hi(unsigned w) { return __builtin_bit_cast(float, w & 0xffff0000u); }
__device__ __forceinline__ int lane_id() { unsigned ones = ~0u; asm volatile("" : "+s"(ones)); return (int)__builtin_amdgcn_mbcnt_hi(ones, __builtin_amdgcn_mbcnt_lo(ones, 0u)); }
__device__ __forceinline__ float sigmoidf_(float x) { return __builtin_amdgcn_rcpf(1.0f + __builtin_amdgcn_exp2f(-1.4426950408889634f * x)); }

namespace pg8 {
#define PG8_LAS __attribute__((address_space(3)))
constexpr int BM = 256, BK = 64, HALF = 128, HTB = HALF * BK * 2  , STAGE_BYTES = 8 * HTB, NXCD = 8, WGM = 8;

__host__ __device__ __forceinline__ int lds_byte(int r, int c) { const int st = (r >> 4) * 2 + (c >> 5), rr = r & 15, cc = c & 31, ob = rr * 64 + cc * 2; return st * 1024 + (ob ^ (((ob >> 9) & 1) << 5)); }
__host__ __device__ __forceinline__ void stage_rc(int b, int& R, int& C) { const int st = b / 1024, sb = b % 1024, swz = sb ^ (((sb >> 9) & 1) << 5); R = (st >> 1) * 16 + swz / 64; C = (st & 1) * 32 + (swz % 64) / 2; }
__host__ __device__ __forceinline__ int perm32(int rho) { const int n = rho >> 4, i = rho & 15; return 8 * (i >> 2) + 4 * n + (i & 3); }

struct Unit { const char* a; const char* b; int row0, pn, e; };

struct DenseOrder {
    const char* A; const char* Bt; int K, nM, nN, nwg, G, c;
    static constexpr bool GATHER = false;
    __device__ __forceinline__ void init(const void* A_, const void* Bt_, int M, int N, int K_, int G_, int c_) { A = (const char*)A_; Bt = (const char*)Bt_; K = K_; nM = M / BM; nN = N / BM; nwg = nM * nN; G = G_; c = c_; }
    __device__ __forceinline__ bool next(int i, Unit& u) const {
        const long L = (long)i * G + c; if (L >= nwg) return false;
        int wgid = (int)L; { const int q = nwg / NXCD, r = nwg % NXCD, xcd = wgid % NXCD, off = wgid / NXCD; wgid = (xcd < r ? xcd * (q + 1) : r * (q + 1) + (xcd - r) * q) + off; }
        const int nig = WGM * nN, gid = wgid / nig, fm = gid * WGM, gsz = (nM - fm) < WGM ? (nM - fm) : WGM;
        const int pm = fm + ((wgid % nig) % gsz); int pn = (wgid % nig) / gsz;
#ifdef MK_REV_PN
        if (nN == 20) pn = 19 - pn;
#endif
        u.a = A + (size_t)pm * BM * K * 2; u.b = Bt + (size_t)pn * BM * K * 2; u.row0 = pm * BM; u.pn = pn; u.e = 0; return true;
    }
};

template <class Epi, class Sched, bool ALIGN_EPI>
__device__ __forceinline__ void gemm_phase(PG8_LAS unsigned char* lds, const int K, const Sched& S, const Epi& E, const int wid) {
    const int lane = lane_id(), tid = wid * 64 + lane, wr = wid >> 2, wc = wid & 3, fr = lane & 15, fq = lane >> 4;
    const int nt = K / BK;
    constexpr int NVA = Sched::GATHER ? 2 : 1;
    unsigned voffA[NVA][2], voffB[2];
#pragma unroll
    for (int i = 0; i < 2; ++i) { int R, C; stage_rc(tid * 16 + i * 8192, R, C); static_assert(Epi::PERM, "all epilogues use the permuted layout");
        voffB[i] = (unsigned)((64 * (R >> 5) + perm32(R & 31)) * K + C) * 2u;
        if constexpr (!Sched::GATHER) voffA[0][i] = (unsigned)(R * K + C) * 2u; }
    const size_t kstep = (size_t)(BK * 2);
    const size_t hstep = (size_t)32 * K * 2;
    const size_t hstepA = Sched::GATHER ? 0 : (size_t)HALF * K * 2;
    const unsigned ldsw = (unsigned)wid * 1024u;
    const int aoff = lds_byte(wr * 64 + fr, fq * 8), boff = lds_byte(wc * 32 + fr, fq * 8);
#define PG8_SA(b, h) (((b) * 2 + (h)) * HTB)
#define PG8_SB(b, h) ((4 + (b) * 2 + (h)) * HTB)
#define PG8_STAGE(bufoff, gbase, voff) do { _Pragma("unroll") for (int _i = 0; _i < 2; ++_i) \
        __builtin_amdgcn_global_load_lds((const unsigned*)((const char*)(gbase) + (voff)[_i]), (PG8_LAS unsigned*)(lds + (bufoff) + ldsw + _i * 8192), 16, 0, 0); } while (0)
#define PG8_LDA(dst, b, h) do { _Pragma("unroll") for (int m = 0; m < 4; ++m) _Pragma("unroll") for (int k = 0; k < 2; ++k) dst[m][k] = *(const PG8_LAS bf16x8*)(lds + PG8_SA(b, h) + aoff + m * 2048 + k * 1024); } while (0)
#define PG8_LDB(dst, b, h) do { _Pragma("unroll") for (int n = 0; n < 2; ++n) _Pragma("unroll") for (int k = 0; k < 2; ++k) dst[n][k] = *(const PG8_LAS bf16x8*)(lds + PG8_SB(b, h) + boff + n * 2048 + k * 1024); } while (0)
#define PG8_MMA(ai, bj, At, Bt) do { __builtin_amdgcn_s_setprio(1); _Pragma("unroll") for (int m = 0; m < 4; ++m) _Pragma("unroll") for (int n = 0; n < 2; ++n) _Pragma("unroll") for (int k = 0; k < 2; ++k) \
        acc[ai][bj][m][n] = __builtin_amdgcn_mfma_f32_16x16x32_bf16(Bt[n][k], At[m][k], acc[ai][bj][m][n], 0, 0, 0); __builtin_amdgcn_s_setprio(0); } while (0)
#ifdef MK_DRAIN
#define PG8_WAIT_V(n) asm volatile("s_waitcnt vmcnt(0)" ::: "memory")
#else
#define PG8_WAIT_V(n) asm volatile("s_waitcnt vmcnt(" #n ")" ::: "memory")
#endif
#define PG8_WAIT_L(n) asm volatile("s_waitcnt lgkmcnt(" #n ")" ::: "memory")
#define PG8_BAR __builtin_amdgcn_s_barrier()
#define PG8_SCHED __builtin_amdgcn_sched_barrier(0)
    Unit cur, nxt; int ui = 0;
    if (!S.next(0, cur)) return;
    if constexpr (Sched::GATHER) S.aoff(cur, tid, voffA);
    f32x4 acc[2][2][4][2];
#pragma unroll
    for (int a = 0; a < 2; ++a)
#pragma unroll
        for (int b = 0; b < 2; ++b)
#pragma unroll
            for (int m = 0; m < 4; ++m)
#pragma unroll
                for (int n = 0; n < 2; ++n) acc[a][b][m][n] = (f32x4){0.f, 0.f, 0.f, 0.f};
    bf16x8 At[4][2], B0[2][2], B1[2][2];
    PG8_STAGE(PG8_SB(0, 0), cur.b, voffB); PG8_STAGE(PG8_SB(0, 1), cur.b + hstep, voffB); PG8_STAGE(PG8_SA(0, 0), cur.a, voffA[0]); PG8_STAGE(PG8_SA(0, 1), cur.a + hstepA, voffA[NVA - 1]);
    if (wr == 1) PG8_BAR;
    PG8_WAIT_V(2); PG8_BAR;
    PG8_STAGE(PG8_SB(1, 0), cur.b + kstep, voffB); PG8_STAGE(PG8_SA(1, 0), cur.a + kstep, voffA[0]); PG8_STAGE(PG8_SB(1, 1), cur.b + hstep + kstep, voffB);
    PG8_WAIT_V(6); PG8_BAR;
    for (;;) {
        const bool has_next = S.next(ui + 1, nxt);
        const char* nA = has_next ? nxt.a : cur.a; const char* nB = has_next ? nxt.b : cur.b;
#pragma nounroll
        for (int t = 0; t < nt; t += 2) {
            const bool last = (t == nt - 2);
            const char* a1 = cur.a + (size_t)(t + 1) * kstep;
            const char* a2 = last ? nA : cur.a + (size_t)(t + 2) * kstep; const char* b2 = last ? nB : cur.b + (size_t)(t + 2) * kstep;
            const char* a3 = a2 + kstep; const char* b3 = b2 + kstep;
            PG8_LDB(B0, 0, 0); PG8_LDB(B1, 0, 1); PG8_SCHED; PG8_LDA(At, 0, 0); PG8_STAGE(PG8_SA(1, 1), a1 + hstepA, voffA[NVA - 1]);
            if constexpr (Sched::GATHER) { if (last && has_next) S.aoff(nxt, tid, voffA); }
            PG8_WAIT_V(8); PG8_WAIT_L(0); PG8_BAR; PG8_MMA(0, 0, At, B0); PG8_MMA(0, 1, At, B1); PG8_BAR; PG8_SCHED;
            PG8_LDA(At, 0, 1); PG8_STAGE(PG8_SB(0, 0), b2, voffB); PG8_STAGE(PG8_SB(0, 1), b2 + hstep, voffB); PG8_STAGE(PG8_SA(0, 0), a2, voffA[0]);
            PG8_WAIT_V(8); PG8_WAIT_L(0); PG8_BAR; PG8_MMA(1, 0, At, B0); PG8_MMA(1, 1, At, B1); PG8_BAR; PG8_SCHED;
            PG8_LDB(B0, 1, 0); PG8_LDB(B1, 1, 1); PG8_SCHED; PG8_LDA(At, 1, 0); PG8_STAGE(PG8_SA(0, 1), a2 + hstepA, voffA[NVA - 1]);
            PG8_WAIT_V(8); PG8_WAIT_L(0); PG8_BAR; PG8_MMA(0, 0, At, B0); PG8_MMA(0, 1, At, B1); PG8_BAR; PG8_SCHED;
            PG8_LDA(At, 1, 1); PG8_STAGE(PG8_SB(1, 0), b3, voffB); PG8_STAGE(PG8_SB(1, 1), b3 + hstep, voffB); PG8_STAGE(PG8_SA(1, 0), a3, voffA[0]);
            PG8_WAIT_V(8); PG8_WAIT_L(0); PG8_BAR; PG8_MMA(1, 0, At, B0); PG8_MMA(1, 1, At, B1); PG8_BAR; PG8_SCHED;
        }
        if constexpr (ALIGN_EPI) { if (wr == 0) PG8_BAR; }
        E(acc, cur, wr, wc, fr, fq);
        if (!has_next) break;
#pragma unroll
        for (int a = 0; a < 2; ++a)
#pragma unroll
            for (int b = 0; b < 2; ++b)
#pragma unroll
                for (int m = 0; m < 4; ++m)
#pragma unroll
                    for (int n = 0; n < 2; ++n) acc[a][b][m][n] = (f32x4){0.f, 0.f, 0.f, 0.f};
        cur = nxt; ++ui;
        if constexpr (ALIGN_EPI) { if (wr == 1) PG8_BAR; }
    }
    PG8_WAIT_V(0);
    if constexpr (!ALIGN_EPI) { if (wr == 0) PG8_BAR; }
    PG8_BAR;
#undef PG8_SA
#undef PG8_SB
#undef PG8_STAGE
#undef PG8_LDA
#undef PG8_LDB
#undef PG8_MMA
#undef PG8_WAIT_V
#undef PG8_WAIT_L
#undef PG8_BAR
#undef PG8_SCHED
}
}

namespace attn_body {
using bf16=__hip_bfloat16;
using bf16x8=__attribute__((ext_vector_type(8)))short;
using s16x4=__attribute__((ext_vector_type(4)))short;
using f32x16=__attribute__((ext_vector_type(16)))float;
using u32x4=__attribute__((ext_vector_type(4)))unsigned;
constexpr int BATCH=8,NHEAD=8,SEQ=4096,D=64,DM=NHEAD*D;
constexpr int NW=8,QBLK=32,QB=QBLK*NW,KVBLK=64,NQB=SEQ/QB;
__device__ __forceinline__ int crow(int r,int hi){return (r&3)+8*(r>>2)+4*hi;}
#define SBAR() __builtin_amdgcn_sched_barrier(0)
__device__ __forceinline__ void cmask(f32x16&p0,f32x16&p1,int qe,int hi){
  const float NEG=-INFINITY; int kb=4*hi;
  #pragma unroll
  for(int r=0;r<16;++r){int kv=kb+(r&3)+8*(r>>2); if(kv>qe)p0[r]=NEG; if(kv+32>qe)p1[r]=NEG;}
}
__device__ __forceinline__ void bmask(f32x16&p0,f32x16&p1,bool keep,float mhat){
  float pen=keep?-mhat:-INFINITY; asm volatile("":"+v"(pen));
  #pragma unroll
  for(int r=0;r<16;++r){p0[r]+=pen; p1[r]+=pen;}
}

constexpr int NSLOT=3, SLOTB=8192;
constexpr int LDS_K=0, LDS_V=NSLOT*SLOTB, LDS_WS=2*NSLOT*SLOTB, LDS_OST=LDS_WS+NW*64*4, LDS_BYTES=LDS_OST+NW*4096;
constexpr float C2=0.125f*1.4426950408889634f;
__device__ __forceinline__ void glds16(const void*gsrc,unsigned lds_dst){unsigned keep;
  asm volatile("s_mov_b32 %0, m0\n\ts_mov_b32 m0, %2\n\ts_nop 0\n\tglobal_load_lds_dwordx4 %1, off\n\ts_mov_b32 m0, %0":"=&s"(keep):"v"(gsrc),"s"(lds_dst):"memory");}
__device__ __forceinline__ float max3f(float a,float b,float c){float r;asm("v_max3_f32 %0, %1, %2, %3":"=v"(r):"v"(a),"v"(b),"v"(c));return r;}
__device__ __forceinline__ float max2f(float a,float b){float r;asm("v_max_f32_e32 %0, %1, %2":"=v"(r):"v"(a),"v"(b));return r;}
__device__ __forceinline__ float fadd_s(float a,float b){float r;asm("v_add_f32_e32 %0, %1, %2":"=v"(r):"v"(a),"v"(b));return r;}
__device__ __forceinline__ float fsub_s(float a,float b){float r;asm("v_sub_f32_e32 %0, %1, %2":"=v"(r):"v"(a),"v"(b));return r;}
typedef float f32x2_t __attribute__((ext_vector_type(2))); typedef __bf16 bf16x2_t __attribute__((ext_vector_type(2)));
__device__ __forceinline__ unsigned cvtpk_s(float lo,float hi){f32x2_t v={lo,hi};bf16x2_t b=__builtin_convertvector(v,bf16x2_t);return __builtin_bit_cast(unsigned,b);}
#define WAIT_BAR(N) asm volatile("s_waitcnt vmcnt(" #N ") lgkmcnt(0)\n\ts_barrier":::"memory")

__device__ __forceinline__ void qkt(f32x16&p0,f32x16&p1,const char*Kslot,const bf16x8*qr,int r32,int hi){
  const char*kb=Kslot+hi*1024+r32*16;
  #pragma unroll
  for(int d0=0;d0<4;++d0){
    const bf16x8 b0=*reinterpret_cast<const bf16x8*>(kb+d0*2048);
    const bf16x8 b1=*reinterpret_cast<const bf16x8*>(kb+d0*2048+512);
    if(d0==0){p0=__builtin_amdgcn_mfma_f32_32x32x16_bf16(b0,qr[0],f32x16{},0,0,0);p1=__builtin_amdgcn_mfma_f32_32x32x16_bf16(b1,qr[0],f32x16{},0,0,0);}
    else{p0=__builtin_amdgcn_mfma_f32_32x32x16_bf16(b0,qr[d0],p0,0,0,0);p1=__builtin_amdgcn_mfma_f32_32x32x16_bf16(b1,qr[d0],p1,0,0,0);}}
}
typedef __attribute__((address_space(3))) const char* lds_cptr;
typedef short v4i16_t __attribute__((ext_vector_type(4)));
__device__ __forceinline__ void kload8(bf16x8*kf,lds_cptr kp){
  kf[0]=*(const __attribute__((address_space(3))) bf16x8*)(kp);      kf[1]=*(const __attribute__((address_space(3))) bf16x8*)(kp+512);
  kf[2]=*(const __attribute__((address_space(3))) bf16x8*)(kp+2048); kf[3]=*(const __attribute__((address_space(3))) bf16x8*)(kp+2560);
  kf[4]=*(const __attribute__((address_space(3))) bf16x8*)(kp+4096); kf[5]=*(const __attribute__((address_space(3))) bf16x8*)(kp+4608);
  kf[6]=*(const __attribute__((address_space(3))) bf16x8*)(kp+6144); kf[7]=*(const __attribute__((address_space(3))) bf16x8*)(kp+6656);
}
__device__ __forceinline__ void kload2(bf16x8*kf,lds_cptr kp,int j){ kf[2*j]=*(const __attribute__((address_space(3))) bf16x8*)(kp+j*2048); kf[2*j+1]=*(const __attribute__((address_space(3))) bf16x8*)(kp+j*2048+512); }
__device__ __forceinline__ s16x4 vtr(lds_cptr p){ return __builtin_bit_cast(s16x4,__builtin_amdgcn_ds_read_tr16_b64_v4i16((__attribute__((address_space(3))) v4i16_t*)p)); }
__device__ __forceinline__ float rowmax(const f32x16&p0,const f32x16&p1){
  float a=max3f(p0[0],p0[1],p1[0]),b=max3f(p0[2],p0[3],p1[1]);a=max3f(a,p1[2],p1[3]);
  #pragma unroll
  for(int r=4;r<16;r+=4){a=max3f(a,p0[r],p0[r+1]);b=max3f(b,p0[r+2],p0[r+3]);a=max3f(a,p1[r],p1[r+1]);b=max3f(b,p1[r+2],p1[r+3]);}
  const float m=max2f(a,b);
  auto rr=__builtin_amdgcn_permlane32_swap(__float_as_uint(m),__float_as_uint(m),false,false);
  return max2f(__uint_as_float(rr[0]),__uint_as_float(rr[1]));
}
__device__ __forceinline__ void pv(f32x16*o,int vb,bf16x8 pa0,bf16x8 pa1,bf16x8 pa2,bf16x8 pa3){
  #pragma unroll
  for(int d0=0;d0<2;++d0){s16x4 lo[4],hi[4];
    #pragma unroll
    for(int ks=0;ks<4;++ks){
      asm volatile("ds_read_b64_tr_b16 %0,%1 offset:%c2":"=&v"(lo[ks]):"v"(vb),"i"(d0*4096+ks*1024):"memory");
      asm volatile("ds_read_b64_tr_b16 %0,%1 offset:%c2":"=&v"(hi[ks]):"v"(vb),"i"(d0*4096+ks*1024+512):"memory");}
    asm volatile("s_waitcnt lgkmcnt(0)":::"memory");SBAR();
    #define PK(k) (bf16x8){lo[k][0],lo[k][1],lo[k][2],lo[k][3],hi[k][0],hi[k][1],hi[k][2],hi[k][3]}
    o[d0]=__builtin_amdgcn_mfma_f32_32x32x16_bf16(pa0,PK(0),o[d0],0,0,0);
    o[d0]=__builtin_amdgcn_mfma_f32_32x32x16_bf16(pa1,PK(1),o[d0],0,0,0);
    o[d0]=__builtin_amdgcn_mfma_f32_32x32x16_bf16(pa2,PK(2),o[d0],0,0,0);
    o[d0]=__builtin_amdgcn_mfma_f32_32x32x16_bf16(pa3,PK(3),o[d0],0,0,0);
    #undef PK
  }
}

#define ATTN_STORE16(p,v) (*(u32x4*)(p)=(v))
template<int THRL> __device__ __forceinline__ void attn_unit(int b,int h,int qb,const bf16*Q,const bf16*__restrict__ K,const bf16*__restrict__ V,bf16*O,const unsigned*SEL,char*shm,const int wid_){
  const int lane=lane_id(),r32=lane&31,hi=lane>>5; const int wid=wid_;
  const long rowbase=(long)b*SEQ; const int q0=qb*QB;
  const bf16*Qw=Q+(rowbase+q0+wid*QBLK)*DM+h*D;
  const bf16*Kh=K+rowbase*DM+h*D,*Vh=V+rowbase*DM+h*D;
  const unsigned lds0=(unsigned)(uintptr_t)shm;
  float*wsf=(float*)(shm+LDS_WS)+wid*64;
  const unsigned selm=SEL[((long)(b*NHEAD+h))*SEQ+q0+wid*QBLK+r32];
  const bf16*ksrc=Kh+(long)lane*DM+wid*8;
  const bf16*vsrc=Vh+(long)(16*(wid&3)+(lane>>2))*DM+(wid>>2)*32+(lane&3)*8;
  const unsigned kdst=lds0+LDS_K+wid*1024, vdst=lds0+LDS_V+wid*1024;
  #define DMA_K(t,slot) glds16(ksrc+(long)(t)*KVBLK*DM,(unsigned)__builtin_amdgcn_readfirstlane(kdst+(slot)))
  #define DMA_V(t,slot) glds16(vsrc+(long)(t)*KVBLK*DM,(unsigned)__builtin_amdgcn_readfirstlane(vdst+(slot)))
  const int vb0=(int)(lds0+LDS_V)+((lane>>4)&1)*32+(lane&3)*8+(4*hi+((lane&15)>>2))*64;
  const char*Kbase=shm+LDS_K; bf16x8 kf[8];
  const lds_cptr shm3=(lds_cptr)shm; const lds_cptr kp0=shm3+LDS_K+hi*1024+r32*16; const lds_cptr vp0=shm3+LDS_V+((lane>>4)&1)*32+(lane&3)*8+(4*hi+((lane&15)>>2))*64;
  const int NT=(q0+QB)/KVBLK;
  DMA_K(0,0);DMA_V(0,0);DMA_K(1,SLOTB);
  bf16x8 qr[4];
  #pragma unroll
  for(int d0=0;d0<4;++d0)qr[d0]=*reinterpret_cast<const bf16x8*>(&Qw[(long)r32*DM+d0*16+hi*8]);
  float mhat=0.f,l_reg=0.f;f32x16 o[2];o[0]=f32x16{};o[1]=f32x16{};
  const int qrel=wid*QBLK+r32;
  #define CMASK(P0,P1,t) do{const int jb_=(t)-(NT-4); if(jb_>=0){cmask(P0,P1,qrel-64*jb_,hi); bmask(P0,P1,true,mhat);} else bmask(P0,P1,((selm>>((t)>>2))&1u)!=0u,mhat);}while(0)
  bool resc=false;
  #define START(P0,P1) do{ const float rm=rowmax(P0,P1); resc=false; \
    { const float dl=__builtin_fmaxf(rm,-60.f); mhat=fadd_s(mhat,dl); \
      _Pragma("unroll") for(int r=0;r<16;++r){P0[r]=fsub_s(P0[r],dl);P1[r]=fsub_s(P1[r],dl);} } \
    _Pragma("unroll") for(int r=0;r<16;++r)P0[r]=__builtin_amdgcn_exp2f(P0[r]); }while(0)
  #define RESC() do{ if(resc){ asm volatile("s_waitcnt lgkmcnt(0)":::"memory"); \
      _Pragma("unroll") for(int d_=0;d_<2;++d_) _Pragma("unroll") for(int r=0;r<16;++r)o[d_][r]*=wsf[crow(r,hi)]; } }while(0)
  f32x16 pA0,pA1,pB0,pB1;
  int sl_prev=0,sl_cur=0,sl_next=SLOTB;
  #define ROT() do{sl_prev=sl_cur;sl_cur=sl_next;sl_next=(sl_next==(NSLOT-1)*SLOTB)?0:sl_next+SLOTB;}while(0)
  DMA_K(2,2*SLOTB);
  WAIT_BAR(3);
  qkt(pA0,pA1,Kbase,qr,r32,hi);asm volatile("s_nop 15\n\ts_nop 7":"+v"(pA0),"+v"(pA1));CMASK(pA0,pA1,0);
  START(pA0,pA1);
  _Pragma("unroll") for(int r=0;r<16;++r)pA1[r]=__builtin_amdgcn_exp2f(pA1[r]);
  WAIT_BAR(0);
  DMA_K(3,0);DMA_V(1,SLOTB);
  ROT();
  kload8(kf,kp0+sl_cur);
  WAIT_BAR(2);
  s16x4 vlo[8],vhi[8]; u32x4 pw0,pw1,pw2,pw3;
  #define PKW(P,B) cvtpk_s(P[B],P[B+1])
  #define PAF(k) __builtin_bit_cast(bf16x8,pw##k)
  #define VFR(i) (bf16x8){vlo[i][0],vlo[i][1],vlo[i][2],vlo[i][3],vhi[i][0],vhi[i][1],vhi[i][2],vhi[i][3]}
  #define PIN(x) asm volatile("":"+v"(x))
  #define MX3(a,b,c) __builtin_fmaxf(__builtin_fmaxf((a),(b)),(c))
  #define GAPA(MF,A0,A1,A2,A3,W0,W1,PW) do{ MF; sacc+=A0; sacc+=A1; sacc+=A2; sacc+=A3; PIN(sacc); W0; W1; PIN(PW); SBAR(); }while(0)
  #define EX(v) __builtin_amdgcn_exp2f(v)
  #define GAPB(MF,X,B) do{ MF; X[B]=EX(X[B]); X[B+1]=EX(X[B+1]); X[B+2]=EX(X[B+2]); X[B+3]=EX(X[B+3]); PIN(X); SBAR(); }while(0)
  #define VRD(i) do{ vlo[i]=vtr(vp_+(((i)>>2)*4096+((i)&3)*1024)); vhi[i]=vtr(vp_+(((i)>>2)*4096+((i)&3)*1024+512)); }while(0)
  #define KRD(G,j) do{ if(G){ kload2(kf,kp0+sl_next,j); SBAR(); } }while(0)
  #define STEP(C0,C1,P0,P1,t,GK,GV,GL) do{ SBAR(); \
    const lds_cptr vp_=vp0+sl_prev; \
    VRD(0); SBAR(); float sacc=(P0[0]+P0[1]); \
    GAPA(C0=__builtin_amdgcn_mfma_f32_32x32x16_bf16(kf[0],qr[0],f32x16{},0,0,0), P0[2],P0[3],P0[4],P0[5],     pw0[0]=PKW(P0,0), pw0[1]=PKW(P0,2), pw0); \
    VRD(4); SBAR(); GAPA(C1=__builtin_amdgcn_mfma_f32_32x32x16_bf16(kf[1],qr[0],f32x16{},0,0,0), P0[6],P0[7],P0[8],P0[9],     pw0[2]=PKW(P0,4), pw0[3]=PKW(P0,6), pw0); \
    VRD(1); SBAR(); GAPA(C0=__builtin_amdgcn_mfma_f32_32x32x16_bf16(kf[2],qr[1],C0,0,0,0),   P0[10],P0[11],P0[12],P0[13], pw1[0]=PKW(P0,8), pw1[1]=PKW(P0,10), pw1); \
    VRD(5); SBAR(); GAPA(C1=__builtin_amdgcn_mfma_f32_32x32x16_bf16(kf[3],qr[1],C1,0,0,0),   P0[14],P0[15],P1[0],P1[1],   pw1[2]=PKW(P0,12),pw1[3]=PKW(P0,14), pw1); \
    VRD(2); SBAR(); GAPA(C0=__builtin_amdgcn_mfma_f32_32x32x16_bf16(kf[4],qr[2],C0,0,0,0),   P1[2],P1[3],P1[4],P1[5],     pw2[0]=PKW(P1,0), pw2[1]=PKW(P1,2), pw2); \
    VRD(6); SBAR(); GAPA(C1=__builtin_amdgcn_mfma_f32_32x32x16_bf16(kf[5],qr[2],C1,0,0,0),   P1[6],P1[7],P1[8],P1[9],     pw2[2]=PKW(P1,4), pw2[3]=PKW(P1,6), pw2); \
    VRD(3); SBAR(); GAPA(C0=__builtin_amdgcn_mfma_f32_32x32x16_bf16(kf[6],qr[3],C0,0,0,0),   P1[10],P1[11],P1[12],P1[13], pw3[0]=PKW(P1,8), pw3[1]=PKW(P1,10), pw3); \
    VRD(7); SBAR(); GAPA(C1=__builtin_amdgcn_mfma_f32_32x32x16_bf16(kf[7],qr[3],C1,0,0,0),   P1[14],P1[15],0.f,0.f,       pw3[2]=PKW(P1,12),pw3[3]=PKW(P1,14), pw3); \
    l_reg+=sacc; \
    if(GK){DMA_K((t)+3,sl_cur);} if(GV){DMA_V((t)+1,sl_next);} \
    CMASK(C0,C1,t); \
    { float a=MX3(C0[0],C0[1],C1[0]),b=MX3(C0[2],C0[3],C1[1]); a=MX3(a,C1[2],C1[3]); \
      _Pragma("unroll") for(int r=4;r<16;r+=4){a=MX3(a,C0[r],C0[r+1]);b=MX3(b,C0[r+2],C0[r+3]);a=MX3(a,C1[r],C1[r+1]);b=MX3(b,C1[r+2],C1[r+3]);} \
      float rm=__builtin_fmaxf(a,b); { auto rr=__builtin_amdgcn_permlane32_swap(__float_as_uint(rm),__float_as_uint(rm),false,false); rm=__builtin_fmaxf(__uint_as_float(rr[0]),__uint_as_float(rr[1])); } \
      resc=false; \
      if(__builtin_expect(__any(rm>(float)THRL),0)){ const float dl=__builtin_fmaxf(rm,0.f); mhat+=dl; \
        _Pragma("unroll") for(int r=0;r<16;++r){C0[r]-=dl;C1[r]-=dl;} \
        const float f=__builtin_amdgcn_exp2f(-dl); l_reg*=f; if(hi==0)wsf[r32]=f; resc=true; } } \
    SBAR(); \
    GAPB(o[0]=__builtin_amdgcn_mfma_f32_32x32x16_bf16(PAF(0),VFR(0),o[0],0,0,0), C0,0); \
    GAPB(o[1]=__builtin_amdgcn_mfma_f32_32x32x16_bf16(PAF(0),VFR(4),o[1],0,0,0), C0,4); \
    KRD(GL,0); GAPB(o[0]=__builtin_amdgcn_mfma_f32_32x32x16_bf16(PAF(1),VFR(1),o[0],0,0,0), C0,8); \
    KRD(GL,1); GAPB(o[1]=__builtin_amdgcn_mfma_f32_32x32x16_bf16(PAF(1),VFR(5),o[1],0,0,0), C0,12); \
    KRD(GL,2); GAPB(o[0]=__builtin_amdgcn_mfma_f32_32x32x16_bf16(PAF(2),VFR(2),o[0],0,0,0), C1,0); \
    KRD(GL,3); GAPB(o[1]=__builtin_amdgcn_mfma_f32_32x32x16_bf16(PAF(2),VFR(6),o[1],0,0,0), C1,4); \
    GAPB(o[0]=__builtin_amdgcn_mfma_f32_32x32x16_bf16(PAF(3),VFR(3),o[0],0,0,0), C1,8); \
    GAPB(o[1]=__builtin_amdgcn_mfma_f32_32x32x16_bf16(PAF(3),VFR(7),o[1],0,0,0), C1,12); \
    }while(0)
  int t=1;
  #undef CMASK
  #define CMASK(P0,P1,t) bmask(P0,P1,((selm>>((t)>>2))&1u)!=0u,mhat)
  for(;t+5<NT;t+=2){
    STEP(pB0,pB1,pA0,pA1,t,true,true,true);     WAIT_BAR(2); RESC(); ROT();
    STEP(pA0,pA1,pB0,pB1,t+1,true,true,true);   WAIT_BAR(2); RESC(); ROT();
  }
  #undef CMASK
  #define CMASK(P0,P1,t) do{const int jb_=(t)-(NT-4); if(jb_>=0){cmask(P0,P1,qrel-64*jb_,hi); bmask(P0,P1,true,mhat);} else bmask(P0,P1,((selm>>((t)>>2))&1u)!=0u,mhat);}while(0)
  #define ENDW(tt) do{ if((tt)+3<NT){WAIT_BAR(2);} else if((tt)+2<NT){WAIT_BAR(1);} else {WAIT_BAR(0);} }while(0)
  for(;t+1<NT;t+=2){
    STEP(pB0,pB1,pA0,pA1,t,(t+3<NT),(t+1<NT),(t+1<NT));       ENDW(t);   RESC(); ROT();
    STEP(pA0,pA1,pB0,pB1,t+1,(t+4<NT),(t+2<NT),(t+2<NT));     ENDW(t+1); RESC(); ROT();
  }
  STEP(pB0,pB1,pA0,pA1,NT-1,false,false,false); RESC();
  { float sacc=pB0[0]+pB0[1]; _Pragma("unroll") for(int r=2;r<16;++r)sacc+=pB0[r]; _Pragma("unroll") for(int r=0;r<16;++r)sacc+=pB1[r]; l_reg+=sacc;
    pw0=(u32x4){PKW(pB0,0),PKW(pB0,2),PKW(pB0,4),PKW(pB0,6)};pw1=(u32x4){PKW(pB0,8),PKW(pB0,10),PKW(pB0,12),PKW(pB0,14)};pw2=(u32x4){PKW(pB1,0),PKW(pB1,2),PKW(pB1,4),PKW(pB1,6)};pw3=(u32x4){PKW(pB1,8),PKW(pB1,10),PKW(pB1,12),PKW(pB1,14)};
    SBAR(); pv(o,vb0+sl_cur,PAF(0),PAF(1),PAF(2),PAF(3)); }
  #undef PKW
  #undef PAF
  #undef VFR
  #undef PIN
  #undef MX3
  #undef GAPA
  #undef GAPB
  #undef EX
  #undef VRD
  #undef KRD
  #undef STEP
  #undef ENDW
  {auto rr=__builtin_amdgcn_permlane32_swap(__float_as_uint(l_reg),__float_as_uint(l_reg),false,false);l_reg=__uint_as_float(rr[0])+__uint_as_float(rr[1]);}
  if(hi==0)wsf[32+r32]=l_reg;asm volatile("s_waitcnt lgkmcnt(0)":::"memory");
  float rli[16];
  #pragma unroll
  for(int r=0;r<16;++r)rli[r]=__builtin_amdgcn_rcpf(wsf[32+crow(r,hi)]);
  bf16*Ow=O+(rowbase+q0+wid*QBLK)*DM+h*D;
  { bf16*stg=(bf16*)(shm+LDS_OST)+wid*2048;
    #pragma unroll
    for(int r=0;r<16;++r){const int orow=crow(r,hi);
      #pragma unroll
      for(int d0=0;d0<2;++d0)stg[orow*64+d0*32+r32]=__float2bfloat16(o[d0][r]*rli[r]);}
    asm volatile("s_waitcnt lgkmcnt(0)":::"memory");
    #pragma unroll
    for(int i=0;i<4;++i){const int row=i*8+(lane>>3),ch=lane&7; const u32x4 v=*(const u32x4*)(stg+row*64+ch*8); ATTN_STORE16(Ow+(long)row*DM+ch*8,v);} }
  asm volatile("s_waitcnt lgkmcnt(0)\n\ts_barrier":::"memory");
  #undef DMA_K
  #undef DMA_V
  #undef CMASK
  #undef START
  #undef RESC
  #undef ROT
}
constexpr int ATTN_LDS_BYTES=LDS_BYTES;
#undef SBAR
#undef WAIT_BAR
}

constexpr int NWAVES = 8;
constexpr int NPH = 15;
constexpr int N_LAUNCHES = MK_N_LAUNCHES;
static_assert(N_LAUNCHES == 1 || N_LAUNCHES == NPH, "MK_N_LAUNCHES is 1 or NPH");

constexpr size_t MiB = 1u << 20;
constexpr size_t WS_CTL = 0, CTL_ZERO_BYTES = 2 * MiB;
constexpr size_t WS_KMEAN = 1 * MiB;
constexpr size_t WS_GCOUNT = 1 * MiB + 512 * 1024;
constexpr size_t WS_WIN = 2 * MiB;
constexpr size_t WS_WAO = 12 * MiB, WS_WCO = 13 * MiB, WS_WOUT = 14 * MiB;
constexpr size_t WS_WSR = 16 * MiB;
constexpr size_t WS_WSD = 18 * MiB;
constexpr size_t WS_WPG = 19 * MiB, WS_WPP = 21 * MiB;
constexpr size_t WS_ROPE = 22 * MiB;
constexpr size_t WS_SEL = 22 * MiB + 512 * 1024;
constexpr size_t WS_PB = 24 * MiB;
constexpr size_t WS_TOPI = 40 * MiB, WS_TOPW = 41 * MiB, WS_LRANK = 42 * MiB;
constexpr size_t WS_ROWTOK = 43 * MiB, WS_ROWDST = 44 * MiB + 512 * 1024, WS_ROWW = 46 * MiB, WS_WGBASE = 47 * MiB + 256 * 1024;
constexpr size_t WS_WD = 48 * MiB;
constexpr size_t WS_WGU = 176 * MiB;
constexpr size_t WS_YLO = 176 * MiB;
constexpr size_t WS_XB = 432 * MiB;
constexpr size_t WS_S6 = 496 * MiB;
constexpr size_t WS_H = 496 * MiB;
constexpr size_t WS_YHI = 656 * MiB;
constexpr size_t WS_G = 688 * MiB;
constexpr size_t WS_P1 = 816 * MiB;
constexpr size_t WS_LOGITS = 912 * MiB;
constexpr size_t WS_HS = 944 * MiB;
constexpr size_t WS_PP = 960 * MiB;
constexpr size_t WS_END = 1024 * MiB;
static_assert(WS_H + (size_t)RMAX_ * 256 * 2 <= WS_YHI && WS_YHI + (size_t)T_ * 4 * 1024 * 2 <= WS_LOGITS && WS_WGU + (size_t)NE_ * 512 * 1024 * 2 <= WS_XB, "ws map");
static_assert(WS_ROWTOK + (size_t)RMAX_ * 4 <= WS_ROWDST && WS_ROWDST + (size_t)RMAX_ * 4 <= WS_ROWW && WS_ROWW + (size_t)RMAX_ * 4 <= WS_WGBASE, "ws tables");
constexpr int CW_BAR = 4096;

constexpr int RING_OFF = 0, RING_BYTES = 131072;
constexpr int LDSCTL_OFF = RING_BYTES, MISC_OFF = LDSCTL_OFF + 320;
constexpr int LX_HIST = LDSCTL_OFF + 512;
constexpr int LX_PST = LX_HIST + 1024;
constexpr int LX_NB = LX_PST + 1040;
constexpr int LX_BLKE = LX_NB + 1024;
constexpr int LX_XS = LX_BLKE + 2560;
constexpr int LDS_BYTES = 147456;
static_assert(LX_XS + 64 <= LDS_BYTES && attn_body::ATTN_LDS_BYTES <= RING_BYTES, "LDS map");

#define XB_TMO      128
#define XB_XCNT(j)  (256  + 64 * (j))
#define XB_XSUB(j)  (1280 + 64 * (j))
#define XB_XGEN(j)  (2304 + 64 * (j))
#define XB_TOP      3328
#define XB_TOPGEN   3392
#define XCD_BAR_WORDS 3456
#define XB_SPIN_CAP (1u << 18)

__device__ __forceinline__ unsigned xb_ld(unsigned* p)              { return __hip_atomic_load(p, __ATOMIC_RELAXED, __HIP_MEMORY_SCOPE_AGENT); }
__device__ __forceinline__ unsigned xb_add(unsigned* p, unsigned v) { return __hip_atomic_fetch_add(p, v, __ATOMIC_RELAXED, __HIP_MEMORY_SCOPE_AGENT); }
__device__ __forceinline__ unsigned xb_xcc_id() { return (unsigned)__builtin_amdgcn_s_getreg((3 << 11) | 20) & 0xFu; }
#define XB_SPIN(cond, bar) do { unsigned _sp = 0; while (cond) { __builtin_amdgcn_s_sleep(1); \
    if ((++_sp & 255u) == 0u) { if (xb_ld(&(bar)[XB_TMO])) break; if (_sp > XB_SPIN_CAP) { atomicAdd(&(bar)[XB_TMO], 1u); break; } } } } while (0)

struct XcdBarrier {
    unsigned* bar; unsigned x;
    volatile LAS unsigned* st;
};
__device__ __forceinline__ XcdBarrier xcd_barrier_post(unsigned* bar, volatile LAS unsigned* st, int wave) {
    XcdBarrier b; b.bar = bar; b.x = xb_xcc_id(); b.st = st;
    if (wave == 0 && lane_id() == 0) (void)xb_add(&bar[XB_XCNT(b.x)], 1u);
    return b;
}
__device__ __forceinline__ void xcd_barrier_complete(unsigned* bar, unsigned x, unsigned& nloc, unsigned& nx) {
    const unsigned G = gridDim.x * gridDim.y * gridDim.z;
    unsigned sum, cnt, mine, sp = 0u;
    for (;;) {
        sum = 0u; cnt = 0u; mine = 0u;
#pragma unroll
        for (unsigned j = 0; j < 16; ++j) { const unsigned c = xb_ld(&bar[XB_XCNT(j)]); sum += c; cnt += (c > 0u) ? 1u : 0u; mine = (j == x) ? c : mine; }
        if (sum == G) break;
        __builtin_amdgcn_s_sleep(1);
        if ((++sp & 255u) == 0u) { if (xb_ld(&bar[XB_TMO])) break; if (sp > XB_SPIN_CAP) { atomicAdd(&bar[XB_TMO], 1u); break; } }
    }
    nloc = mine > 0u ? mine : 1u; nx = cnt > 0u ? cnt : 1u;
}
__device__ __forceinline__ void xcd_barrier(const XcdBarrier& b, int wave) {
    asm volatile("s_waitcnt vmcnt(0)" ::: "memory");
    __syncthreads();
    if (wave == 0 && lane_id() == 0) {
        unsigned* bar = b.bar;
        __builtin_amdgcn_s_waitcnt(0);
        unsigned nloc = b.st[0], nx = b.st[1];
        if (nloc == 0u) { xcd_barrier_complete(bar, b.x, nloc, nx); b.st[0] = nloc; b.st[1] = nx; }
        const unsigned old = xb_add(&bar[XB_XSUB(b.x)], 1u);
        const unsigned gen = old / nloc;
        if (old + 1u == (gen + 1u) * nloc) {
            __builtin_amdgcn_fence(__ATOMIC_RELEASE, "agent");
            asm volatile("s_waitcnt vmcnt(0)" ::: "memory");
            const unsigned og = xb_add(&bar[XB_TOP], 1u);
            const unsigned tg = og / nx;
            if (og + 1u == (tg + 1u) * nx) xb_add(&bar[XB_TOPGEN], 1u);
            else XB_SPIN(xb_ld(&bar[XB_TOPGEN]) == tg, bar);
            __builtin_amdgcn_fence(__ATOMIC_ACQUIRE, "agent");
            xb_add(&bar[XB_XGEN(b.x)], 1u);
            asm volatile("s_waitcnt vmcnt(0)" ::: "memory");
        } else {
            XB_SPIN(xb_ld(&bar[XB_XGEN(b.x)]) == gen, bar);
            __builtin_amdgcn_fence(__ATOMIC_ACQUIRE, "agent");
            asm volatile("s_waitcnt vmcnt(0)" ::: "memory");
        }
    }
    __syncthreads();
}

struct Args { const float* in[23]; float* out; unsigned char* ws; int ph_lo, ph_hi, li, pad; };

struct Frame {
    LAS unsigned char* lds;
    volatile LAS unsigned* MISC;
    gu32* ctl;
    int wave;
    int vcu, G;
    unsigned char* ws; float* out;
};

__device__ __forceinline__ float wave_sum(float v) {
#pragma unroll
    for (int o = 1; o < 64; o <<= 1) v += __shfl_xor(v, o);
    return v;
}

__device__ __forceinline__ void xpose_item(const float* W, int N, int k0, int n0, bf16* dst, int Kd, LAS float* scr, int lane) {
#pragma unroll 8
    for (int i = 0; i < 32; ++i) { const int kk = 2 * i + (lane >> 5); scr[kk * 33 + (lane & 31)] = W[(size_t)(k0 + kk) * N + n0 + (lane & 31)]; }
    LDS_WAIT(); asm volatile("" ::: "memory");
    const int c = lane & 7;
#pragma unroll
    for (int j = 0; j < 4; ++j) { const int n = (lane >> 3) + 8 * j; const LAS float* s = scr + (8 * c) * 33 + n;
        v4u o; o.x = cvt_pk_bf16(s[0 * 33], s[1 * 33]); o.y = cvt_pk_bf16(s[2 * 33], s[3 * 33]); o.z = cvt_pk_bf16(s[4 * 33], s[5 * 33]); o.w = cvt_pk_bf16(s[6 * 33], s[7 * 33]);
        *(v4u*)(dst + (size_t)n * Kd + 8 * c) = o; }
    LDS_WAIT(); asm volatile("" ::: "memory");
}
__device__ __forceinline__ void xpose_mat(const float* W, int K, int N, bf16* WT, int rbase, int mode, int half, int r, LAS float* scr, int lane) {
    const int nblk = N / 32, kb = r / nblk, nb = r % nblk, k0 = 64 * kb, n0 = 32 * nb;
    const int drow = mode ? (rbase + (n0 >> 7) * 256 + ((n0 & 127) >> 5) * 64 + half * 32 + (n0 & 31)) : (rbase + n0);
    xpose_item(W, N, k0, n0, WT + (size_t)drow * K + k0, K, scr, lane);
}
__device__ __forceinline__ void p0_prologue(Frame& F, const Args& A) {
    const int lane_ = lane_id(), tid_ = F.wave * 64 + lane_; (void)tid_;
    LAS float* scr = (LAS float*)(F.lds + RING_OFF + F.wave * 16384);
    unsigned char* ws = F.ws;
    const int gw = F.vcu * NWAVES + F.wave, NGW = F.G * NWAVES;
    constexpr int I_IN = 16 * 160, I_AO = 8 * 32, I_CO = 8 * 32, I_OUT = 16 * 32, I_R = 16 * 8, I_SG = 16 * 8, I_SU = 16 * 8, I_SD = 4 * 32, I_PG = 16 * 32, I_PP = 4 * 32;
    constexpr int NSMALL = I_IN + I_AO + I_CO + I_OUT + I_R + I_SG + I_SU + I_SD + I_PG + I_PP;
    for (int it = gw; it < NSMALL; it += NGW) {
        int r = it;
        if (r < I_IN) { xpose_mat(A.in[2], 1024, 5120, (bf16*)(ws + WS_WIN), 0, 0, 0, r, scr, lane_); continue; } r -= I_IN;
        if (r < I_AO) { xpose_mat(A.in[4], 512, 1024, (bf16*)(ws + WS_WAO), 0, 0, 0, r, scr, lane_); continue; } r -= I_AO;
        if (r < I_CO) { xpose_mat(A.in[5], 512, 1024, (bf16*)(ws + WS_WCO), 0, 0, 0, r, scr, lane_); continue; } r -= I_CO;
        if (r < I_OUT) { xpose_mat(A.in[6], 1024, 1024, (bf16*)(ws + WS_WOUT), 0, 0, 0, r, scr, lane_); continue; } r -= I_OUT;
        if (r < I_R) { xpose_mat(A.in[9], 1024, 256, (bf16*)(ws + WS_WSR), 512, 0, 0, r, scr, lane_); continue; } r -= I_R;
        if (r < I_SG) { xpose_mat(A.in[14], 1024, 256, (bf16*)(ws + WS_WSR), 0, 1, 0, r, scr, lane_); continue; } r -= I_SG;
        if (r < I_SU) { xpose_mat(A.in[15], 1024, 256, (bf16*)(ws + WS_WSR), 0, 1, 1, r, scr, lane_); continue; } r -= I_SU;
        if (r < I_SD) { xpose_mat(A.in[16], 256, 1024, (bf16*)(ws + WS_WSD), 0, 0, 0, r, scr, lane_); continue; } r -= I_SD;
        if (r < I_PG) { xpose_mat(A.in[19], 1024, 1024, (bf16*)(ws + WS_WPG), 0, 0, 0, r, scr, lane_); continue; } r -= I_PG;
        xpose_mat(A.in[20], 256, 1024, (bf16*)(ws + WS_WPP), 0, 0, 0, r, scr, lane_);
    }
    for (int it = gw; it < NE_ * 384; it += NGW) {
        const int e = it / 384; int r = it % 384;
        if (r < 128) { xpose_mat(A.in[11] + (size_t)e * 1024 * 256, 1024, 256, (bf16*)(ws + WS_WGU), e * 512, 1, 0, r, scr, lane_); continue; } r -= 128;
        if (r < 128) { xpose_mat(A.in[12] + (size_t)e * 1024 * 256, 1024, 256, (bf16*)(ws + WS_WGU), e * 512, 1, 1, r, scr, lane_); continue; } r -= 128;
        xpose_mat(A.in[13] + (size_t)e * 256 * 1024, 256, 1024, (bf16*)(ws + WS_WD), e * 1024, 0, 0, r, scr, lane_);
    }
    {
        const size_t gt = (size_t)F.vcu * 512 + tid_, NT = (size_t)F.G * 512;
#ifdef MK_FILL_G
        { v4u z; z.x = z.y = z.z = z.w = 0u; unsigned char* gp = ws + WS_G; for (size_t i = gt; i < (size_t)(128u << 20) / 16; i += NT) *(v4u*)(gp + i * 16) = z; }
#endif
        const float* x = A.in[0]; bf16* xb = (bf16*)(ws + WS_XB);
        for (size_t i = gt; i < (size_t)T_ * D_ / 8; i += NT) { const f32x4 a = *(const f32x4*)(x + i * 8), b = *(const f32x4*)(x + i * 8 + 4);
            v4u o; o.x = cvt_pk_bf16(a.x, a.y); o.y = cvt_pk_bf16(a.z, a.w); o.z = cvt_pk_bf16(b.x, b.y); o.w = cvt_pk_bf16(b.z, b.w); *(v4u*)(xb + i * 8) = o; }
        const float* p = A.in[1]; bf16* pb = (bf16*)(ws + WS_PB);
        for (size_t i = gt; i < (size_t)T_ * PLE_ / 8; i += NT) { const f32x4 a = *(const f32x4*)(p + i * 8), b = *(const f32x4*)(p + i * 8 + 4);
            v4u o; o.x = cvt_pk_bf16(a.x, a.y); o.y = cvt_pk_bf16(a.z, a.w); o.z = cvt_pk_bf16(b.x, b.y); o.w = cvt_pk_bf16(b.z, b.w); *(v4u*)(pb + i * 8) = o; }
        float* rope = (float*)(ws + WS_ROPE);
        for (size_t i = gt; i < (size_t)SEQ_ * 8; i += NT) {
            const int pos = (int)(i >> 3), fi = (int)(i & 7);
            const float invf = (float)exp(-(double)fi * 0.125 * log(500000.0));
            const float angf = (float)pos * invf;
            const double ang = (double)angf;
            const double kq = rint(ang * 0.63661977236758134308);
            const double rr = (ang - kq * 1.57079632679489655800) - kq * 6.12323399573676603587e-17;
            const double r2 = rr * rr;
            const double sn = rr * (1.0 + r2 * (-1.0 / 6 + r2 * (1.0 / 120 + r2 * (-1.0 / 5040 + r2 * (1.0 / 362880 + r2 * (-1.0 / 39916800 + r2 * (1.0 / 6227020800.0)))))));
            const double cs = 1.0 + r2 * (-0.5 + r2 * (1.0 / 24 + r2 * (-1.0 / 720 + r2 * (1.0 / 40320 + r2 * (-1.0 / 3628800 + r2 * (1.0 / 479001600.0 + r2 * (-1.0 / 87178291200.0)))))));
            const int q = (int)(((long long)kq) & 3);
            const double c = (q == 0) ? cs : (q == 1) ? -sn : (q == 2) ? -cs : sn;
            const double s = (q == 0) ? sn : (q == 1) ? cs : (q == 2) ? -sn : -cs;
            rope[pos * 16 + fi] = (float)c; rope[pos * 16 + 8 + fi] = (float)s;
        }
    }
}

typedef const f32x4 (&AccRef)[2][2][4][2];
__device__ __forceinline__ void store_rows128(bf16* rowA, bf16* rowB, int fr, int fq, v4u p0, v4u p1) {
    const bool low = (fr & 8) == 0;
    const v4u snd = low ? p1 : p0; v4u rcv;
    rcv.x = __shfl_xor(snd.x, 8); rcv.y = __shfl_xor(snd.y, 8); rcv.z = __shfl_xor(snd.z, 8); rcv.w = __shfl_xor(snd.w, 8);
    const v4u dA = low ? p0 : rcv, dB = low ? rcv : p1;
    const int colb = (low ? 0 : 32) + 8 * fq;
    if (rowA) *(v4u*)(rowA + colb) = dA;
    if (rowB) *(v4u*)(rowB + colb) = dB;
}

struct EpiZ {
    static constexpr bool PERM = true;
    bf16* S6; bf16* Gt; const float* rope; float* kmean;
    __device__ __forceinline__ void operator()(AccRef acc, const pg8::Unit& u, int wr, int wc, int fr, int fq) const {
        const int pn = u.pn, row0 = u.row0 + wr * 64 + fr, ct0 = wc * 64 + 8 * fq, rg0 = u.row0 + wr * 64 + (fr & 7);
        if (pn < 12) {
            bf16* base = S6 + (size_t)(pn >> 1) * T_ * 512 + (pn & 1) * 256 + wc * 64;
            const bool ropew = (pn < 4);
            const bool isk = (pn == 2) || (pn == 3);
            const float sc = (pn < 2) ? attn_body::C2 : 1.f;
            float ks[2][8];
#pragma unroll
            for (int bj = 0; bj < 2; ++bj)
#pragma unroll
                for (int i = 0; i < 8; ++i) ks[bj][i] = 0.f;
#pragma unroll
            for (int ai = 0; ai < 2; ++ai)
#pragma unroll
                for (int m = 0; m < 4; ++m) {
                    const int r = row0 + ai * 128 + m * 16;
                    float cs[8], sn[8];
                    if (ropew) { const float* rp = rope + (size_t)(r & (SEQ_ - 1)) * 16; const f32x4 c0 = *(const f32x4*)rp, c1 = *(const f32x4*)(rp + 4), s0 = *(const f32x4*)(rp + 8), s1 = *(const f32x4*)(rp + 12);
                        cs[0] = c0.x; cs[1] = c0.y; cs[2] = c0.z; cs[3] = c0.w; cs[4] = c1.x; cs[5] = c1.y; cs[6] = c1.z; cs[7] = c1.w;
                        sn[0] = s0.x; sn[1] = s0.y; sn[2] = s0.z; sn[3] = s0.w; sn[4] = s1.x; sn[5] = s1.y; sn[6] = s1.z; sn[7] = s1.w; }
                    v4u pc[2];
#pragma unroll
                    for (int bj = 0; bj < 2; ++bj) {
                        const f32x4 v0 = acc[ai][bj][m][0], v1 = acc[ai][bj][m][1];
                        float x[8] = {v0.x, v0.y, v0.z, v0.w, v1.x, v1.y, v1.z, v1.w};
                        if (ropew && bj == 0) {
#pragma unroll
                            for (int i = 0; i < 8; ++i) { const float o = __shfl_xor(x[i], 16);
                                const float a = x[i] * cs[i] - o * sn[i];
                                const float b = o * sn[i] + x[i] * cs[i];
                                x[i] = (fq == 0) ? a : (fq == 1) ? b : x[i]; }
                        }
                        if (isk) {
#pragma unroll
                            for (int i = 0; i < 8; ++i) ks[bj][i] += x[i];
                        }
                        v4u w; w.x = cvt_pk_bf16(x[0] * sc, x[1] * sc); w.y = cvt_pk_bf16(x[2] * sc, x[3] * sc); w.z = cvt_pk_bf16(x[4] * sc, x[5] * sc); w.w = cvt_pk_bf16(x[6] * sc, x[7] * sc);
                        pc[bj] = w;
                    }
                    { bf16* ra = base + (size_t)(rg0 + ai * 128 + m * 16) * 512; store_rows128(ra, ra + 8 * 512, fr, fq, pc[0], pc[1]); }
                }
            if (isk) {
                const int b = u.row0 / SEQ_, blk = (u.row0 % SEQ_) / 256;
#pragma unroll
                for (int bj = 0; bj < 2; ++bj)
#pragma unroll
                    for (int i = 0; i < 8; ++i) { float s = ks[bj][i]; s += __shfl_xor(s, 1); s += __shfl_xor(s, 2); s += __shfl_xor(s, 4); s += __shfl_xor(s, 8);
                        if (fr == 0) { const int c = (pn - 2) * 256 + bj * 32 + ct0 + i; atomicAdd(kmean + ((size_t)((b * NH_ + (c >> 6)) * NBLK_ + blk)) * 64 + (c & 63), s * (1.0f / 256.0f)); } }
            }
        } else {
            bf16* base = Gt + (size_t)((pn - 12) >> 2) * T_ * 1024 + (size_t)((pn - 12) & 3) * 256 + wc * 64;
#pragma unroll
            for (int ai = 0; ai < 2; ++ai)
#pragma unroll
                for (int m = 0; m < 4; ++m) { v4u pc[2];
#pragma unroll
                    for (int bj = 0; bj < 2; ++bj) { const f32x4 v0 = acc[ai][bj][m][0], v1 = acc[ai][bj][m][1];
                        v4u w; w.x = cvt_pk_bf16(sigmoidf_(v0.x), sigmoidf_(v0.y)); w.y = cvt_pk_bf16(sigmoidf_(v0.z), sigmoidf_(v0.w)); w.z = cvt_pk_bf16(sigmoidf_(v1.x), sigmoidf_(v1.y)); w.w = cvt_pk_bf16(sigmoidf_(v1.z), sigmoidf_(v1.w));
                        pc[bj] = w; }
                    bf16* ra = base + (size_t)(rg0 + ai * 128 + m * 16) * 1024; store_rows128(ra, ra + 8 * 1024, fr, fq, pc[0], pc[1]); }
        }
    }
};

template <bool ADD> struct EpiGate {
    static constexpr bool PERM = true;
    bf16* O; const bf16* gate;
    __device__ __forceinline__ void operator()(AccRef acc, const pg8::Unit& u, int wr, int wc, int fr, int fq) const {
        const int row0 = u.row0 + wr * 64 + fr, col0 = u.pn * 256 + wc * 64 + 8 * fq, rg0 = u.row0 + wr * 64 + (fr & 7);
#pragma unroll
        for (int ai = 0; ai < 2; ++ai) {
            v4u g[4][2], p[4][2];
#pragma unroll
            for (int m = 0; m < 4; ++m)
#pragma unroll
                for (int bj = 0; bj < 2; ++bj) { const size_t off = (size_t)(row0 + ai * 128 + m * 16) * 1024 + col0 + bj * 32; g[m][bj] = *(const v4u*)(gate + off); if (ADD) p[m][bj] = *(const v4u*)(O + off); }
            asm volatile("" ::: "memory");
#pragma unroll
            for (int m = 0; m < 4; ++m) { v4u pc[2];
#pragma unroll
                for (int bj = 0; bj < 2; ++bj) { const f32x4 v0 = acc[ai][bj][m][0], v1 = acc[ai][bj][m][1]; const v4u gg = g[m][bj];
                    float y[8] = {bf_lo(gg.x) * v0.x, bf_hi(gg.x) * v0.y, bf_lo(gg.y) * v0.z, bf_hi(gg.y) * v0.w, bf_lo(gg.z) * v1.x, bf_hi(gg.z) * v1.y, bf_lo(gg.w) * v1.z, bf_hi(gg.w) * v1.w};
                    if (ADD) { const v4u pp = p[m][bj]; y[0] += bf_lo(pp.x); y[1] += bf_hi(pp.x); y[2] += bf_lo(pp.y); y[3] += bf_hi(pp.y); y[4] += bf_lo(pp.z); y[5] += bf_hi(pp.z); y[6] += bf_lo(pp.w); y[7] += bf_hi(pp.w); }
                    v4u w; w.x = cvt_pk_bf16(y[0], y[1]); w.y = cvt_pk_bf16(y[2], y[3]); w.z = cvt_pk_bf16(y[4], y[5]); w.w = cvt_pk_bf16(y[6], y[7]);
                    pc[bj] = w; }
                bf16* ra = O + (size_t)(rg0 + ai * 128 + m * 16) * 1024 + u.pn * 256 + wc * 64; store_rows128(ra, ra + 8 * 1024, fr, fq, pc[0], pc[1]); }
            asm volatile("" ::: "memory");
        }
    }
};

template <bool RBF> struct EpiRes {
    static constexpr bool PERM = true;
    bf16* O; const void* R;
    __device__ __forceinline__ void operator()(AccRef acc, const pg8::Unit& u, int wr, int wc, int fr, int fq) const {
        const int row0 = u.row0 + wr * 64 + fr, col0 = u.pn * 256 + wc * 64 + 8 * fq, rg0 = u.row0 + wr * 64 + (fr & 7);
#pragma unroll
        for (int ai = 0; ai < 2; ++ai) {
            f32x4 ra[4][2], rb[4][2]; v4u rh[4][2];
#pragma unroll
            for (int m = 0; m < 4; ++m)
#pragma unroll
                for (int bj = 0; bj < 2; ++bj) { const size_t off = (size_t)(row0 + ai * 128 + m * 16) * D_ + col0 + bj * 32;
                    if (RBF) rh[m][bj] = *(const v4u*)((const bf16*)R + off); else { ra[m][bj] = *(const f32x4*)((const float*)R + off); rb[m][bj] = *(const f32x4*)((const float*)R + off + 4); } }
            asm volatile("" ::: "memory");
#pragma unroll
            for (int m = 0; m < 4; ++m) { v4u pc[2];
#pragma unroll
                for (int bj = 0; bj < 2; ++bj) { const f32x4 v0 = acc[ai][bj][m][0], v1 = acc[ai][bj][m][1];
                    float r[8];
                    if (RBF) { const v4u h = rh[m][bj]; r[0] = bf_lo(h.x); r[1] = bf_hi(h.x); r[2] = bf_lo(h.y); r[3] = bf_hi(h.y); r[4] = bf_lo(h.z); r[5] = bf_hi(h.z); r[6] = bf_lo(h.w); r[7] = bf_hi(h.w); }
                    else { const f32x4 a = ra[m][bj], b = rb[m][bj]; r[0] = a.x; r[1] = a.y; r[2] = a.z; r[3] = a.w; r[4] = b.x; r[5] = b.y; r[6] = b.z; r[7] = b.w; }
                    v4u w; w.x = cvt_pk_bf16(r[0] * DN_ALPHA_ + v0.x, r[1] * DN_ALPHA_ + v0.y); w.y = cvt_pk_bf16(r[2] * DN_ALPHA_ + v0.z, r[3] * DN_ALPHA_ + v0.w);
                    w.z = cvt_pk_bf16(r[4] * DN_ALPHA_ + v1.x, r[5] * DN_ALPHA_ + v1.y); w.w = cvt_pk_bf16(r[6] * DN_ALPHA_ + v1.z, r[7] * DN_ALPHA_ + v1.w);
                    pc[bj] = w; }
                bf16* rowa = O + (size_t)(rg0 + ai * 128 + m * 16) * D_ + u.pn * 256 + wc * 64; store_rows128(rowa, rowa + 8 * D_, fr, fq, pc[0], pc[1]); }
            asm volatile("" ::: "memory");
        }
    }
};

__device__ __forceinline__ void swiglu_store(AccRef acc, bf16* Hrow0  , int ld, int wr, int wc, int fr, int fq) {
#pragma unroll
    for (int ai = 0; ai < 2; ++ai)
#pragma unroll
        for (int m = 0; m < 4; ++m) { bf16* hp = Hrow0 + (size_t)(wr * 64 + fr + ai * 128 + m * 16) * ld + wc * 32 + 8 * fq;
            float y[8];
#pragma unroll
            for (int n = 0; n < 2; ++n)
#pragma unroll
                for (int j = 0; j < 4; ++j) { const float g = acc[ai][0][m][n][j], up = acc[ai][1][m][n][j]; y[n * 4 + j] = g * sigmoidf_(g) * up; }
            v4u w; w.x = cvt_pk_bf16(y[0], y[1]); w.y = cvt_pk_bf16(y[2], y[3]); w.z = cvt_pk_bf16(y[4], y[5]); w.w = cvt_pk_bf16(y[6], y[7]);
            *(v4u*)hp = w; asm volatile("" ::: "memory"); }
}
struct EpiShRouter {
    static constexpr bool PERM = true;
    bf16* Hs; float* logits;
    __device__ __forceinline__ void operator()(AccRef acc, const pg8::Unit& u, int wr, int wc, int fr, int fq) const {
        if (u.pn < 2) { swiglu_store(acc, Hs + (size_t)u.row0 * 256 + u.pn * 128, 256, wr, wc, fr, fq); return; }
#pragma unroll
        for (int ai = 0; ai < 2; ++ai)
#pragma unroll
            for (int m = 0; m < 4; ++m) { float* lp = logits + (size_t)(u.row0 + wr * 64 + fr + ai * 128 + m * 16) * 256 + wc * 64 + 8 * fq;
#pragma unroll
                for (int bj = 0; bj < 2; ++bj) { *(f32x4*)(lp + bj * 32) = acc[ai][bj][m][0]; *(f32x4*)(lp + bj * 32 + 4) = acc[ai][bj][m][1]; } asm volatile("" ::: "memory"); }
    }
};
struct EpiMoeUp {
    static constexpr bool PERM = true;
    bf16* H;
    __device__ __forceinline__ void operator()(AccRef acc, const pg8::Unit& u, int wr, int wc, int fr, int fq) const { swiglu_store(acc, H + (size_t)u.row0 * 256 + u.pn * 128, 256, wr, wc, fr, fq); }
};
struct EpiMoeDown {
    static constexpr bool PERM = true;
    bf16* Ylo; bf16* Yhi; const int* row_dst; const float* row_w;
    __device__ __forceinline__ bf16* yrow(int dst) const { return dst < 0 ? nullptr : (dst < T_ * 4 ? Ylo + (size_t)dst * 1024 : Yhi + (size_t)(dst - T_ * 4) * 1024); }
    __device__ __forceinline__ void operator()(AccRef acc, const pg8::Unit& u, int wr, int wc, int fr, int fq) const {
        const int s0 = u.row0 + wr * 64, colw = u.pn * 256 + wc * 64;
        int dA[2][4], dB[2][4]; float ws_[2][4];
#pragma unroll
        for (int ai = 0; ai < 2; ++ai)
#pragma unroll
            for (int m = 0; m < 4; ++m) { const int g = s0 + ai * 128 + m * 16; dA[ai][m] = row_dst[g + (fr & 7)]; dB[ai][m] = row_dst[g + 8 + (fr & 7)]; ws_[ai][m] = row_w[g + fr]; }
        asm volatile("" ::: "memory");
#pragma unroll
        for (int ai = 0; ai < 2; ++ai)
#pragma unroll
            for (int m = 0; m < 4; ++m) { const float w = ws_[ai][m]; v4u pc[2];
#pragma unroll
                for (int bj = 0; bj < 2; ++bj) { const f32x4 v0 = acc[ai][bj][m][0] * w, v1 = acc[ai][bj][m][1] * w;
                    v4u o; o.x = cvt_pk_bf16(v0.x, v0.y); o.y = cvt_pk_bf16(v0.z, v0.w); o.z = cvt_pk_bf16(v1.x, v1.y); o.w = cvt_pk_bf16(v1.z, v1.w); pc[bj] = o; }
                bf16* ra = yrow(dA[ai][m]); bf16* rb = yrow(dB[ai][m]);
                store_rows128(ra ? ra + colw : nullptr, rb ? rb + colw : nullptr, fr, fq, pc[0], pc[1]); }
    }
};
struct EpiBf16Plain {
    static constexpr bool PERM = true;
    bf16* O; int ldc;
    __device__ __forceinline__ void operator()(AccRef acc, const pg8::Unit& u, int wr, int wc, int fr, int fq) const {
        const int rg0 = u.row0 + wr * 64 + (fr & 7), colw = u.pn * 256 + wc * 64;
#pragma unroll
        for (int ai = 0; ai < 2; ++ai)
#pragma unroll
            for (int m = 0; m < 4; ++m) { v4u pc[2];
#pragma unroll
                for (int bj = 0; bj < 2; ++bj) { const f32x4 v0 = acc[ai][bj][m][0], v1 = acc[ai][bj][m][1];
                    v4u o; o.x = cvt_pk_bf16(v0.x, v0.y); o.y = cvt_pk_bf16(v0.z, v0.w); o.z = cvt_pk_bf16(v1.x, v1.y); o.w = cvt_pk_bf16(v1.z, v1.w); pc[bj] = o; }
                bf16* ra = O + (size_t)(rg0 + ai * 128 + m * 16) * ldc + colw; store_rows128(ra, ra + (size_t)8 * ldc, fr, fq, pc[0], pc[1]); }
    }
};
struct EpiPle {
    static constexpr bool PERM = true;
    bf16* X; const bf16* Hres; const bf16* PP;
    __device__ __forceinline__ void operator()(AccRef acc, const pg8::Unit& u, int wr, int wc, int fr, int fq) const {
        const int row0 = u.row0 + wr * 64 + fr, col0 = u.pn * 256 + wc * 64 + 8 * fq, rg0 = u.row0 + wr * 64 + (fr & 7);
#pragma unroll
        for (int ai = 0; ai < 2; ++ai) {
            v4u pv[4][2], hv[4][2];
#pragma unroll
            for (int m = 0; m < 4; ++m)
#pragma unroll
                for (int bj = 0; bj < 2; ++bj) { const size_t ro = (size_t)(row0 + ai * 128 + m * 16) * D_ + col0 + bj * 32; pv[m][bj] = *(const v4u*)(PP + ro); hv[m][bj] = *(const v4u*)(Hres + ro); }
            asm volatile("" ::: "memory");
#pragma unroll
            for (int m = 0; m < 4; ++m) { v4u pc[2];
#pragma unroll
                for (int bj = 0; bj < 2; ++bj) { const f32x4 v0 = acc[ai][bj][m][0], v1 = acc[ai][bj][m][1];
                    const v4u p = pv[m][bj], h = hv[m][bj];
                    f32x4 o0, o1;
                    o0.x = bf_lo(h.x) * DN_ALPHA_ + sigmoidf_(v0.x) * bf_lo(p.x); o0.y = bf_hi(h.x) * DN_ALPHA_ + sigmoidf_(v0.y) * bf_hi(p.x); o0.z = bf_lo(h.y) * DN_ALPHA_ + sigmoidf_(v0.z) * bf_lo(p.y); o0.w = bf_hi(h.y) * DN_ALPHA_ + sigmoidf_(v0.w) * bf_hi(p.y);
                    o1.x = bf_lo(h.z) * DN_ALPHA_ + sigmoidf_(v1.x) * bf_lo(p.z); o1.y = bf_hi(h.z) * DN_ALPHA_ + sigmoidf_(v1.y) * bf_hi(p.z); o1.z = bf_lo(h.w) * DN_ALPHA_ + sigmoidf_(v1.z) * bf_lo(p.w); o1.w = bf_hi(h.w) * DN_ALPHA_ + sigmoidf_(v1.w) * bf_hi(p.w);
                    v4u w; w.x = cvt_pk_bf16(o0.x, o0.y); w.y = cvt_pk_bf16(o0.z, o0.w); w.z = cvt_pk_bf16(o1.x, o1.y); w.w = cvt_pk_bf16(o1.z, o1.w); pc[bj] = w; }
                bf16* rowa = X + (size_t)(rg0 + ai * 128 + m * 16) * D_ + u.pn * 256 + wc * 64; store_rows128(rowa, rowa + 8 * D_, fr, fq, pc[0], pc[1]); }
            asm volatile("" ::: "memory");
        }
    }
};

struct EpiNull { static constexpr bool PERM = true; __device__ __forceinline__ void operator()(AccRef acc, const pg8::Unit& u, int, int, int, int) const { if (u.row0 == -12345) { float* p = nullptr; p[0] = acc[0][0][0][0].x; } } };
__device__ __forceinline__ void moe_tables(Frame& F) {
    const int lane_ = lane_id(), tid_ = F.wave * 64 + lane_; (void)tid_;
    LAS unsigned* PST = (LAS unsigned*)(F.lds + LX_PST); LAS unsigned* NB = (LAS unsigned*)(F.lds + LX_NB); LAS unsigned short* BLKE = (LAS unsigned short*)(F.lds + LX_BLKE);
    const unsigned* gcount = (const unsigned*)(F.ws + WS_GCOUNT);
    __syncthreads();
    if (tid_ < 256) NB[tid_] = (gcount[tid_] + 255u) >> 8;
    __syncthreads();
    if (tid_ < 256) { const int pe = (tid_ & 7) * 32 + (tid_ >> 3); unsigned s = 0, tot = 0; for (int j = 0; j < 256; ++j) { const unsigned nbj = NB[j]; tot += nbj; if (((j & 7) * 32 + (j >> 3)) < pe) s += nbj; }
        PST[tid_] = s * 256u; if (tid_ == 255) PST[256] = tot;
        LAS unsigned* XS = (LAS unsigned*)(F.lds + LX_XS); if (tid_ < 8) XS[tid_] = s; if (tid_ == 8) XS[8] = tot;
        const unsigned nb = NB[tid_]; for (unsigned i = 0; i < nb; ++i) BLKE[s + i] = (unsigned short)tid_; }
    __syncthreads();
}
struct MoeUpOrder {
    static constexpr bool GATHER = true;
    const LAS unsigned short* blke; const LAS unsigned* xs; const int* row_tok; const char* A; const char* Bt; int wpl, vcu;
    __device__ __forceinline__ bool next(int i, pg8::Unit& u) const {
        const int x = vcu / wpl, n = i * wpl + (vcu % wpl); if (x >= 8) return false;
        const int b0 = (int)xs[x], b1 = (int)xs[x + 1], rbl = n >> 1, pn = n & 1; if (rbl >= b1 - b0) return false;
        const int rb = b0 + rbl; const int e = __builtin_amdgcn_readfirstlane((int)blke[rb]);
        u.a = A; u.b = Bt + ((size_t)e * 512 + pn * 256) * 1024 * 2; u.row0 = rb * 256; u.pn = pn; u.e = e; return true;
    }
    __device__ __forceinline__ void aoff(const pg8::Unit& u, int tid, unsigned (&v)[2][2]) const {
#pragma unroll
        for (int i = 0; i < 2; ++i) { int R, C; pg8::stage_rc(tid * 16 + i * 8192, R, C);
#pragma unroll
            for (int h = 0; h < 2; ++h) { const int tok = row_tok[u.row0 + h * 128 + R]; v[h][i] = (unsigned)(tok * 1024 + C) * 2u; } }
    }
};
struct MoeDownOrder {
    static constexpr bool GATHER = false;
    const LAS unsigned short* blke; const LAS unsigned* xs; const char* A; const char* Bt; int wpl, vcu;
    __device__ __forceinline__ bool next(int i, pg8::Unit& u) const {
        const int x = vcu / wpl, n = i * wpl + (vcu % wpl); if (x >= 8) return false;
        const int b0 = (int)xs[x], b1 = (int)xs[x + 1], rbl = n >> 2, pn = n & 3; if (rbl >= b1 - b0) return false;
        const int rb = b0 + rbl; const int e = __builtin_amdgcn_readfirstlane((int)blke[rb]);
        u.a = A + (size_t)rb * 256 * 256 * 2; u.b = Bt + ((size_t)e * 1024 + pn * 256) * 256 * 2; u.row0 = rb * 256; u.pn = pn; u.e = e; return true;
    }
};

__device__ __forceinline__ void p_conv(Frame& F, const float* conv_w) {
    const int lane_ = lane_id(), tid_ = F.wave * 64 + lane_; (void)tid_;
    bf16* cb = (bf16*)(F.ws + WS_S6) + (size_t)3 * T_ * 512; const bf16* cc = (const bf16*)(F.ws + WS_S6) + (size_t)4 * T_ * 512; const bf16* ch = (const bf16*)(F.ws + WS_S6) + (size_t)5 * T_ * 512;
    const int gw = F.vcu * NWAVES + F.wave, NGW = F.G * NWAVES, c0 = lane_ * 8;
    float w0[8], w1[8], w2[8];
#pragma unroll
    for (int i = 0; i < 8; ++i) { w0[i] = conv_w[c0 + i]; w1[i] = conv_w[512 + c0 + i]; w2[i] = conv_w[1024 + c0 + i]; }
    for (int ck = gw; ck < T_ / 32; ck += NGW) {
        const int t0 = ck * 32;
        float u1[8], u2[8];
#pragma unroll
        for (int i = 0; i < 8; ++i) { u1[i] = 0.f; u2[i] = 0.f; }
        if ((t0 & (SEQ_ - 1)) != 0) {
            const v4u a2 = *(const v4u*)(cc + (size_t)(t0 - 2) * 512 + c0), b2 = *(const v4u*)(ch + (size_t)(t0 - 2) * 512 + c0);
            const v4u a1 = *(const v4u*)(cc + (size_t)(t0 - 1) * 512 + c0), b1 = *(const v4u*)(ch + (size_t)(t0 - 1) * 512 + c0);
            u2[0] = bf_lo(a2.x) * bf_lo(b2.x); u2[1] = bf_hi(a2.x) * bf_hi(b2.x); u2[2] = bf_lo(a2.y) * bf_lo(b2.y); u2[3] = bf_hi(a2.y) * bf_hi(b2.y);
            u2[4] = bf_lo(a2.z) * bf_lo(b2.z); u2[5] = bf_hi(a2.z) * bf_hi(b2.z); u2[6] = bf_lo(a2.w) * bf_lo(b2.w); u2[7] = bf_hi(a2.w) * bf_hi(b2.w);
            u1[0] = bf_lo(a1.x) * bf_lo(b1.x); u1[1] = bf_hi(a1.x) * bf_hi(b1.x); u1[2] = bf_lo(a1.y) * bf_lo(b1.y); u1[3] = bf_hi(a1.y) * bf_hi(b1.y);
            u1[4] = bf_lo(a1.z) * bf_lo(b1.z); u1[5] = bf_hi(a1.z) * bf_hi(b1.z); u1[6] = bf_lo(a1.w) * bf_lo(b1.w); u1[7] = bf_hi(a1.w) * bf_hi(b1.w);
        }
#pragma unroll 4
        for (int t = t0; t < t0 + 32; ++t) {
            const v4u a = *(const v4u*)(cc + (size_t)t * 512 + c0), b = *(const v4u*)(ch + (size_t)t * 512 + c0), g = *(const v4u*)(cb + (size_t)t * 512 + c0);
            float u0[8] = {bf_lo(a.x) * bf_lo(b.x), bf_hi(a.x) * bf_hi(b.x), bf_lo(a.y) * bf_lo(b.y), bf_hi(a.y) * bf_hi(b.y), bf_lo(a.z) * bf_lo(b.z), bf_hi(a.z) * bf_hi(b.z), bf_lo(a.w) * bf_lo(b.w), bf_hi(a.w) * bf_hi(b.w)};
            const float gb[8] = {bf_lo(g.x), bf_hi(g.x), bf_lo(g.y), bf_hi(g.y), bf_lo(g.z), bf_hi(g.z), bf_lo(g.w), bf_hi(g.w)};
            float y[8];
#pragma unroll
            for (int i = 0; i < 8; ++i) { y[i] = gb[i] * (w0[i] * u2[i] + w1[i] * u1[i] + w2[i] * u0[i]); u2[i] = u1[i]; u1[i] = u0[i]; }
            v4u o; o.x = cvt_pk_bf16(y[0], y[1]); o.y = cvt_pk_bf16(y[2], y[3]); o.z = cvt_pk_bf16(y[4], y[5]); o.w = cvt_pk_bf16(y[6], y[7]);
            *(v4u*)(cb + (size_t)t * 512 + c0) = o;
        }
    }
}
__device__ __forceinline__ void p_select(Frame& F) {
    const int lane_ = lane_id(), tid_ = F.wave * 64 + lane_; (void)tid_;
    const bf16* Q = (const bf16*)(F.ws + WS_S6); const float* kmean = (const float*)(F.ws + WS_KMEAN); unsigned* SEL = (unsigned*)(F.ws + WS_SEL);
    const int gt = F.vcu * 512 + tid_, NT = F.G * 512;
    for (int it = gt; it < NB_ * NH_ * SEQ_; it += NT) {
        const int s = it & (SEQ_ - 1), bh = it >> 12, b = bh >> 3, h = bh & 7;
        const int own = __builtin_amdgcn_readfirstlane(s >> 8);
        const int bhu = __builtin_amdgcn_readfirstlane(bh);
        float q[64];
        const bf16* qp = Q + ((size_t)(b * SEQ_ + s)) * 512 + h * 64;
#pragma unroll
        for (int i = 0; i < 8; ++i) { const v4u w = *(const v4u*)(qp + i * 8); q[i * 8 + 0] = bf_lo(w.x); q[i * 8 + 1] = bf_hi(w.x); q[i * 8 + 2] = bf_lo(w.y); q[i * 8 + 3] = bf_hi(w.y); q[i * 8 + 4] = bf_lo(w.z); q[i * 8 + 5] = bf_hi(w.z); q[i * 8 + 6] = bf_lo(w.w); q[i * 8 + 7] = bf_hi(w.w); }
        float v0 = -INFINITY, v1 = -INFINITY, v2 = -INFINITY; int i0 = -1, i1 = -1, i2 = -1;
        for (int j = 0; j < own; ++j) {
            const float* km = kmean + ((size_t)(bhu * NBLK_ + j)) * 64;
            float d = 0.f;
#pragma unroll
            for (int i = 0; i < 64; ++i) d += q[i] * km[i];
            if (d > v0) { v2 = v1; i2 = i1; v1 = v0; i1 = i0; v0 = d; i0 = j; }
            else if (d > v1) { v2 = v1; i2 = i1; v1 = d; i1 = j; }
            else if (d > v2) { v2 = d; i2 = j; }
        }
        unsigned m = 0u; if (i0 >= 0) m |= 1u << i0; if (i1 >= 0) m |= 1u << i1; if (i2 >= 0) m |= 1u << i2;
        SEL[it] = m;
    }
}

struct AttnOrder {
    int vcu;
    __device__ __forceinline__ bool next(int i, int& bh, int& qb) const { if (i >= 4 || vcu >= 256) return false; const int j = vcu & 3; bh = vcu >> 2; qb = (i == 0) ? 15 - j : (i == 1) ? 8 + j : (i == 2) ? 7 - j : j; return true; }
};

template <bool ADD_Y, bool WRITE_F32, bool WRITE_BF>
__device__ __forceinline__ void ln_row(Frame& F, const bf16* src, float* dst, bf16* dstb, const float* gam, const float* bet, const bf16* y0, const bf16* y1, int row) {
    const int lane_ = lane_id();
    float v[2][8];
#pragma unroll
    for (int h = 0; h < 2; ++h) { const v4u w = *(const v4u*)(src + (size_t)row * D_ + 512 * h + lane_ * 8);
        v[h][0] = bf_lo(w.x); v[h][1] = bf_hi(w.x); v[h][2] = bf_lo(w.y); v[h][3] = bf_hi(w.y); v[h][4] = bf_lo(w.z); v[h][5] = bf_hi(w.z); v[h][6] = bf_lo(w.w); v[h][7] = bf_hi(w.w); }
    if (ADD_Y) {
        const bf16* yb = (row < T_ / 2) ? y0 + (size_t)row * 8 * 1024 : y1 + (size_t)(row - T_ / 2) * 8 * 1024;
#pragma unroll
        for (int k = 0; k < 8; ++k)
#pragma unroll
            for (int h = 0; h < 2; ++h) { const v4u w = *(const v4u*)(yb + (size_t)k * 1024 + 512 * h + lane_ * 8);
                v[h][0] += bf_lo(w.x); v[h][1] += bf_hi(w.x); v[h][2] += bf_lo(w.y); v[h][3] += bf_hi(w.y); v[h][4] += bf_lo(w.z); v[h][5] += bf_hi(w.z); v[h][6] += bf_lo(w.w); v[h][7] += bf_hi(w.w); }
    }
    float s = 0.f;
#pragma unroll
    for (int h = 0; h < 2; ++h)
#pragma unroll
        for (int i = 0; i < 8; ++i) s += v[h][i];
    const float mean = wave_sum(s) * (1.f / D_); float s2 = 0.f;
#pragma unroll
    for (int h = 0; h < 2; ++h)
#pragma unroll
        for (int i = 0; i < 8; ++i) { v[h][i] -= mean; s2 += v[h][i] * v[h][i]; }
    const float rstd = 1.f / sqrtf(wave_sum(s2) * (1.f / D_) + LN_EPS_);
#pragma unroll
    for (int h = 0; h < 2; ++h) { const int c0 = 512 * h + lane_ * 8;
        const f32x4 g0 = *(const f32x4*)(gam + c0), g1 = *(const f32x4*)(gam + c0 + 4), b0 = *(const f32x4*)(bet + c0), b1 = *(const f32x4*)(bet + c0 + 4);
        f32x4 o0, o1; o0.x = v[h][0] * rstd * g0.x + b0.x; o0.y = v[h][1] * rstd * g0.y + b0.y; o0.z = v[h][2] * rstd * g0.z + b0.z; o0.w = v[h][3] * rstd * g0.w + b0.w;
        o1.x = v[h][4] * rstd * g1.x + b1.x; o1.y = v[h][5] * rstd * g1.y + b1.y; o1.z = v[h][6] * rstd * g1.z + b1.z; o1.w = v[h][7] * rstd * g1.w + b1.w;
        if (WRITE_F32) { *(f32x4*)(dst + (size_t)row * D_ + c0) = o0; *(f32x4*)(dst + (size_t)row * D_ + c0 + 4) = o1; }
        if (WRITE_BF) { v4u w; w.x = cvt_pk_bf16(o0.x, o0.y); w.y = cvt_pk_bf16(o0.z, o0.w); w.z = cvt_pk_bf16(o1.x, o1.y); w.w = cvt_pk_bf16(o1.z, o1.w); *(v4u*)(dstb + (size_t)row * D_ + c0) = w; } }
}

__device__ __forceinline__ void p_route(Frame& F, const float* router_bias) {
    const int lane_ = lane_id(), tid_ = F.wave * 64 + lane_; (void)tid_;
    LAS unsigned* hist = (LAS unsigned*)(F.lds + LX_HIST);
    const float* logits = (const float*)(F.ws + WS_LOGITS);
    int* topi = (int*)(F.ws + WS_TOPI); float* topw = (float*)(F.ws + WS_TOPW); int* lrank = (int*)(F.ws + WS_LRANK);
    unsigned* gcount = (unsigned*)(F.ws + WS_GCOUNT); unsigned* wgbase = (unsigned*)(F.ws + WS_WGBASE);
    { int* row_tok = (int*)(F.ws + WS_ROWTOK); int* row_dst = (int*)(F.ws + WS_ROWDST); float* row_w = (float*)(F.ws + WS_ROWW);
      for (int i = blockIdx.x * 512 + tid_; i < RMAX_; i += F.G * 512) { row_tok[i] = 0; row_dst[i] = -1; row_w[i] = 0.f; } }
    if (tid_ < 256) hist[tid_] = 0u;
    __syncthreads();
    const int lane = lane_;
    const f32x4 bias = *(const f32x4*)(router_bias + lane * 4);
    for (int tok = blockIdx.x * 8 + F.wave; tok < T_; tok += F.G * 8) {
        const f32x4 lg = *(const f32x4*)(logits + (size_t)tok * 256 + lane * 4);
        const float s0 = sigmoidf_(lg.x), s1 = sigmoidf_(lg.y), s2 = sigmoidf_(lg.z), s3 = sigmoidf_(lg.w);
        float c0 = s0 + bias.x, c1 = s1 + bias.y, c2 = s2 + bias.z, c3 = s3 + bias.w;
        float a1 = fmaxf(c0, c1), a2 = fminf(c0, c1); { const float b1 = fmaxf(c2, c3), b2 = fminf(c2, c3); const float n1 = fmaxf(a1, b1), n2 = fmaxf(fminf(a1, b1), fmaxf(a2, b2)); a1 = n1; a2 = n2; }
#pragma unroll
        for (int off = 1; off < 8; off <<= 1) { const float b1 = __shfl_xor(a1, off), b2 = __shfl_xor(a2, off); const float n1 = fmaxf(a1, b1), n2 = fmaxf(fminf(a1, b1), fmaxf(a2, b2)); a1 = n1; a2 = n2; }
        const float gs = a1 + a2; const int g = lane >> 3;
        int rank = 0;
#pragma unroll
        for (int j = 0; j < 8; ++j) { const float sj = __shfl(gs, j * 8); rank += (sj > gs || (sj == gs && j < g)) ? 1 : 0; }
        if (rank >= 4) { c0 = -INFINITY; c1 = -INFINITY; c2 = -INFINITY; c3 = -INFINITY; }
        int ridx = 0; float rs = 0.f;
#pragma unroll
        for (int k = 0; k < 8; ++k) {
            float bv = c0; int bi = 0; if (c1 > bv) { bv = c1; bi = 1; } if (c2 > bv) { bv = c2; bi = 2; } if (c3 > bv) { bv = c3; bi = 3; }
            float v = bv; int ix = lane * 4 + bi;
#pragma unroll
            for (int off = 1; off < 64; off <<= 1) { const float ov = __shfl_xor(v, off); const int oi = __shfl_xor(ix, off); if (ov > v || (ov == v && oi < ix)) { v = ov; ix = oi; } }
            const int ol = ix >> 2, oj = ix & 3;
            const float ssel = (oj == 0) ? s0 : (oj == 1) ? s1 : (oj == 2) ? s2 : s3;
            const float sv = __shfl(ssel, ol);
            if (lane == ol) { if (oj == 0) c0 = -INFINITY; else if (oj == 1) c1 = -INFINITY; else if (oj == 2) c2 = -INFINITY; else c3 = -INFINITY; }
            if (lane == k) { ridx = ix; rs = sv; }
        }
        float sum = (lane < 8) ? rs : 0.f; sum += __shfl_xor(sum, 1); sum += __shfl_xor(sum, 2); sum += __shfl_xor(sum, 4);
        if (lane < 8) { const float w = rs / sum * ROUTED_SCALE_;
            topi[tok * 8 + lane] = ridx; topw[tok * 8 + lane] = w;
            const unsigned lr = __hip_atomic_fetch_add(&hist[ridx], 1u, __ATOMIC_RELAXED, __HIP_MEMORY_SCOPE_WORKGROUP);
            lrank[tok * 8 + lane] = (int)lr; }
    }
    __syncthreads();
    if (tid_ < 256) { const unsigned hc = hist[tid_]; const unsigned base = __hip_atomic_fetch_add(gcount + tid_, hc, RLX_AGENT); wgbase[blockIdx.x * 256 + tid_] = base; }
}
__device__ __forceinline__ void p_assign(Frame& F) {
    const int lane_ = lane_id(), tid_ = F.wave * 64 + lane_; (void)tid_;
    moe_tables(F);
    LAS unsigned* PST = (LAS unsigned*)(F.lds + LX_PST);
    const int* topi = (const int*)(F.ws + WS_TOPI); const float* topw = (const float*)(F.ws + WS_TOPW); const int* lrank = (const int*)(F.ws + WS_LRANK);
    const unsigned* wgbase = (const unsigned*)(F.ws + WS_WGBASE);
    int* row_tok = (int*)(F.ws + WS_ROWTOK); int* row_dst = (int*)(F.ws + WS_ROWDST); float* row_w = (float*)(F.ws + WS_ROWW);
    for (int tok = blockIdx.x * 8 + F.wave; tok < T_; tok += F.G * 8) {
        if (lane_ < 8) { const int e = topi[tok * 8 + lane_]; const unsigned slot = PST[e] + wgbase[blockIdx.x * 256 + e] + (unsigned)lrank[tok * 8 + lane_];
            row_tok[slot] = tok; row_dst[slot] = tok * 8 + lane_; row_w[slot] = topw[tok * 8 + lane_]; }
    }
}

__global__ void __launch_bounds__(NWAVES * 64, 2) fwd_kernel(Args args) {
    extern __shared__ __attribute__((aligned(16))) unsigned char lds[];
    Frame F;
    F.lds = (LAS unsigned char*)lds;
    F.MISC = (volatile LAS unsigned*)(F.lds + MISC_OFF);
    F.wave = __builtin_amdgcn_readfirstlane((int)threadIdx.x >> 6);
    F.G = gridDim.x; { const int bx = blockIdx.x; F.vcu = (F.G % 8 == 0) ? (bx % 8) * (F.G / 8) + bx / 8 : bx; }
    F.ws = args.ws; F.out = args.out;
    F.ctl = (gu32*)(args.ws + WS_CTL);
    unsigned char* ws = args.ws;
    { const int tid_ = F.wave * 64 + lane_id(); for (int u = tid_; u < (LDS_BYTES - LDSCTL_OFF) / 4; u += NWAVES * 64) ((LAS unsigned*)(F.lds + LDSCTL_OFF))[u] = 0u; }
    __syncthreads();
    XcdBarrier bar; bar.bar = (unsigned*)(F.ctl + CW_BAR); bar.x = 0; bar.st = nullptr;
    if (N_LAUNCHES == 1) bar = xcd_barrier_post((unsigned*)(F.ctl + CW_BAR), F.MISC + 8, F.wave);
#define GRID_BAR() do { if (N_LAUNCHES == 1) xcd_barrier(bar, F.wave); } while (0)
    const int lo = args.ph_lo, hi = args.ph_hi;
#ifndef MK_PHMASK
#define MK_PHMASK 0x7fff
#endif
#ifndef MK_DOUBLE
#define MK_DOUBLE -1
#endif
#define REP(k) _Pragma("unroll") for (int rep_ = 0; rep_ < ((MK_DOUBLE) == (k) ? 2 : 1); ++rep_)
#define IN(k) ((((MK_PHMASK) >> (k)) & 1) && lo <= (k) && (k) < hi)
#define BOTH(k) (IN(k) && IN((k) + 1))
    bf16* S6 = (bf16*)(ws + WS_S6);
    float* X1 = args.out;
    bf16* TB = (bf16*)args.out;

    REP(0) if (IN(0)) { p0_prologue(F, args); if (BOTH(0)) GRID_BAR(); }

    REP(1) if (IN(1)) {
        pg8::DenseOrder S; S.init(ws + WS_XB, ws + WS_WIN, T_, INW_, D_, F.G, (int)blockIdx.x);
        EpiZ E{S6, (bf16*)(ws + WS_G), (const float*)(ws + WS_ROPE), (float*)(ws + WS_KMEAN)};
        pg8::gemm_phase<EpiZ, pg8::DenseOrder, true>(F.lds + RING_OFF, D_, S, E, F.wave);
        if (BOTH(1)) GRID_BAR();
    }
    if (IN(2)) { p_conv(F, args.in[3]); p_select(F); if (BOTH(2)) GRID_BAR(); }

    if (IN(3)) {
        const AttnOrder S{F.vcu};
        int bh, qb;
        for (int i = 0; S.next(i, bh, qb); ++i)
            attn_body::attn_unit<8>(bh >> 3, bh & 7, qb, (const attn_body::bf16*)S6, (const attn_body::bf16*)(S6 + (size_t)T_ * 512), (const attn_body::bf16*)(S6 + (size_t)2 * T_ * 512),
                                    (attn_body::bf16*)S6, (const unsigned*)(ws + WS_SEL), (char*)lds + RING_OFF, F.wave);
        if (BOTH(3)) GRID_BAR();
    }
    REP(4) if (IN(4)) {
        { pg8::DenseOrder S; S.init(S6, ws + WS_WAO, T_, D_, AW_, F.G, (int)blockIdx.x);
#ifdef MK_P4A_PLAIN
          EpiBf16Plain E{(bf16*)(ws + WS_P1), D_};
          pg8::gemm_phase<EpiBf16Plain, pg8::DenseOrder, true>(F.lds + RING_OFF, AW_, S, E, F.wave); }
#else
          EpiGate<false> E{(bf16*)(ws + WS_P1), (const bf16*)(ws + WS_G)};
          pg8::gemm_phase<EpiGate<false>, pg8::DenseOrder, true>(F.lds + RING_OFF, AW_, S, E, F.wave); }
#endif
        VM_WAIT(); __syncthreads();
#ifndef MK_SKIP_P4B
        { pg8::DenseOrder S; S.init(S6 + (size_t)3 * T_ * 512, ws + WS_WCO, T_, D_, CW_, F.G, (int)blockIdx.x);
          EpiGate<true> E{(bf16*)(ws + WS_P1), (const bf16*)(ws + WS_G) + (size_t)T_ * 1024};
          pg8::gemm_phase<EpiGate<true>, pg8::DenseOrder, true>(F.lds + RING_OFF, CW_, S, E, F.wave); }
#endif
        if (BOTH(4)) GRID_BAR();
    }
    REP(5) if (IN(5)) {
        pg8::DenseOrder S; S.init(ws + WS_P1, ws + WS_WOUT, T_, D_, D_, F.G, (int)blockIdx.x);
        EpiRes<false> E{TB, args.in[0]};
        pg8::gemm_phase<EpiRes<false>, pg8::DenseOrder, true>(F.lds + RING_OFF, D_, S, E, F.wave);
        if (BOTH(5)) GRID_BAR();
    }
    if (IN(6)) {
        const int gw = F.vcu * NWAVES + F.wave, NGW = F.G * NWAVES;
        for (int m = gw; m < T_; m += NGW) ln_row<false, false, true>(F, TB, nullptr, (bf16*)(ws + WS_XB), args.in[7], args.in[8], nullptr, nullptr, m);
        if (BOTH(6)) GRID_BAR();
    }
    REP(7) if (IN(7)) {
        { pg8::DenseOrder S; S.init(ws + WS_XB, ws + WS_WSR, T_, 768, D_, F.G, (int)blockIdx.x);
          EpiShRouter E{(bf16*)(ws + WS_HS), (float*)(ws + WS_LOGITS)};
          pg8::gemm_phase<EpiShRouter, pg8::DenseOrder, true>(F.lds + RING_OFF, D_, S, E, F.wave); }
        { pg8::DenseOrder S; S.init(ws + WS_PB, ws + WS_WPP, T_, D_, PLE_, F.G, (int)blockIdx.x);
          EpiBf16Plain E{(bf16*)(ws + WS_PP), D_};
          pg8::gemm_phase<EpiBf16Plain, pg8::DenseOrder, true>(F.lds + RING_OFF, PLE_, S, E, F.wave); }
        if (BOTH(7)) GRID_BAR();
    }
    if (IN(8)) {
        p_route(F, args.in[10]);
        { pg8::DenseOrder S; S.init(ws + WS_HS, ws + WS_WSD, T_, D_, 256, F.G, (int)blockIdx.x);
          EpiRes<true> E{TB, (const void*)(ws + WS_XB)};
          pg8::gemm_phase<EpiRes<true>, pg8::DenseOrder, true>(F.lds + RING_OFF, 256, S, E, F.wave); }
        if (BOTH(8)) GRID_BAR();
    }
    if (IN(9)) { p_assign(F); if (BOTH(9)) GRID_BAR(); }

    REP(10) if (IN(10)) {
        moe_tables(F);
        MoeUpOrder S{(const LAS unsigned short*)(F.lds + LX_BLKE), (const LAS unsigned*)(F.lds + LX_XS), (const int*)(ws + WS_ROWTOK), (const char*)(ws + WS_XB), (const char*)(ws + WS_WGU), F.G >= 8 ? F.G / 8 : 1, F.vcu};
        EpiMoeUp E{(bf16*)(ws + WS_H)};
        pg8::gemm_phase<EpiMoeUp, MoeUpOrder, true>(F.lds + RING_OFF, D_, S, E, F.wave);
        if (BOTH(10)) GRID_BAR();
    }
    REP(11) if (IN(11)) {
        moe_tables(F);
        MoeDownOrder S{(const LAS unsigned short*)(F.lds + LX_BLKE), (const LAS unsigned*)(F.lds + LX_XS), (const char*)(ws + WS_H), (const char*)(ws + WS_WD), F.G >= 8 ? F.G / 8 : 1, F.vcu};
        EpiMoeDown E{(bf16*)(ws + WS_YLO), (bf16*)(ws + WS_YHI), (const int*)(ws + WS_ROWDST), (const float*)(ws + WS_ROWW)};
        pg8::gemm_phase<EpiMoeDown, MoeDownOrder, true>(F.lds + RING_OFF, 256, S, E, F.wave);
#ifdef MK_P11_NULL
        { EpiNull E0; pg8::gemm_phase<EpiNull, MoeDownOrder, true>(F.lds + RING_OFF, 256, S, E0, F.wave); }
#endif
        if (BOTH(11)) GRID_BAR();
    }
    if (IN(12)) {
        const int gw = F.vcu * NWAVES + F.wave, NGW = F.G * NWAVES;
        for (int m = gw; m < T_; m += NGW) ln_row<true, false, true>(F, TB, nullptr, (bf16*)(ws + WS_XB), args.in[17], args.in[18], (const bf16*)(ws + WS_YLO), (const bf16*)(ws + WS_YHI), m);
        if (BOTH(12)) GRID_BAR();
    }
    if (IN(13)) {
        pg8::DenseOrder S; S.init(ws + WS_XB, ws + WS_WPG, T_, D_, D_, F.G, (int)blockIdx.x);
        EpiPle E{(bf16*)(ws + WS_H), (const bf16*)(ws + WS_XB), (const bf16*)(ws + WS_PP)};
        pg8::gemm_phase<EpiPle, pg8::DenseOrder, true>(F.lds + RING_OFF, D_, S, E, F.wave);
        if (BOTH(13)) GRID_BAR();
    }
    if (IN(14)) {
        const int gw = F.vcu * NWAVES + F.wave, NGW = F.G * NWAVES;
        for (int m = gw; m < T_; m += NGW) ln_row<false, true, false>(F, (const bf16*)(ws + WS_H), X1, nullptr, args.in[21], args.in[22], nullptr, nullptr, m);
    }
#if defined(MK_DBG_OFF)
    if (lo <= 14 && 14 < hi) { const int lane_ = lane_id(), tid_ = F.wave * 64 + lane_; const bf16* src = (const bf16*)(ws + (size_t)(MK_DBG_OFF));
        for (size_t i = (size_t)F.vcu * 512 + tid_; i < (size_t)T_ * D_ / 8; i += (size_t)F.G * 512) { const v4u w = *(const v4u*)(src + (i % (size_t)(MK_DBG_WRAP)) * 8);
            f32x4 a, b; a.x = bf_lo(w.x); a.y = bf_hi(w.x); a.z = bf_lo(w.y); a.w = bf_hi(w.y); b.x = bf_lo(w.z); b.y = bf_hi(w.z); b.z = bf_lo(w.w); b.w = bf_hi(w.w);
            *(f32x4*)(args.out + i * 8) = a; *(f32x4*)(args.out + i * 8 + 4) = b; } }
#endif
#undef IN
#undef BOTH
#undef GRID_BAR
}

extern "C" void kernel_launch(void* const* d_in, const int* in_sizes, int n_in, void* d_out, int out_size, void* d_ws, size_t ws_size, hipStream_t stream) {
    static int grid = 0;
    if (grid == 0) {
        if (n_in != 23 || in_sizes[0] != T_ * D_ || out_size != T_ * D_ || ws_size < WS_END) { fprintf(stderr, "kernel_launch: unexpected shapes (n_in %d, in0 %d, out %d, ws %zu); nothing launched\n", n_in, n_in > 0 ? in_sizes[0] : -1, out_size, ws_size); grid = -1; return; }
        int dev = 0, cus = 0, per_cu = 0;
        if (hipGetDevice(&dev) != hipSuccess || hipDeviceGetAttribute(&cus, hipDeviceAttributeMultiprocessorCount, dev) != hipSuccess) { fprintf(stderr, "kernel_launch: device query failed\n"); grid = -1; return; }
        if (hipFuncSetAttribute((const void*)fwd_kernel, hipFuncAttributeMaxDynamicSharedMemorySize, LDS_BYTES) != hipSuccess) { fprintf(stderr, "kernel_launch: hipFuncSetAttribute failed\n"); grid = -1; return; }
        if (hipOccupancyMaxActiveBlocksPerMultiprocessor(&per_cu, (const void*)fwd_kernel, NWAVES * 64, LDS_BYTES) != hipSuccess || per_cu < 1)
            fprintf(stderr, "kernel_launch: note: occupancy query reports %d workgroups per CU\n", per_cu);
        (void)hipGetLastError();
        grid = cus;
    }
    if (grid < 0) return;
    if (hipMemsetAsync((char*)d_ws + WS_CTL, 0, CTL_ZERO_BYTES, stream) != hipSuccess) { fprintf(stderr, "kernel_launch: memset failed\n"); return; }
    Args a{};
    for (int i = 0; i < 23; ++i) a.in[i] = (const float*)d_in[i];
    a.out = (float*)d_out; a.ws = (unsigned char*)d_ws; a.pad = 0;
    for (int li = 0; li < N_LAUNCHES; ++li) {
        a.ph_lo = (N_LAUNCHES == 1) ? 0 : li; a.ph_hi = (N_LAUNCHES == 1) ? NPH : li + 1; a.li = li;
        hipLaunchKernelGGL(fwd_kernel, dim3(grid), dim3(NWAVES * 64), LDS_BYTES, stream, a);
        const hipError_t le = hipPeekAtLastError();
        if (le != hipSuccess) { fprintf(stderr, "kernel_launch: launch %d failed: %s\n", li, hipGetErrorName(le)); break; }
    }
}
```

```cpp
#include <hip/hip_runtime.h>
#include <hip/hip_bf16.h>
#include <cstdio>
#include <cstdint>
#include <cmath>

#ifndef MK_N_LAUNCHES
#define MK_N_LAUNCHES 1
#endif

constexpr int NB_ = 8, SEQ_ = 4096, T_ = NB_ * SEQ_, D_ = 1024;
constexpr int NH_ = 8, HD_ = 64, AW_ = 512, CW_ = 512, INW_ = 5120;
constexpr int NE_ = 256, ED_ = 256, TOPK_ = 8, PLE_ = 256;
constexpr int NBLK_ = 16;
constexpr float LN_EPS_ = 1e-5f;
constexpr float DN_ALPHA_ = 1.189207115002721f;
constexpr float ROUTED_SCALE_ = 2.5f;
constexpr int RMAX_ = T_ * TOPK_ + NE_ * 256;

#define GAS __attribute__((address_space(1)))
#define LAS __attribute__((address_space(3)))
typedef unsigned short bf16;
typedef unsigned v4u __attribute__((ext_vector_type(4)));
typedef float f32x4 __attribute__((ext_vector_type(4)));
typedef float f32x2 __attribute__((ext_vector_type(2)));
typedef unsigned u32x2 __attribute__((ext_vector_type(2)));
typedef short bf16x8 __attribute__((ext_vector_type(8)));
typedef GAS unsigned gu32;
#define RLX_AGENT __ATOMIC_RELAXED, __HIP_MEMORY_SCOPE_AGENT
#define LDS_WAIT() asm volatile("s_waitcnt lgkmcnt(0)" ::: "memory")
#define VM_WAIT() asm volatile("s_waitcnt vmcnt(0)" ::: "memory")

typedef float cvt_f32x2_t __attribute__((ext_vector_type(2))); typedef __bf16 cvt_bf16x2_t __attribute__((ext_vector_type(2)));
__device__ __forceinline__ unsigned cvt_pk_bf16(float lo, float hi) { cvt_f32x2_t v = {lo, hi}; cvt_bf16x2_t b = __builtin_convertvector(v, cvt_bf16x2_t); return __builtin_bit_cast(unsigned, b); }
__device__ __forceinline__ float bf_lo(unsigned w) { return __builtin_bit_cast(float, w << 16); }
__device__ __forceinline__ float bf_hi(unsigned w) { return __builtin_bit_cast(float, w & 0xffff0000u); }
__device__ __forceinline__ int lane_id() { unsigned ones = ~0u; asm volatile("" : "+s"(ones)); return (int)__builtin_amdgcn_mbcnt_hi(ones, __builtin_amdgcn_mbcnt_lo(ones, 0u)); }
__device__ __forceinline__ float sigmoidf_(float x) { return __builtin_amdgcn_rcpf(1.0f + __builtin_amdgcn_exp2f(-1.4426950408889634f * x)); }

namespace pg8 {
#define PG8_LAS __attribute__((address_space(3)))
constexpr int BM = 256, BK = 64, HALF = 128, HTB = HALF * BK * 2  , STAGE_BYTES = 8 * HTB, NXCD = 8, WGM = 8;

__host__ __device__ __forceinline__ int lds_byte(int r, int c) { const int st = (r >> 4) * 2 + (c >> 5), rr = r & 15, cc = c & 31, ob = rr * 64 + cc * 2; return st * 1024 + (ob ^ (((ob >> 9) & 1) << 5)); }
__host__ __device__ __forceinline__ void stage_rc(int b, int& R, int& C) { const int st = b / 1024, sb = b % 1024, swz = sb ^ (((sb >> 9) & 1) << 5); R = (st >> 1) * 16 + swz / 64; C = (st & 1) * 32 + (swz % 64) / 2; }
__host__ __device__ __forceinline__ int perm32(int rho) { const int n = rho >> 4, i = rho & 15; return 8 * (i >> 2) + 4 * n + (i & 3); }

struct Unit { const char* a; const char* b; int row0, pn, e; };

struct DenseOrder {
    const char* A; const char* Bt; int K, nM, nN, nwg, G, c;
    static constexpr bool GATHER = false;
    __device__ __forceinline__ void init(const void* A_, const void* Bt_, int M, int N, int K_, int G_, int c_) { A = (const char*)A_; Bt = (const char*)Bt_; K = K_; nM = M / BM; nN = N / BM; nwg = nM * nN; G = G_; c = c_; }
    __device__ __forceinline__ bool next(int i, Unit& u) const {
        const long L = (long)i * G + c; if (L >= nwg) return false;
        int wgid = (int)L; { const int q = nwg / NXCD, r = nwg % NXCD, xcd = wgid % NXCD, off = wgid / NXCD; wgid = (xcd < r ? xcd * (q + 1) : r * (q + 1) + (xcd - r) * q) + off; }
        const int nig = WGM * nN, gid = wgid / nig, fm = gid * WGM, gsz = (nM - fm) < WGM ? (nM - fm) : WGM;
        const int pm = fm + ((wgid % nig) % gsz); int pn = (wgid % nig) / gsz;
#ifdef MK_REV_PN
        if (nN == 20) pn = 19 - pn;
#endif
        u.a = A + (size_t)pm * BM * K * 2; u.b = Bt + (size_t)pn * BM * K * 2; u.row0 = pm * BM; u.pn = pn; u.e = 0; return true;
    }
};

template <class Epi, class Sched, bool ALIGN_EPI>
__device__ __forceinline__ void gemm_phase(PG8_LAS unsigned char* lds, const int K, const Sched& S, const Epi& E, const int wid) {
    const int lane = lane_id(), tid = wid * 64 + lane, wr = wid >> 2, wc = wid & 3, fr = lane & 15, fq = lane >> 4;
    const int nt = K / BK;
    constexpr int NVA = Sched::GATHER ? 2 : 1;
    unsigned voffA[NVA][2], voffB[2];
#pragma unroll
    for (int i = 0; i < 2; ++i) { int R, C; stage_rc(tid * 16 + i * 8192, R, C); static_assert(Epi::PERM, "all epilogues use the permuted layout");
        voffB[i] = (unsigned)((64 * (R >> 5) + perm32(R & 31)) * K + C) * 2u;
        if constexpr (!Sched::GATHER) voffA[0][i] = (unsigned)(R * K + C) * 2u; }
    const size_t kstep = (size_t)(BK * 2);
    const size_t hstep = (size_t)32 * K * 2;
    const size_t hstepA = Sched::GATHER ? 0 : (size_t)HALF * K * 2;
    const unsigned ldsw = (unsigned)wid * 1024u;
    const int aoff = lds_byte(wr * 64 + fr, fq * 8), boff = lds_byte(wc * 32 + fr, fq * 8);
#define PG8_SA(b, h) (((b) * 2 + (h)) * HTB)
#define PG8_SB(b, h) ((4 + (b) * 2 + (h)) * HTB)
#define PG8_STAGE(bufoff, gbase, voff) do { _Pragma("unroll") for (int _i = 0; _i < 2; ++_i) \
        __builtin_amdgcn_global_load_lds((const unsigned*)((const char*)(gbase) + (voff)[_i]), (PG8_LAS unsigned*)(lds + (bufoff) + ldsw + _i * 8192), 16, 0, 0); } while (0)
#define PG8_LDA(dst, b, h) do { _Pragma("unroll") for (int m = 0; m < 4; ++m) _Pragma("unroll") for (int k = 0; k < 2; ++k) dst[m][k] = *(const PG8_LAS bf16x8*)(lds + PG8_SA(b, h) + aoff + m * 2048 + k * 1024); } while (0)
#define PG8_LDB(dst, b, h) do { _Pragma("unroll") for (int n = 0; n < 2; ++n) _Pragma("unroll") for (int k = 0; k < 2; ++k) dst[n][k] = *(const PG8_LAS bf16x8*)(lds + PG8_SB(b, h) + boff + n * 2048 + k * 1024); } while (0)
#define PG8_MMA(ai, bj, At, Bt) do { __builtin_amdgcn_s_setprio(1); _Pragma("unroll") for (int m = 0; m < 4; ++m) _Pragma("unroll") for (int n = 0; n < 2; ++n) _Pragma("unroll") for (int k = 0; k < 2; ++k) \
        acc[ai][bj][m][n] = __builtin_amdgcn_mfma_f32_16x16x32_bf16(Bt[n][k], At[m][k], acc[ai][bj][m][n], 0, 0, 0); __builtin_amdgcn_s_setprio(0); } while (0)
#ifdef MK_DRAIN
#define PG8_WAIT_V(n) asm volatile("s_waitcnt vmcnt(0)" ::: "memory")
#else
#define PG8_WAIT_V(n) asm volatile("s_waitcnt vmcnt(" #n ")" ::: "memory")
#endif
#define PG8_WAIT_L(n) asm volatile("s_waitcnt lgkmcnt(" #n ")" ::: "memory")
#define PG8_BAR __builtin_amdgcn_s_barrier()
#define PG8_SCHED __builtin_amdgcn_sched_barrier(0)
    Unit cur, nxt; int ui = 0;
    if (!S.next(0, cur)) return;
    if constexpr (Sched::GATHER) S.aoff(cur, tid, voffA);
    f32x4 acc[2][2][4][2];
#pragma unroll
    for (int a = 0; a < 2; ++a)
#pragma unroll
        for (int b = 0; b < 2; ++b)
#pragma unroll
            for (int m = 0; m < 4; ++m)
#pragma unroll
                for (int n = 0; n < 2; ++n) acc[a][b][m][n] = (f32x4){0.f, 0.f, 0.f, 0.f};
    bf16x8 At[4][2], B0[2][2], B1[2][2];
    PG8_STAGE(PG8_SB(0, 0), cur.b, voffB); PG8_STAGE(PG8_SB(0, 1), cur.b + hstep, voffB); PG8_STAGE(PG8_SA(0, 0), cur.a, voffA[0]); PG8_STAGE(PG8_SA(0, 1), cur.a + hstepA, voffA[NVA - 1]);
    if (wr == 1) PG8_BAR;
    PG8_WAIT_V(2); PG8_BAR;
    PG8_STAGE(PG8_SB(1, 0), cur.b + kstep, voffB); PG8_STAGE(PG8_SA(1, 0), cur.a + kstep, voffA[0]); PG8_STAGE(PG8_SB(1, 1), cur.b + hstep + kstep, voffB);
    PG8_WAIT_V(6); PG8_BAR;
    for (;;) {
        const bool has_next = S.next(ui + 1, nxt);
        const char* nA = has_next ? nxt.a : cur.a; const char* nB = has_next ? nxt.b : cur.b;
#pragma nounroll
        for (int t = 0; t < nt; t += 2) {
            const bool last = (t == nt - 2);
            const char* a1 = cur.a + (size_t)(t + 1) * kstep;
            const char* a2 = last ? nA : cur.a + (size_t)(t + 2) * kstep; const char* b2 = last ? nB : cur.b + (size_t)(t + 2) * kstep;
            const char* a3 = a2 + kstep; const char* b3 = b2 + kstep;
            PG8_LDB(B0, 0, 0); PG8_LDB(B1, 0, 1); PG8_SCHED; PG8_LDA(At, 0, 0); PG8_STAGE(PG8_SA(1, 1), a1 + hstepA, voffA[NVA - 1]);
            if constexpr (Sched::GATHER) { if (last && has_next) S.aoff(nxt, tid, voffA); }
            PG8_WAIT_V(8); PG8_WAIT_L(0); PG8_BAR; PG8_MMA(0, 0, At, B0); PG8_MMA(0, 1, At, B1); PG8_BAR; PG8_SCHED;
            PG8_LDA(At, 0, 1); PG8_STAGE(PG8_SB(0, 0), b2, voffB); PG8_STAGE(PG8_SB(0, 1), b2 + hstep, voffB); PG8_STAGE(PG8_SA(0, 0), a2, voffA[0]);
            PG8_WAIT_V(8); PG8_WAIT_L(0); PG8_BAR; PG8_MMA(1, 0, At, B0); PG8_MMA(1, 1, At, B1); PG8_BAR; PG8_SCHED;
            PG8_LDB(B0, 1, 0); PG8_LDB(B1, 1, 1); PG8_SCHED; PG8_LDA(At, 1, 0); PG8_STAGE(PG8_SA(0, 1), a2 + hstepA, voffA[NVA - 1]);
            PG8_WAIT_V(8); PG8_WAIT_L(0); PG8_BAR; PG8_MMA(0, 0, At, B0); PG8_MMA(0, 1, At, B1); PG8_BAR; PG8_SCHED;
            PG8_LDA(At, 1, 1); PG8_STAGE(PG8_SB(1, 0), b3, voffB); PG8_STAGE(PG8_SB(1, 1), b3 + hstep, voffB); PG8_STAGE(PG8_SA(1, 0), a3, voffA[0]);
            PG8_WAIT_V(8); PG8_WAIT_L(0); PG8_BAR; PG8_MMA(1, 0, At, B0); PG8_MMA(1, 1, At, B1); PG8_BAR; PG8_SCHED;
        }
        if constexpr (ALIGN_EPI) { if (wr == 0) PG8_BAR; }
        E(acc, cur, wr, wc, fr, fq);
        if (!has_next) break;
#pragma unroll
        for (int a = 0; a < 2; ++a)
#pragma unroll
            for (int b = 0; b < 2; ++b)
#pragma unroll
                for (int m = 0; m < 4; ++m)
#pragma unroll
                    for (int n = 0; n < 2; ++n) acc[a][b][m][n] = (f32x4){0.f, 0.f, 0.f, 0.f};
        cur = nxt; ++ui;
        if constexpr (ALIGN_EPI) { if (wr == 1) PG8_BAR; }
    }
    PG8_WAIT_V(0);
    if constexpr (!ALIGN_EPI) { if (wr == 0) PG8_BAR; }
    PG8_BAR;
#undef PG8_SA
#undef PG8_SB
#undef PG8_STAGE
#undef PG8_LDA
#undef PG8_LDB
#undef PG8_MMA
#undef PG8_WAIT_V
#undef PG8_WAIT_L
#undef PG8_BAR
#undef PG8_SCHED
}
}

namespace attn_body {
using bf16=__hip_bfloat16;
using bf16x8=__attribute__((ext_vector_type(8)))short;
using s16x4=__attribute__((ext_vector_type(4)))short;
using f32x16=__attribute__((ext_vector_type(16)))float;
using u32x4=__attribute__((ext_vector_type(4)))unsigned;
constexpr int BATCH=8,NHEAD=8,SEQ=4096,D=64,DM=NHEAD*D;
constexpr int NW=8,QBLK=32,QB=QBLK*NW,KVBLK=64,NQB=SEQ/QB;
__device__ __forceinline__ int crow(int r,int hi){return (r&3)+8*(r>>2)+4*hi;}
#define SBAR() __builtin_amdgcn_sched_barrier(0)
__device__ __forceinline__ void cmask(f32x16&p0,f32x16&p1,int qe,int hi){
  const float NEG=-INFINITY; int kb=4*hi;
  #pragma unroll
  for(int r=0;r<16;++r){int kv=kb+(r&3)+8*(r>>2); if(kv>qe)p0[r]=NEG; if(kv+32>qe)p1[r]=NEG;}
}
__device__ __forceinline__ void bmask(f32x16&p0,f32x16&p1,bool keep,float mhat){
  float pen=keep?-mhat:-INFINITY; asm volatile("":"+v"(pen));
  #pragma unroll
  for(int r=0;r<16;++r){p0[r]+=pen; p1[r]+=pen;}
}

constexpr int NSLOT=3, SLOTB=8192;
constexpr int LDS_K=0, LDS_V=NSLOT*SLOTB, LDS_WS=2*NSLOT*SLOTB, LDS_OST=LDS_WS+NW*64*4, LDS_BYTES=LDS_OST+NW*4096;
constexpr float C2=0.125f*1.4426950408889634f;
__device__ __forceinline__ void glds16(const void*gsrc,unsigned lds_dst){unsigned keep;
  asm volatile("s_mov_b32 %0, m0\n\ts_mov_b32 m0, %2\n\ts_nop 0\n\tglobal_load_lds_dwordx4 %1, off\n\ts_mov_b32 m0, %0":"=&s"(keep):"v"(gsrc),"s"(lds_dst):"memory");}
__device__ __forceinline__ float max3f(float a,float b,float c){float r;asm("v_max3_f32 %0, %1, %2, %3":"=v"(r):"v"(a),"v"(b),"v"(c));return r;}
__device__ __forceinline__ float max2f(float a,float b){float r;asm("v_max_f32_e32 %0, %1, %2":"=v"(r):"v"(a),"v"(b));return r;}
__device__ __forceinline__ float fadd_s(float a,float b){float r;asm("v_add_f32_e32 %0, %1, %2":"=v"(r):"v"(a),"v"(b));return r;}
__device__ __forceinline__ float fsub_s(float a,float b){float r;asm("v_sub_f32_e32 %0, %1, %2":"=v"(r):"v"(a),"v"(b));return r;}
typedef float f32x2_t __attribute__((ext_vector_type(2))); typedef __bf16 bf16x2_t __attribute__((ext_vector_type(2)));
__device__ __forceinline__ unsigned cvtpk_s(float lo,float hi){f32x2_t v={lo,hi};bf16x2_t b=__builtin_convertvector(v,bf16x2_t);return __builtin_bit_cast(unsigned,b);}
#define WAIT_BAR(N) asm volatile("s_waitcnt vmcnt(" #N ") lgkmcnt(0)\n\ts_barrier":::"memory")

__device__ __forceinline__ void qkt(f32x16&p0,f32x16&p1,const char*Kslot,const bf16x8*qr,int r32,int hi){
  const char*kb=Kslot+hi*1024+r32*16;
  #pragma unroll
  for(int d0=0;d0<4;++d0){
    const bf16x8 b0=*reinterpret_cast<const bf16x8*>(kb+d0*2048);
    const bf16x8 b1=*reinterpret_cast<const bf16x8*>(kb+d0*2048+512);
    if(d0==0){p0=__builtin_amdgcn_mfma_f32_32x32x16_bf16(b0,qr[0],f32x16{},0,0,0);p1=__builtin_amdgcn_mfma_f32_32x32x16_bf16(b1,qr[0],f32x16{},0,0,0);}
    else{p0=__builtin_amdgcn_mfma_f32_32x32x16_bf16(b0,qr[d0],p0,0,0,0);p1=__builtin_amdgcn_mfma_f32_32x32x16_bf16(b1,qr[d0],p1,0,0,0);}}
}
typedef __attribute__((address_space(3))) const char* lds_cptr;
typedef short v4i16_t __attribute__((ext_vector_type(4)));
__device__ __forceinline__ void kload8(bf16x8*kf,lds_cptr kp){
  kf[0]=*(const __attribute__((address_space(3))) bf16x8*)(kp);      kf[1]=*(const __attribute__((address_space(3))) bf16x8*)(kp+512);
  kf[2]=*(const __attribute__((address_space(3))) bf16x8*)(kp+2048); kf[3]=*(const __attribute__((address_space(3))) bf16x8*)(kp+2560);
  kf[4]=*(const __attribute__((address_space(3))) bf16x8*)(kp+4096); kf[5]=*(const __attribute__((address_space(3))) bf16x8*)(kp+4608);
  kf[6]=*(const __attribute__((address_space(3))) bf16x8*)(kp+6144); kf[7]=*(const __attribute__((address_space(3))) bf16x8*)(kp+6656);
}
__device__ __forceinline__ void kload2(bf16x8*kf,lds_cptr kp,int j){ kf[2*j]=*(const __attribute__((address_space(3))) bf16x8*)(kp+j*2048); kf[2*j+1]=*(const __attribute__((address_space(3))) bf16x8*)(kp+j*2048+512); }
__device__ __forceinline__ s16x4 vtr(lds_cptr p){ return __builtin_bit_cast(s16x4,__builtin_amdgcn_ds_read_tr16_b64_v4i16((__attribute__((address_space(3))) v4i16_t*)p)); }
__device__ __forceinline__ float rowmax(const f32x16&p0,const f32x16&p1){
  float a=max3f(p0[0],p0[1],p1[0]),b=max3f(p0[2],p0[3],p1[1]);a=max3f(a,p1[2],p1[3]);
  #pragma unroll
  for(int r=4;r<16;r+=4){a=max3f(a,p0[r],p0[r+1]);b=max3f(b,p0[r+2],p0[r+3]);a=max3f(a,p1[r],p1[r+1]);b=max3f(b,p1[r+2],p1[r+3]);}
  const float m=max2f(a,b);
  auto rr=__builtin_amdgcn_permlane32_swap(__float_as_uint(m),__float_as_uint(m),false,false);
  return max2f(__uint_as_float(rr[0]),__uint_as_float(rr[1]));
}
__device__ __forceinline__ void pv(f32x16*o,int vb,bf16x8 pa0,bf16x8 pa1,bf16x8 pa2,bf16x8 pa3){
  #pragma unroll
  for(int d0=0;d0<2;++d0){s16x4 lo[4],hi[4];
    #pragma unroll
    for(int ks=0;ks<4;++ks){
      asm volatile("ds_read_b64_tr_b16 %0,%1 offset:%c2":"=&v"(lo[ks]):"v"(vb),"i"(d0*4096+ks*1024):"memory");
      asm volatile("ds_read_b64_tr_b16 %0,%1 offset:%c2":"=&v"(hi[ks]):"v"(vb),"i"(d0*4096+ks*1024+512):"memory");}
    asm volatile("s_waitcnt lgkmcnt(0)":::"memory");SBAR();
    #define PK(k) (bf16x8){lo[k][0],lo[k][1],lo[k][2],lo[k][3],hi[k][0],hi[k][1],hi[k][2],hi[k][3]}
    o[d0]=__builtin_amdgcn_mfma_f32_32x32x16_bf16(pa0,PK(0),o[d0],0,0,0);
    o[d0]=__builtin_amdgcn_mfma_f32_32x32x16_bf16(pa1,PK(1),o[d0],0,0,0);
    o[d0]=__builtin_amdgcn_mfma_f32_32x32x16_bf16(pa2,PK(2),o[d0],0,0,0);
    o[d0]=__builtin_amdgcn_mfma_f32_32x32x16_bf16(pa3,PK(3),o[d0],0,0,0);
    #undef PK
  }
}

#define ATTN_STORE16(p,v) (*(u32x4*)(p)=(v))
template<int THRL> __device__ __forceinline__ void attn_unit(int b,int h,int qb,const bf16*Q,const bf16*__restrict__ K,const bf16*__restrict__ V,bf16*O,const unsigned*SEL,char*shm,const int wid_){
  const int lane=lane_id(),r32=lane&31,hi=lane>>5; const int wid=wid_;
  const long rowbase=(long)b*SEQ; const int q0=qb*QB;
  const bf16*Qw=Q+(rowbase+q0+wid*QBLK)*DM+h*D;
  const bf16*Kh=K+rowbase*DM+h*D,*Vh=V+rowbase*DM+h*D;
  const unsigned lds0=(unsigned)(uintptr_t)shm;
  float*wsf=(float*)(shm+LDS_WS)+wid*64;
  const unsigned selm=SEL[((long)(b*NHEAD+h))*SEQ+q0+wid*QBLK+r32];
  const bf16*ksrc=Kh+(long)lane*DM+wid*8;
  const bf16*vsrc=Vh+(long)(16*(wid&3)+(lane>>2))*DM+(wid>>2)*32+(lane&3)*8;
  const unsigned kdst=lds0+LDS_K+wid*1024, vdst=lds0+LDS_V+wid*1024;
  #define DMA_K(t,slot) glds16(ksrc+(long)(t)*KVBLK*DM,(unsigned)__builtin_amdgcn_readfirstlane(kdst+(slot)))
  #define DMA_V(t,slot) glds16(vsrc+(long)(t)*KVBLK*DM,(unsigned)__builtin_amdgcn_readfirstlane(vdst+(slot)))
  const int vb0=(int)(lds0+LDS_V)+((lane>>4)&1)*32+(lane&3)*8+(4*hi+((lane&15)>>2))*64;
  const char*Kbase=shm+LDS_K; bf16x8 kf[8];
  const lds_cptr shm3=(lds_cptr)shm; const lds_cptr kp0=shm3+LDS_K+hi*1024+r32*16; const lds_cptr vp0=shm3+LDS_V+((lane>>4)&1)*32+(lane&3)*8+(4*hi+((lane&15)>>2))*64;
  const int NT=(q0+QB)/KVBLK;
  DMA_K(0,0);DMA_V(0,0);DMA_K(1,SLOTB);
  bf16x8 qr[4];
  #pragma unroll
  for(int d0=0;d0<4;++d0)qr[d0]=*reinterpret_cast<const bf16x8*>(&Qw[(long)r32*DM+d0*16+hi*8]);
  float mhat=0.f,l_reg=0.f;f32x16 o[2];o[0]=f32x16{};o[1]=f32x16{};
  const int qrel=wid*QBLK+r32;
  #define CMASK(P0,P1,t) do{const int jb_=(t)-(NT-4); if(jb_>=0){cmask(P0,P1,qrel-64*jb_,hi); bmask(P0,P1,true,mhat);} else bmask(P0,P1,((selm>>((t)>>2))&1u)!=0u,mhat);}while(0)
  bool resc=false;
  #define START(P0,P1) do{ const float rm=rowmax(P0,P1); resc=false; \
    { const float dl=__builtin_fmaxf(rm,-60.f); mhat=fadd_s(mhat,dl); \
      _Pragma("unroll") for(int r=0;r<16;++r){P0[r]=fsub_s(P0[r],dl);P1[r]=fsub_s(P1[r],dl);} } \
    _Pragma("unroll") for(int r=0;r<16;++r)P0[r]=__builtin_amdgcn_exp2f(P0[r]); }while(0)
  #define RESC() do{ if(resc){ asm volatile("s_waitcnt lgkmcnt(0)":::"memory"); \
      _Pragma("unroll") for(int d_=0;d_<2;++d_) _Pragma("unroll") for(int r=0;r<16;++r)o[d_][r]*=wsf[crow(r,hi)]; } }while(0)
  f32x16 pA0,pA1,pB0,pB1;
  int sl_prev=0,sl_cur=0,sl_next=SLOTB;
  #define ROT() do{sl_prev=sl_cur;sl_cur=sl_next;sl_next=(sl_next==(NSLOT-1)*SLOTB)?0:sl_next+SLOTB;}while(0)
  DMA_K(2,2*SLOTB);
  WAIT_BAR(3);
  qkt(pA0,pA1,Kbase,qr,r32,hi);asm volatile("s_nop 15\n\ts_nop 7":"+v"(pA0),"+v"(pA1));CMASK(pA0,pA1,0);
  START(pA0,pA1);
  _Pragma("unroll") for(int r=0;r<16;++r)pA1[r]=__builtin_amdgcn_exp2f(pA1[r]);
  WAIT_BAR(0);
  DMA_K(3,0);DMA_V(1,SLOTB);
  ROT();
  kload8(kf,kp0+sl_cur);
  WAIT_BAR(2);
  s16x4 vlo[8],vhi[8]; u32x4 pw0,pw1,pw2,pw3;
  #define PKW(P,B) cvtpk_s(P[B],P[B+1])
  #define PAF(k) __builtin_bit_cast(bf16x8,pw##k)
  #define VFR(i) (bf16x8){vlo[i][0],vlo[i][1],vlo[i][2],vlo[i][3],vhi[i][0],vhi[i][1],vhi[i][2],vhi[i][3]}
  #define PIN(x) asm volatile("":"+v"(x))
  #define MX3(a,b,c) __builtin_fmaxf(__builtin_fmaxf((a),(b)),(c))
  #define GAPA(MF,A0,A1,A2,A3,W0,W1,PW) do{ MF; sacc+=A0; sacc+=A1; sacc+=A2; sacc+=A3; PIN(sacc); W0; W1; PIN(PW); SBAR(); }while(0)
  #define EX(v) __builtin_amdgcn_exp2f(v)
  #define GAPB(MF,X,B) do{ MF; X[B]=EX(X[B]); X[B+1]=EX(X[B+1]); X[B+2]=EX(X[B+2]); X[B+3]=EX(X[B+3]); PIN(X); SBAR(); }while(0)
  #define VRD(i) do{ vlo[i]=vtr(vp_+(((i)>>2)*4096+((i)&3)*1024)); vhi[i]=vtr(vp_+(((i)>>2)*4096+((i)&3)*1024+512)); }while(0)
  #define KRD(G,j) do{ if(G){ kload2(kf,kp0+sl_next,j); SBAR(); } }while(0)
  #define STEP(C0,C1,P0,P1,t,GK,GV,GL) do{ SBAR(); \
    const lds_cptr vp_=vp0+sl_prev; \
    VRD(0); SBAR(); float sacc=(P0[0]+P0[1]); \
    GAPA(C0=__builtin_amdgcn_mfma_f32_32x32x16_bf16(kf[0],qr[0],f32x16{},0,0,0), P0[2],P0[3],P0[4],P0[5],     pw0[0]=PKW(P0,0), pw0[1]=PKW(P0,2), pw0); \
    VRD(4); SBAR(); GAPA(C1=__builtin_amdgcn_mfma_f32_32x32x16_bf16(kf[1],qr[0],f32x16{},0,0,0), P0[6],P0[7],P0[8],P0[9],     pw0[2]=PKW(P0,4), pw0[3]=PKW(P0,6), pw0); \
    VRD(1); SBAR(); GAPA(C0=__builtin_amdgcn_mfma_f32_32x32x16_bf16(kf[2],qr[1],C0,0,0,0),   P0[10],P0[11],P0[12],P0[13], pw1[0]=PKW(P0,8), pw1[1]=PKW(P0,10), pw1); \
    VRD(5); SBAR(); GAPA(C1=__builtin_amdgcn_mfma_f32_32x32x16_bf16(kf[3],qr[1],C1,0,0,0),   P0[14],P0[15],P1[0],P1[1],   pw1[2]=PKW(P0,12),pw1[3]=PKW(P0,14), pw1); \
    VRD(2); SBAR(); GAPA(C0=__builtin_amdgcn_mfma_f32_32x32x16_bf16(kf[4],qr[2],C0,0,0,0),   P1[2],P1[3],P1[4],P1[5],     pw2[0]=PKW(P1,0), pw2[1]=PKW(P1,2), pw2); \
    VRD(6); SBAR(); GAPA(C1=__builtin_amdgcn_mfma_f32_32x32x16_bf16(kf[5],qr[2],C1,0,0,0),   P1[6],P1[7],P1[8],P1[9],     pw2[2]=PKW(P1,4), pw2[3]=PKW(P1,6), pw2); \
    VRD(3); SBAR(); GAPA(C0=__builtin_amdgcn_mfma_f32_32x32x16_bf16(kf[6],qr[3],C0,0,0,0),   P1[10],P1[11],P1[12],P1[13], pw3[0]=PKW(P1,8), pw3[1]=PKW(P1,10), pw3); \
    VRD(7); SBAR(); GAPA(C1=__builtin_amdgcn_mfma_f32_32x32x16_bf16(kf[7],qr[3],C1,0,0,0),   P1[14],P1[15],0.f,0.f,       pw3[2]=PKW(P1,12),pw3[3]=PKW(P1,14), pw3); \
    l_reg+=sacc; \
    if(GK){DMA_K((t)+3,sl_cur);} if(GV){DMA_V((t)+1,sl_next);} \
    CMASK(C0,C1,t); \
    { float a=MX3(C0[0],C0[1],C1[0]),b=MX3(C0[2],C0[3],C1[1]); a=MX3(a,C1[2],C1[3]); \
      _Pragma("unroll") for(int r=4;r<16;r+=4){a=MX3(a,C0[r],C0[r+1]);b=MX3(b,C0[r+2],C0[r+3]);a=MX3(a,C1[r],C1[r+1]);b=MX3(b,C1[r+2],C1[r+3]);} \
      float rm=__builtin_fmaxf(a,b); { auto rr=__builtin_amdgcn_permlane32_swap(__float_as_uint(rm),__float_as_uint(rm),false,false); rm=__builtin_fmaxf(__uint_as_float(rr[0]),__uint_as_float(rr[1])); } \
      resc=false; \
      if(__builtin_expect(__any(rm>(float)THRL),0)){ const float dl=__builtin_fmaxf(rm,0.f); mhat+=dl; \
        _Pragma("unroll") for(int r=0;r<16;++r){C0[r]-=dl;C1[r]-=dl;} \
        const float f=__builtin_amdgcn_exp2f(-dl); l_reg*=f; if(hi==0)wsf[r32]=f; resc=true; } } \
    SBAR(); \
    GAPB(o[0]=__builtin_amdgcn_mfma_f32_32x32x16_bf16(PAF(0),VFR(0),o[0],0,0,0), C0,0); \
    GAPB(o[1]=__builtin_amdgcn_mfma_f32_32x32x16_bf16(PAF(0),VFR(4),o[1],0,0,0), C0,4); \
    KRD(GL,0); GAPB(o[0]=__builtin_amdgcn_mfma_f32_32x32x16_bf16(PAF(1),VFR(1),o[0],0,0,0), C0,8); \
    KRD(GL,1); GAPB(o[1]=__builtin_amdgcn_mfma_f32_32x32x16_bf16(PAF(1),VFR(5),o[1],0,0,0), C0,12); \
    KRD(GL,2); GAPB(o[0]=__builtin_amdgcn_mfma_f32_32x32x16_bf16(PAF(2),VFR(2),o[0],0,0,0), C1,0); \
    KRD(GL,3); GAPB(o[1]=__builtin_amdgcn_mfma_f32_32x32x16_bf16(PAF(2),VFR(6),o[1],0,0,0), C1,4); \
    GAPB(o[0]=__builtin_amdgcn_mfma_f32_32x32x16_bf16(PAF(3),VFR(3),o[0],0,0,0), C1,8); \
    GAPB(o[1]=__builtin_amdgcn_mfma_f32_32x32x16_bf16(PAF(3),VFR(7),o[1],0,0,0), C1,12); \
    }while(0)
  int t=1;
  #undef CMASK
  #define CMASK(P0,P1,t) bmask(P0,P1,((selm>>((t)>>2))&1u)!=0u,mhat)
  for(;t+5<NT;t+=2){
    STEP(pB0,pB1,pA0,pA1,t,true,true,true);     WAIT_BAR(2); RESC(); ROT();
    STEP(pA0,pA1,pB0,pB1,t+1,true,true,true);   WAIT_BAR(2); RESC(); ROT();
  }
  #undef CMASK
  #define CMASK(P0,P1,t) do{const int jb_=(t)-(NT-4); if(jb_>=0){cmask(P0,P1,qrel-64*jb_,hi); bmask(P0,P1,true,mhat);} else bmask(P0,P1,((selm>>((t)>>2))&1u)!=0u,mhat);}while(0)
  #define ENDW(tt) do{ if((tt)+3<NT){WAIT_BAR(2);} else if((tt)+2<NT){WAIT_BAR(1);} else {WAIT_BAR(0);} }while(0)
  for(;t+1<NT;t+=2){
    STEP(pB0,pB1,pA0,pA1,t,(t+3<NT),(t+1<NT),(t+1<NT));       ENDW(t);   RESC(); ROT();
    STEP(pA0,pA1,pB0,pB1,t+1,(t+4<NT),(t+2<NT),(t+2<NT));     ENDW(t+1); RESC(); ROT();
  }
  STEP(pB0,pB1,pA0,pA1,NT-1,false,false,false); RESC();
  { float sacc=pB0[0]+pB0[1]; _Pragma("unroll") for(int r=2;r<16;++r)sacc+=pB0[r]; _Pragma("unroll") for(int r=0;r<16;++r)sacc+=pB1[r]; l_reg+=sacc;
    pw0=(u32x4){PKW(pB0,0),PKW(pB0,2),PKW(pB0,4),PKW(pB0,6)};pw1=(u32x4){PKW(pB0,8),PKW(pB0,10),PKW(pB0,12),PKW(pB0,14)};pw2=(u32x4){PKW(pB1,0),PKW(pB1,2),PKW(pB1,4),PKW(pB1,6)};pw3=(u32x4){PKW(pB1,8),PKW(pB1,10),PKW(pB1,12),PKW(pB1,14)};
    SBAR(); pv(o,vb0+sl_cur,PAF(0),PAF(1),PAF(2),PAF(3)); }
  #undef PKW
  #undef PAF
  #undef VFR
  #undef PIN
  #undef MX3
  #undef GAPA
  #undef GAPB
  #undef EX
  #undef VRD
  #undef KRD
  #undef STEP
  #undef ENDW
  {auto rr=__builtin_amdgcn_permlane32_swap(__float_as_uint(l_reg),__float_as_uint(l_reg),false,false);l_reg=__uint_as_float(rr[0])+__uint_as_float(rr[1]);}
  if(hi==0)wsf[32+r32]=l_reg;asm volatile("s_waitcnt lgkmcnt(0)":::"memory");
  float rli[16];
  #pragma unroll
  for(int r=0;r<16;++r)rli[r]=__builtin_amdgcn_rcpf(wsf[32+crow(r,hi)]);
  bf16*Ow=O+(rowbase+q0+wid*QBLK)*DM+h*D;
  { bf16*stg=(bf16*)(shm+LDS_OST)+wid*2048;
    #pragma unroll
    for(int r=0;r<16;++r){const int orow=crow(r,hi);
      #pragma unroll
      for(int d0=0;d0<2;++d0)stg[orow*64+d0*32+r32]=__float2bfloat16(o[d0][r]*rli[r]);}
    asm volatile("s_waitcnt lgkmcnt(0)":::"memory");
    #pragma unroll
    for(int i=0;i<4;++i){const int row=i*8+(lane>>3),ch=lane&7; const u32x4 v=*(const u32x4*)(stg+row*64+ch*8); ATTN_STORE16(Ow+(long)row*DM+ch*8,v);} }
  asm volatile("s_waitcnt lgkmcnt(0)\n\ts_barrier":::"memory");
  #undef DMA_K
  #undef DMA_V
  #undef CMASK
  #undef START
  #undef RESC
  #undef ROT
}
constexpr int ATTN_LDS_BYTES=LDS_BYTES;
#undef SBAR
#undef WAIT_BAR
}

constexpr int NWAVES = 8;
constexpr int NPH = 15;
constexpr int N_LAUNCHES = MK_N_LAUNCHES;
static_assert(N_LAUNCHES == 1 || N_LAUNCHES == NPH, "MK_N_LAUNCHES is 1 or NPH");

constexpr size_t MiB = 1u << 20;
constexpr size_t WS_CTL = 0, CTL_ZERO_BYTES = 2 * MiB;
constexpr size_t WS_KMEAN = 1 * MiB;
constexpr size_t WS_GCOUNT = 1 * MiB + 512 * 1024;
constexpr size_t WS_WIN = 2 * MiB;
constexpr size_t WS_WAO = 12 * MiB, WS_WCO = 13 * MiB, WS_WOUT = 14 * MiB;
constexpr size_t WS_WSR = 16 * MiB;
constexpr size_t WS_WSD = 18 * MiB;
constexpr size_t WS_WPG = 19 * MiB, WS_WPP = 21 * MiB;
constexpr size_t WS_ROPE = 22 * MiB;
constexpr size_t WS_SEL = 22 * MiB + 512 * 1024;
constexpr size_t WS_PB = 24 * MiB;
constexpr size_t WS_TOPI = 40 * MiB, WS_TOPW = 41 * MiB, WS_LRANK = 42 * MiB;
constexpr size_t WS_ROWTOK = 43 * MiB, WS_ROWDST = 44 * MiB + 512 * 1024, WS_ROWW = 46 * MiB, WS_WGBASE = 47 * MiB + 256 * 1024;
constexpr size_t WS_WD = 48 * MiB;
constexpr size_t WS_WGU = 176 * MiB;
constexpr size_t WS_YLO = 176 * MiB;
constexpr size_t WS_XB = 432 * MiB;
constexpr size_t WS_S6 = 496 * MiB;
constexpr size_t WS_H = 496 * MiB;
constexpr size_t WS_YHI = 656 * MiB;
constexpr size_t WS_G = 688 * MiB;
constexpr size_t WS_P1 = 816 * MiB;
constexpr size_t WS_LOGITS = 912 * MiB;
constexpr size_t WS_HS = 944 * MiB;
constexpr size_t WS_PP = 960 * MiB;
constexpr size_t WS_END = 1024 * MiB;
static_assert(WS_H + (size_t)RMAX_ * 256 * 2 <= WS_YHI && WS_YHI + (size_t)T_ * 4 * 1024 * 2 <= WS_LOGITS && WS_WGU + (size_t)NE_ * 512 * 1024 * 2 <= WS_XB, "ws map");
static_assert(WS_ROWTOK + (size_t)RMAX_ * 4 <= WS_ROWDST && WS_ROWDST + (size_t)RMAX_ * 4 <= WS_ROWW && WS_ROWW + (size_t)RMAX_ * 4 <= WS_WGBASE, "ws tables");
constexpr int CW_BAR = 4096;

constexpr int RING_OFF = 0, RING_BYTES = 131072;
constexpr int LDSCTL_OFF = RING_BYTES, MISC_OFF = LDSCTL_OFF + 320;
constexpr int LX_HIST = LDSCTL_OFF + 512;
constexpr int LX_PST = LX_HIST + 1024;
constexpr int LX_NB = LX_PST + 1040;
constexpr int LX_BLKE = LX_NB + 1024;
constexpr int LX_XS = LX_BLKE + 2560;
constexpr int LDS_BYTES = 147456;
static_assert(LX_XS + 64 <= LDS_BYTES && attn_body::ATTN_LDS_BYTES <= RING_BYTES, "LDS map");

#define XB_TMO      128
#define XB_XCNT(j)  (256  + 64 * (j))
#define XB_XSUB(j)  (1280 + 64 * (j))
#define XB_XGEN(j)  (2304 + 64 * (j))
#define XB_TOP      3328
#define XB_TOPGEN   3392
#define XCD_BAR_WORDS 3456
#define XB_SPIN_CAP (1u << 18)

__device__ __forceinline__ unsigned xb_ld(unsigned* p)              { return __hip_atomic_load(p, __ATOMIC_RELAXED, __HIP_MEMORY_SCOPE_AGENT); }
__device__ __forceinline__ unsigned xb_add(unsigned* p, unsigned v) { return __hip_atomic_fetch_add(p, v, __ATOMIC_RELAXED, __HIP_MEMORY_SCOPE_AGENT); }
__device__ __forceinline__ unsigned xb_xcc_id() { return (unsigned)__builtin_amdgcn_s_getreg((3 << 11) | 20) & 0xFu; }
#define XB_SPIN(cond, bar) do { unsigned _sp = 0; while (cond) { __builtin_amdgcn_s_sleep(1); \
    if ((++_sp & 255u) == 0u) { if (xb_ld(&(bar)[XB_TMO])) break; if (_sp > XB_SPIN_CAP) { atomicAdd(&(bar)[XB_TMO], 1u); break; } } } } while (0)

struct XcdBarrier {
    unsigned* bar; unsigned x;
    volatile LAS unsigned* st;
};
__device__ __forceinline__ XcdBarrier xcd_barrier_post(unsigned* bar, volatile LAS unsigned* st, int wave) {
    XcdBarrier b; b.bar = bar; b.x = xb_xcc_id(); b.st = st;
    if (wave == 0 && lane_id() == 0) (void)xb_add(&bar[XB_XCNT(b.x)], 1u);
    return b;
}
__device__ __forceinline__ void xcd_barrier_complete(unsigned* bar, unsigned x, unsigned& nloc, unsigned& nx) {
    const unsigned G = gridDim.x * gridDim.y * gridDim.z;
    unsigned sum, cnt, mine, sp = 0u;
    for (;;) {
        sum = 0u; cnt = 0u; mine = 0u;
#pragma unroll
        for (unsigned j = 0; j < 16; ++j) { const unsigned c = xb_ld(&bar[XB_XCNT(j)]); sum += c; cnt += (c > 0u) ? 1u : 0u; mine = (j == x) ? c : mine; }
        if (sum == G) break;
        __builtin_amdgcn_s_sleep(1);
        if ((++sp & 255u) == 0u) { if (xb_ld(&bar[XB_TMO])) break; if (sp > XB_SPIN_CAP) { atomicAdd(&bar[XB_TMO], 1u); break; } }
    }
    nloc = mine > 0u ? mine : 1u; nx = cnt > 0u ? cnt : 1u;
}
__device__ __forceinline__ void xcd_barrier(const XcdBarrier& b, int wave) {
    asm volatile("s_waitcnt vmcnt(0)" ::: "memory");
    __syncthreads();
    if (wave == 0 && lane_id() == 0) {
        unsigned* bar = b.bar;
        __builtin_amdgcn_s_waitcnt(0);
        unsigned nloc = b.st[0], nx = b.st[1];
        if (nloc == 0u) { xcd_barrier_complete(bar, b.x, nloc, nx); b.st[0] = nloc; b.st[1] = nx; }
        const unsigned old = xb_add(&bar[XB_XSUB(b.x)], 1u);
        const unsigned gen = old / nloc;
        if (old + 1u == (gen + 1u) * nloc) {
            __builtin_amdgcn_fence(__ATOMIC_RELEASE, "agent");
            asm volatile("s_waitcnt vmcnt(0)" ::: "memory");
            const unsigned og = xb_add(&bar[XB_TOP], 1u);
            const unsigned tg = og / nx;
            if (og + 1u == (tg + 1u) * nx) xb_add(&bar[XB_TOPGEN], 1u);
            else XB_SPIN(xb_ld(&bar[XB_TOPGEN]) == tg, bar);
            __builtin_amdgcn_fence(__ATOMIC_ACQUIRE, "agent");
            xb_add(&bar[XB_XGEN(b.x)], 1u);
            asm volatile("s_waitcnt vmcnt(0)" ::: "memory");
        } else {
            XB_SPIN(xb_ld(&bar[XB_XGEN(b.x)]) == gen, bar);
            __builtin_amdgcn_fence(__ATOMIC_ACQUIRE, "agent");
            asm volatile("s_waitcnt vmcnt(0)" ::: "memory");
        }
    }
    __syncthreads();
}

struct Args { const float* in[23]; float* out; unsigned char* ws; int ph_lo, ph_hi, li, pad; };

struct Frame {
    LAS unsigned char* lds;
    volatile LAS unsigned* MISC;
    gu32* ctl;
    int wave;
    int vcu, G;
    unsigned char* ws; float* out;
};

__device__ __forceinline__ float wave_sum(float v) {
#pragma unroll
    for (int o = 1; o < 64; o <<= 1) v += __shfl_xor(v, o);
    return v;
}

__device__ __forceinline__ void xpose_item(const float* W, int N, int k0, int n0, bf16* dst, int Kd, LAS float* scr, int lane) {
#pragma unroll 8
    for (int i = 0; i < 32; ++i) { const int kk = 2 * i + (lane >> 5); scr[kk * 33 + (lane & 31)] = W[(size_t)(k0 + kk) * N + n0 + (lane & 31)]; }
    LDS_WAIT(); asm volatile("" ::: "memory");
    const int c = lane & 7;
#pragma unroll
    for (int j = 0; j < 4; ++j) { const int n = (lane >> 3) + 8 * j; const LAS float* s = scr + (8 * c) * 33 + n;
        v4u o; o.x = cvt_pk_bf16(s[0 * 33], s[1 * 33]); o.y = cvt_pk_bf16(s[2 * 33], s[3 * 33]); o.z = cvt_pk_bf16(s[4 * 33], s[5 * 33]); o.w = cvt_pk_bf16(s[6 * 33], s[7 * 33]);
        *(v4u*)(dst + (size_t)n * Kd + 8 * c) = o; }
    LDS_WAIT(); asm volatile("" ::: "memory");
}
__device__ __forceinline__ void xpose_mat(const float* W, int K, int N, bf16* WT, int rbase, int mode, int half, int r, LAS float* scr, int lane) {
    const int nblk = N / 32, kb = r / nblk, nb = r % nblk, k0 = 64 * kb, n0 = 32 * nb;
    const int drow = mode ? (rbase + (n0 >> 7) * 256 + ((n0 & 127) >> 5) * 64 + half * 32 + (n0 & 31)) : (rbase + n0);
    xpose_item(W, N, k0, n0, WT + (size_t)drow * K + k0, K, scr, lane);
}
__device__ __forceinline__ void p0_prologue(Frame& F, const Args& A) {
    const int lane_ = lane_id(), tid_ = F.wave * 64 + lane_; (void)tid_;
    LAS float* scr = (LAS float*)(F.lds + RING_OFF + F.wave * 16384);
    unsigned char* ws = F.ws;
    const int gw = F.vcu * NWAVES + F.wave, NGW = F.G * NWAVES;
    constexpr int I_IN = 16 * 160, I_AO = 8 * 32, I_CO = 8 * 32, I_OUT = 16 * 32, I_R = 16 * 8, I_SG = 16 * 8, I_SU = 16 * 8, I_SD = 4 * 32, I_PG = 16 * 32, I_PP = 4 * 32;
    constexpr int NSMALL = I_IN + I_AO + I_CO + I_OUT + I_R + I_SG + I_SU + I_SD + I_PG + I_PP;
    for (int it = gw; it < NSMALL; it += NGW) {
        int r = it;
        if (r < I_IN) { xpose_mat(A.in[2], 1024, 5120, (bf16*)(ws + WS_WIN), 0, 0, 0, r, scr, lane_); continue; } r -= I_IN;
        if (r < I_AO) { xpose_mat(A.in[4], 512, 1024, (bf16*)(ws + WS_WAO), 0, 0, 0, r, scr, lane_); continue; } r -= I_AO;
        if (r < I_CO) { xpose_mat(A.in[5], 512, 1024, (bf16*)(ws + WS_WCO), 0, 0, 0, r, scr, lane_); continue; } r -= I_CO;
        if (r < I_OUT) { xpose_mat(A.in[6], 1024, 1024, (bf16*)(ws + WS_WOUT), 0, 0, 0, r, scr, lane_); continue; } r -= I_OUT;
        if (r < I_R) { xpose_mat(A.in[9], 1024, 256, (bf16*)(ws + WS_WSR), 512, 0, 0, r, scr, lane_); continue; } r -= I_R;
        if (r < I_SG) { xpose_mat(A.in[14], 1024, 256, (bf16*)(ws + WS_WSR), 0, 1, 0, r, scr, lane_); continue; } r -= I_SG;
        if (r < I_SU) { xpose_mat(A.in[15], 1024, 256, (bf16*)(ws + WS_WSR), 0, 1, 1, r, scr, lane_); continue; } r -= I_SU;
        if (r < I_SD) { xpose_mat(A.in[16], 256, 1024, (bf16*)(ws + WS_WSD), 0, 0, 0, r, scr, lane_); continue; } r -= I_SD;
        if (r < I_PG) { xpose_mat(A.in[19], 1024, 1024, (bf16*)(ws + WS_WPG), 0, 0, 0, r, scr, lane_); continue; } r -= I_PG;
        xpose_mat(A.in[20], 256, 1024, (bf16*)(ws + WS_WPP), 0, 0, 0, r, scr, lane_);
    }
    for (int it = gw; it < NE_ * 384; it += NGW) {
        const int e = it / 384; int r = it % 384;
        if (r < 128) { xpose_mat(A.in[11] + (size_t)e * 1024 * 256, 1024, 256, (bf16*)(ws + WS_WGU), e * 512, 1, 0, r, scr, lane_); continue; } r -= 128;
        if (r < 128) { xpose_mat(A.in[12] + (size_t)e * 1024 * 256, 1024, 256, (bf16*)(ws + WS_WGU), e * 512, 1, 1, r, scr, lane_); continue; } r -= 128;
        xpose_mat(A.in[13] + (size_t)e * 256 * 1024, 256, 1024, (bf16*)(ws + WS_WD), e * 1024, 0, 0, r, scr, lane_);
    }
    {
        const size_t gt = (size_t)F.vcu * 512 + tid_, NT = (size_t)F.G * 512;
#ifdef MK_FILL_G
        { v4u z; z.x = z.y = z.z = z.w = 0u; unsigned char* gp = ws + WS_G; for (size_t i = gt; i < (size_t)(128u << 20) / 16; i += NT) *(v4u*)(gp + i * 16) = z; }
#endif
        const float* x = A.in[0]; bf16* xb = (bf16*)(ws + WS_XB);
        for (size_t i = gt; i < (size_t)T_ * D_ / 8; i += NT) { const f32x4 a = *(const f32x4*)(x + i * 8), b = *(const f32x4*)(x + i * 8 + 4);
            v4u o; o.x = cvt_pk_bf16(a.x, a.y); o.y = cvt_pk_bf16(a.z, a.w); o.z = cvt_pk_bf16(b.x, b.y); o.w = cvt_pk_bf16(b.z, b.w); *(v4u*)(xb + i * 8) = o; }
        const float* p = A.in[1]; bf16* pb = (bf16*)(ws + WS_PB);
        for (size_t i = gt; i < (size_t)T_ * PLE_ / 8; i += NT) { const f32x4 a = *(const f32x4*)(p + i * 8), b = *(const f32x4*)(p + i * 8 + 4);
            v4u o; o.x = cvt_pk_bf16(a.x, a.y); o.y = cvt_pk_bf16(a.z, a.w); o.z = cvt_pk_bf16(b.x, b.y); o.w = cvt_pk_bf16(b.z, b.w); *(v4u*)(pb + i * 8) = o; }
        float* rope = (float*)(ws + WS_ROPE);
        for (size_t i = gt; i < (size_t)SEQ_ * 8; i += NT) {
            const int pos = (int)(i >> 3), fi = (int)(i & 7);
            const float invf = (float)exp(-(double)fi * 0.125 * log(500000.0));
            const float angf = (float)pos * invf;
            const double ang = (double)angf;
            const double kq = rint(ang * 0.63661977236758134308);
            const double rr = (ang - kq * 1.57079632679489655800) - kq * 6.12323399573676603587e-17;
            const double r2 = rr * rr;
            const double sn = rr * (1.0 + r2 * (-1.0 / 6 + r2 * (1.0 / 120 + r2 * (-1.0 / 5040 + r2 * (1.0 / 362880 + r2 * (-1.0 / 39916800 + r2 * (1.0 / 6227020800.0)))))));
            const double cs = 1.0 + r2 * (-0.5 + r2 * (1.0 / 24 + r2 * (-1.0 / 720 + r2 * (1.0 / 40320 + r2 * (-1.0 / 3628800 + r2 * (1.0 / 479001600.0 + r2 * (-1.0 / 87178291200.0)))))));
            const int q = (int)(((long long)kq) & 3);
            const double c = (q == 0) ? cs : (q == 1) ? -sn : (q == 2) ? -cs : sn;
            const double s = (q == 0) ? sn : (q == 1) ? cs : (q == 2) ? -sn : -cs;
            rope[pos * 16 + fi] = (float)c; rope[pos * 16 + 8 + fi] = (float)s;
        }
    }
}

typedef const f32x4 (&AccRef)[2][2][4][2];
__device__ __forceinline__ void store_rows128(bf16* rowA, bf16* rowB, int fr, int fq, v4u p0, v4u p1) {
    const bool low = (fr & 8) == 0;
    const v4u snd = low ? p1 : p0; v4u rcv;
    rcv.x = __shfl_xor(snd.x, 8); rcv.y = __shfl_xor(snd.y, 8); rcv.z = __shfl_xor(snd.z, 8); rcv.w = __shfl_xor(snd.w, 8);
    const v4u dA = low ? p0 : rcv, dB = low ? rcv : p1;
    const int colb = (low ? 0 : 32) + 8 * fq;
    if (rowA) *(v4u*)(rowA + colb) = dA;
    if (rowB) *(v4u*)(rowB + colb) = dB;
}

struct EpiZ {
    static constexpr bool PERM = true;
    bf16* S6; bf16* Gt; const float* rope; float* kmean;
    __device__ __forceinline__ void operator()(AccRef acc, const pg8::Unit& u, int wr, int wc, int fr, int fq) const {
        const int pn = u.pn, row0 = u.row0 + wr * 64 + fr, ct0 = wc * 64 + 8 * fq, rg0 = u.row0 + wr * 64 + (fr & 7);
        if (pn < 12) {
            bf16* base = S6 + (size_t)(pn >> 1) * T_ * 512 + (pn & 1) * 256 + wc * 64;
            const bool ropew = (pn < 4);
            const bool isk = (pn == 2) || (pn == 3);
            const float sc = (pn < 2) ? attn_body::C2 : 1.f;
            float ks[2][8];
#pragma unroll
            for (int bj = 0; bj < 2; ++bj)
#pragma unroll
                for (int i = 0; i < 8; ++i) ks[bj][i] = 0.f;
#pragma unroll
            for (int ai = 0; ai < 2; ++ai)
#pragma unroll
                for (int m = 0; m < 4; ++m) {
                    const int r = row0 + ai * 128 + m * 16;
                    float cs[8], sn[8];
                    if (ropew) { const float* rp = rope + (size_t)(r & (SEQ_ - 1)) * 16; const f32x4 c0 = *(const f32x4*)rp, c1 = *(const f32x4*)(rp + 4), s0 = *(const f32x4*)(rp + 8), s1 = *(const f32x4*)(rp + 12);
                        cs[0] = c0.x; cs[1] = c0.y; cs[2] = c0.z; cs[3] = c0.w; cs[4] = c1.x; cs[5] = c1.y; cs[6] = c1.z; cs[7] = c1.w;
                        sn[0] = s0.x; sn[1] = s0.y; sn[2] = s0.z; sn[3] = s0.w; sn[4] = s1.x; sn[5] = s1.y; sn[6] = s1.z; sn[7] = s1.w; }
                    v4u pc[2];
#pragma unroll
                    for (int bj = 0; bj < 2; ++bj) {
                        const f32x4 v0 = acc[ai][bj][m][0], v1 = acc[ai][bj][m][1];
                        float x[8] = {v0.x, v0.y, v0.z, v0.w, v1.x, v1.y, v1.z, v1.w};
                        if (ropew && bj == 0) {
#pragma unroll
                            for (int i = 0; i < 8; ++i) { const float o = __shfl_xor(x[i], 16);
                                const float a = x[i] * cs[i] - o * sn[i];
                                const float b = o * sn[i] + x[i] * cs[i];
                                x[i] = (fq == 0) ? a : (fq == 1) ? b : x[i]; }
                        }
                        if (isk) {
#pragma unroll
                            for (int i = 0; i < 8; ++i) ks[bj][i] += x[i];
                        }
                        v4u w; w.x = cvt_pk_bf16(x[0] * sc, x[1] * sc); w.y = cvt_pk_bf16(x[2] * sc, x[3] * sc); w.z = cvt_pk_bf16(x[4] * sc, x[5] * sc); w.w = cvt_pk_bf16(x[6] * sc, x[7] * sc);
                        pc[bj] = w;
                    }
                    { bf16* ra = base + (size_t)(rg0 + ai * 128 + m * 16) * 512; store_rows128(ra, ra + 8 * 512, fr, fq, pc[0], pc[1]); }
                }
            if (isk) {
                const int b = u.row0 / SEQ_, blk = (u.row0 % SEQ_) / 256;
#pragma unroll
                for (int bj = 0; bj < 2; ++bj)
#pragma unroll
                    for (int i = 0; i < 8; ++i) { float s = ks[bj][i]; s += __shfl_xor(s, 1); s += __shfl_xor(s, 2); s += __shfl_xor(s, 4); s += __shfl_xor(s, 8);
                        if (fr == 0) { const int c = (pn - 2) * 256 + bj * 32 + ct0 + i; atomicAdd(kmean + ((size_t)((b * NH_ + (c >> 6)) * NBLK_ + blk)) * 64 + (c & 63), s * (1.0f / 256.0f)); } }
            }
        } else {
            bf16* base = Gt + (size_t)((pn - 12) >> 2) * T_ * 1024 + (size_t)((pn - 12) & 3) * 256 + wc * 64;
#pragma unroll
            for (int ai = 0; ai < 2; ++ai)
#pragma unroll
                for (int m = 0; m < 4; ++m) { v4u pc[2];
#pragma unroll
                    for (int bj = 0; bj < 2; ++bj) { const f32x4 v0 = acc[ai][bj][m][0], v1 = acc[ai][bj][m][1];
                        v4u w; w.x = cvt_pk_bf16(sigmoidf_(v0.x), sigmoidf_(v0.y)); w.y = cvt_pk_bf16(sigmoidf_(v0.z), sigmoidf_(v0.w)); w.z = cvt_pk_bf16(sigmoidf_(v1.x), sigmoidf_(v1.y)); w.w = cvt_pk_bf16(sigmoidf_(v1.z), sigmoidf_(v1.w));
                        pc[bj] = w; }
                    bf16* ra = base + (size_t)(rg0 + ai * 128 + m * 16) * 1024; store_rows128(ra, ra + 8 * 1024, fr, fq, pc[0], pc[1]); }
        }
    }
};

template <bool ADD> struct EpiGate {
    static constexpr bool PERM = true;
    bf16* O; const bf16* gate;
    __device__ __forceinline__ void operator()(AccRef acc, const pg8::Unit& u, int wr, int wc, int fr, int fq) const {
        const int row0 = u.row0 + wr * 64 + fr, col0 = u.pn * 256 + wc * 64 + 8 * fq, rg0 = u.row0 + wr * 64 + (fr & 7);
#pragma unroll
        for (int ai = 0; ai < 2; ++ai) {
            v4u g[4][2], p[4][2];
#pragma unroll
            for (int m = 0; m < 4; ++m)
#pragma unroll
                for (int bj = 0; bj < 2; ++bj) { const size_t off = (size_t)(row0 + ai * 128 + m * 16) * 1024 + col0 + bj * 32; g[m][bj] = *(const v4u*)(gate + off); if (ADD) p[m][bj] = *(const v4u*)(O + off); }
            asm volatile("" ::: "memory");
#pragma unroll
            for (int m = 0; m < 4; ++m) { v4u pc[2];
#pragma unroll
                for (int bj = 0; bj < 2; ++bj) { const f32x4 v0 = acc[ai][bj][m][0], v1 = acc[ai][bj][m][1]; const v4u gg = g[m][bj];
                    float y[8] = {bf_lo(gg.x) * v0.x, bf_hi(gg.x) * v0.y, bf_lo(gg.y) * v0.z, bf_hi(gg.y) * v0.w, bf_lo(gg.z) * v1.x, bf_hi(gg.z) * v1.y, bf_lo(gg.w) * v1.z, bf_hi(gg.w) * v1.w};
                    if (ADD) { const v4u pp = p[m][bj]; y[0] += bf_lo(pp.x); y[1] += bf_hi(pp.x); y[2] += bf_lo(pp.y); y[3] += bf_hi(pp.y); y[4] += bf_lo(pp.z); y[5] += bf_hi(pp.z); y[6] += bf_lo(pp.w); y[7] += bf_hi(pp.w); }
                    v4u w; w.x = cvt_pk_bf16(y[0], y[1]); w.y = cvt_pk_bf16(y[2], y[3]); w.z = cvt_pk_bf16(y[4], y[5]); w.w = cvt_pk_bf16(y[6], y[7]);
                    pc[bj] = w; }
                bf16* ra = O + (size_t)(rg0 + ai * 128 + m * 16) * 1024 + u.pn * 256 + wc * 64; store_rows128(ra, ra + 8 * 1024, fr, fq, pc[0], pc[1]); }
            asm volatile("" ::: "memory");
        }
    }
};

template <bool RBF> struct EpiRes {
    static constexpr bool PERM = true;
    bf16* O; const void* R;
    __device__ __forceinline__ void operator()(AccRef acc, const pg8::Unit& u, int wr, int wc, int fr, int fq) const {
        const int row0 = u.row0 + wr * 64 + fr, col0 = u.pn * 256 + wc * 64 + 8 * fq, rg0 = u.row0 + wr * 64 + (fr & 7);
#pragma unroll
        for (int ai = 0; ai < 2; ++ai) {
            f32x4 ra[4][2], rb[4][2]; v4u rh[4][2];
#pragma unroll
            for (int m = 0; m < 4; ++m)
#pragma unroll
                for (int bj = 0; bj < 2; ++bj) { const size_t off = (size_t)(row0 + ai * 128 + m * 16) * D_ + col0 + bj * 32;
                    if (RBF) rh[m][bj] = *(const v4u*)((const bf16*)R + off); else { ra[m][bj] = *(const f32x4*)((const float*)R + off); rb[m][bj] = *(const f32x4*)((const float*)R + off + 4); } }
            asm volatile("" ::: "memory");
#pragma unroll
            for (int m = 0; m < 4; ++m) { v4u pc[2];
#pragma unroll
                for (int bj = 0; bj < 2; ++bj) { const f32x4 v0 = acc[ai][bj][m][0], v1 = acc[ai][bj][m][1];
                    float r[8];
                    if (RBF) { const v4u h = rh[m][bj]; r[0] = bf_lo(h.x); r[1] = bf_hi(h.x); r[2] = bf_lo(h.y); r[3] = bf_hi(h.y); r[4] = bf_lo(h.z); r[5] = bf_hi(h.z); r[6] = bf_lo(h.w); r[7] = bf_hi(h.w); }
                    else { const f32x4 a = ra[m][bj], b = rb[m][bj]; r[0] = a.x; r[1] = a.y; r[2] = a.z; r[3] = a.w; r[4] = b.x; r[5] = b.y; r[6] = b.z; r[7] = b.w; }
                    v4u w; w.x = cvt_pk_bf16(r[0] * DN_ALPHA_ + v0.x, r[1] * DN_ALPHA_ + v0.y); w.y = cvt_pk_bf16(r[2] * DN_ALPHA_ + v0.z, r[3] * DN_ALPHA_ + v0.w);
                    w.z = cvt_pk_bf16(r[4] * DN_ALPHA_ + v1.x, r[5] * DN_ALPHA_ + v1.y); w.w = cvt_pk_bf16(r[6] * DN_ALPHA_ + v1.z, r[7] * DN_ALPHA_ + v1.w);
                    pc[bj] = w; }
                bf16* rowa = O + (size_t)(rg0 + ai * 128 + m * 16) * D_ + u.pn * 256 + wc * 64; store_rows128(rowa, rowa + 8 * D_, fr, fq, pc[0], pc[1]); }
            asm volatile("" ::: "memory");
        }
    }
};

__device__ __forceinline__ void swiglu_store(AccRef acc, bf16* Hrow0  , int ld, int wr, int wc, int fr, int fq) {
#pragma unroll
    for (int ai = 0; ai < 2; ++ai)
#pragma unroll
        for (int m = 0; m < 4; ++m) { bf16* hp = Hrow0 + (size_t)(wr * 64 + fr + ai * 128 + m * 16) * ld + wc * 32 + 8 * fq;
            float y[8];
#pragma unroll
            for (int n = 0; n < 2; ++n)
#pragma unroll
                for (int j = 0; j < 4; ++j) { const float g = acc[ai][0][m][n][j], up = acc[ai][1][m][n][j]; y[n * 4 + j] = g * sigmoidf_(g) * up; }
            v4u w; w.x = cvt_pk_bf16(y[0], y[1]); w.y = cvt_pk_bf16(y[2], y[3]); w.z = cvt_pk_bf16(y[4], y[5]); w.w = cvt_pk_bf16(y[6], y[7]);
            *(v4u*)hp = w; asm volatile("" ::: "memory"); }
}
struct EpiShRouter {
    static constexpr bool PERM = true;
    bf16* Hs; float* logits;
    __device__ __forceinline__ void operator()(AccRef acc, const pg8::Unit& u, int wr, int wc, int fr, int fq) const {
        if (u.pn < 2) { swiglu_store(acc, Hs + (size_t)u.row0 * 256 + u.pn * 128, 256, wr, wc, fr, fq); return; }
#pragma unroll
        for (int ai = 0; ai < 2; ++ai)
#pragma unroll
            for (int m = 0; m < 4; ++m) { float* lp = logits + (size_t)(u.row0 + wr * 64 + fr + ai * 128 + m * 16) * 256 + wc * 64 + 8 * fq;
#pragma unroll
                for (int bj = 0; bj < 2; ++bj) { *(f32x4*)(lp + bj * 32) = acc[ai][bj][m][0]; *(f32x4*)(lp + bj * 32 + 4) = acc[ai][bj][m][1]; } asm volatile("" ::: "memory"); }
    }
};
struct EpiMoeUp {
    static constexpr bool PERM = true;
    bf16* H;
    __device__ __forceinline__ void operator()(AccRef acc, const pg8::Unit& u, int wr, int wc, int fr, int fq) const { swiglu_store(acc, H + (size_t)u.row0 * 256 + u.pn * 128, 256, wr, wc, fr, fq); }
};
struct EpiMoeDown {
    static constexpr bool PERM = true;
    unsigned char* Y8; const int* row_dst; const float* row_w;
    __device__ __forceinline__ void operator()(AccRef acc, const pg8::Unit& u, int wr, int wc, int fr, int fq) const {
        const int s0 = u.row0 + wr * 64 + fr, colw = u.pn * 256 + wc * 64;
        int dsts[2][4]; float ws_[2][4];
#pragma unroll
        for (int ai = 0; ai < 2; ++ai)
#pragma unroll
            for (int m = 0; m < 4; ++m) { const int slot = s0 + ai * 128 + m * 16; dsts[ai][m] = row_dst[slot]; ws_[ai][m] = row_w[slot]; }
        asm volatile("" ::: "memory");
        const bool even = (fq & 1) == 0;
#pragma unroll
        for (int ai = 0; ai < 2; ++ai)
#pragma unroll
            for (int m = 0; m < 4; ++m) { const float w = ws_[ai][m]; u32x2 pc[2];
#pragma unroll
                for (int bj = 0; bj < 2; ++bj) { const f32x4 v0 = acc[ai][bj][m][0] * w, v1 = acc[ai][bj][m][1] * w;
                    int lo = 0, hi = 0; lo = __builtin_amdgcn_cvt_pk_fp8_f32(v0.x, v0.y, lo, false); lo = __builtin_amdgcn_cvt_pk_fp8_f32(v0.z, v0.w, lo, true);
                    hi = __builtin_amdgcn_cvt_pk_fp8_f32(v1.x, v1.y, hi, false); hi = __builtin_amdgcn_cvt_pk_fp8_f32(v1.z, v1.w, hi, true);
                    pc[bj].x = (unsigned)lo; pc[bj].y = (unsigned)hi; }
                const u32x2 snd = even ? pc[1] : pc[0]; u32x2 rcv; rcv.x = __shfl_xor(snd.x, 16); rcv.y = __shfl_xor(snd.y, 16);
                v4u o; if (even) { o.x = pc[0].x; o.y = pc[0].y; o.z = rcv.x; o.w = rcv.y; } else { o.x = rcv.x; o.y = rcv.y; o.z = pc[1].x; o.w = pc[1].y; }
                const int dst = dsts[ai][m];
                if (dst >= 0) *(v4u*)(Y8 + (size_t)dst * 1024 + colw + (even ? 8 * fq : 32 + 8 * (fq - 1))) = o; }
    }
};
struct EpiBf16Plain {
    static constexpr bool PERM = true;
    bf16* O; int ldc;
    __device__ __forceinline__ void operator()(AccRef acc, const pg8::Unit& u, int wr, int wc, int fr, int fq) const {
        const int rg0 = u.row0 + wr * 64 + (fr & 7), colw = u.pn * 256 + wc * 64;
#pragma unroll
        for (int ai = 0; ai < 2; ++ai)
#pragma unroll
            for (int m = 0; m < 4; ++m) { v4u pc[2];
#pragma unroll
                for (int bj = 0; bj < 2; ++bj) { const f32x4 v0 = acc[ai][bj][m][0], v1 = acc[ai][bj][m][1];
                    v4u o; o.x = cvt_pk_bf16(v0.x, v0.y); o.y = cvt_pk_bf16(v0.z, v0.w); o.z = cvt_pk_bf16(v1.x, v1.y); o.w = cvt_pk_bf16(v1.z, v1.w); pc[bj] = o; }
                bf16* ra = O + (size_t)(rg0 + ai * 128 + m * 16) * ldc + colw; store_rows128(ra, ra + (size_t)8 * ldc, fr, fq, pc[0], pc[1]); }
    }
};
struct EpiPle {
    static constexpr bool PERM = true;
    bf16* X; const bf16* Hres; const bf16* PP;
    __device__ __forceinline__ void operator()(AccRef acc, const pg8::Unit& u, int wr, int wc, int fr, int fq) const {
        const int row0 = u.row0 + wr * 64 + fr, col0 = u.pn * 256 + wc * 64 + 8 * fq, rg0 = u.row0 + wr * 64 + (fr & 7);
#pragma unroll
        for (int ai = 0; ai < 2; ++ai) {
            v4u pv[4][2], hv[4][2];
#pragma unroll
            for (int m = 0; m < 4; ++m)
#pragma unroll
                for (int bj = 0; bj < 2; ++bj) { const size_t ro = (size_t)(row0 + ai * 128 + m * 16) * D_ + col0 + bj * 32; pv[m][bj] = *(const v4u*)(PP + ro); hv[m][bj] = *(const v4u*)(Hres + ro); }
            asm volatile("" ::: "memory");
#pragma unroll
            for (int m = 0; m < 4; ++m) { v4u pc[2];
#pragma unroll
                for (int bj = 0; bj < 2; ++bj) { const f32x4 v0 = acc[ai][bj][m][0], v1 = acc[ai][bj][m][1];
                    const v4u p = pv[m][bj], h = hv[m][bj];
                    f32x4 o0, o1;
                    o0.x = bf_lo(h.x) * DN_ALPHA_ + sigmoidf_(v0.x) * bf_lo(p.x); o0.y = bf_hi(h.x) * DN_ALPHA_ + sigmoidf_(v0.y) * bf_hi(p.x); o0.z = bf_lo(h.y) * DN_ALPHA_ + sigmoidf_(v0.z) * bf_lo(p.y); o0.w = bf_hi(h.y) * DN_ALPHA_ + sigmoidf_(v0.w) * bf_hi(p.y);
                    o1.x = bf_lo(h.z) * DN_ALPHA_ + sigmoidf_(v1.x) * bf_lo(p.z); o1.y = bf_hi(h.z) * DN_ALPHA_ + sigmoidf_(v1.y) * bf_hi(p.z); o1.z = bf_lo(h.w) * DN_ALPHA_ + sigmoidf_(v1.z) * bf_lo(p.w); o1.w = bf_hi(h.w) * DN_ALPHA_ + sigmoidf_(v1.w) * bf_hi(p.w);
                    v4u w; w.x = cvt_pk_bf16(o0.x, o0.y); w.y = cvt_pk_bf16(o0.z, o0.w); w.z = cvt_pk_bf16(o1.x, o1.y); w.w = cvt_pk_bf16(o1.z, o1.w); pc[bj] = w; }
                bf16* rowa = X + (size_t)(rg0 + ai * 128 + m * 16) * D_ + u.pn * 256 + wc * 64; store_rows128(rowa, rowa + 8 * D_, fr, fq, pc[0], pc[1]); }
            asm volatile("" ::: "memory");
        }
    }
};

struct EpiNull { static constexpr bool PERM = true; __device__ __forceinline__ void operator()(AccRef acc, const pg8::Unit& u, int, int, int, int) const { if (u.row0 == -12345) { float* p = nullptr; p[0] = acc[0][0][0][0].x; } } };
__device__ __forceinline__ void moe_tables(Frame& F) {
    const int lane_ = lane_id(), tid_ = F.wave * 64 + lane_; (void)tid_;
    LAS unsigned* PST = (LAS unsigned*)(F.lds + LX_PST); LAS unsigned* NB = (LAS unsigned*)(F.lds + LX_NB); LAS unsigned short* BLKE = (LAS unsigned short*)(F.lds + LX_BLKE);
    const unsigned* gcount = (const unsigned*)(F.ws + WS_GCOUNT);
    __syncthreads();
    if (tid_ < 256) NB[tid_] = (gcount[tid_] + 255u) >> 8;
    __syncthreads();
    if (tid_ < 256) { const int pe = (tid_ & 7) * 32 + (tid_ >> 3); unsigned s = 0, tot = 0; for (int j = 0; j < 256; ++j) { const unsigned nbj = NB[j]; tot += nbj; if (((j & 7) * 32 + (j >> 3)) < pe) s += nbj; }
        PST[tid_] = s * 256u; if (tid_ == 255) PST[256] = tot;
        LAS unsigned* XS = (LAS unsigned*)(F.lds + LX_XS); if (tid_ < 8) XS[tid_] = s; if (tid_ == 8) XS[8] = tot;
        const unsigned nb = NB[tid_]; for (unsigned i = 0; i < nb; ++i) BLKE[s + i] = (unsigned short)tid_; }
    __syncthreads();
}
struct MoeUpOrder {
    static constexpr bool GATHER = true;
    const LAS unsigned short* blke; const LAS unsigned* xs; const int* row_tok; const char* A; const char* Bt; int wpl, vcu;
    __device__ __forceinline__ bool next(int i, pg8::Unit& u) const {
        const int x = vcu / wpl, n = i * wpl + (vcu % wpl); if (x >= 8) return false;
        const int b0 = (int)xs[x], b1 = (int)xs[x + 1], rbl = n >> 1, pn = n & 1; if (rbl >= b1 - b0) return false;
        const int rb = b0 + rbl; const int e = __builtin_amdgcn_readfirstlane((int)blke[rb]);
        u.a = A; u.b = Bt + ((size_t)e * 512 + pn * 256) * 1024 * 2; u.row0 = rb * 256; u.pn = pn; u.e = e; return true;
    }
    __device__ __forceinline__ void aoff(const pg8::Unit& u, int tid, unsigned (&v)[2][2]) const {
#pragma unroll
        for (int i = 0; i < 2; ++i) { int R, C; pg8::stage_rc(tid * 16 + i * 8192, R, C);
#pragma unroll
            for (int h = 0; h < 2; ++h) { const int tok = row_tok[u.row0 + h * 128 + R]; v[h][i] = (unsigned)(tok * 1024 + C) * 2u; } }
    }
};
struct MoeDownOrder {
    static constexpr bool GATHER = false;
    const LAS unsigned short* blke; const LAS unsigned* xs; const char* A; const char* Bt; int wpl, vcu;
    __device__ __forceinline__ bool next(int i, pg8::Unit& u) const {
        const int x = vcu / wpl, n = i * wpl + (vcu % wpl); if (x >= 8) return false;
        const int b0 = (int)xs[x], b1 = (int)xs[x + 1], rbl = n >> 2, pn = n & 3; if (rbl >= b1 - b0) return false;
        const int rb = b0 + rbl; const int e = __builtin_amdgcn_readfirstlane((int)blke[rb]);
        u.a = A + (size_t)rb * 256 * 256 * 2; u.b = Bt + ((size_t)e * 1024 + pn * 256) * 256 * 2; u.row0 = rb * 256; u.pn = pn; u.e = e; return true;
    }
};

__device__ __forceinline__ void p_conv(Frame& F, const float* conv_w) {
    const int lane_ = lane_id(), tid_ = F.wave * 64 + lane_; (void)tid_;
    bf16* cb = (bf16*)(F.ws + WS_S6) + (size_t)3 * T_ * 512; const bf16* cc = (const bf16*)(F.ws + WS_S6) + (size_t)4 * T_ * 512; const bf16* ch = (const bf16*)(F.ws + WS_S6) + (size_t)5 * T_ * 512;
    const int gw = F.vcu * NWAVES + F.wave, NGW = F.G * NWAVES, c0 = lane_ * 8;
    float w0[8], w1[8], w2[8];
#pragma unroll
    for (int i = 0; i < 8; ++i) { w0[i] = conv_w[c0 + i]; w1[i] = conv_w[512 + c0 + i]; w2[i] = conv_w[1024 + c0 + i]; }
    for (int ck = gw; ck < T_ / 32; ck += NGW) {
        const int t0 = ck * 32;
        float u1[8], u2[8];
#pragma unroll
        for (int i = 0; i < 8; ++i) { u1[i] = 0.f; u2[i] = 0.f; }
        if ((t0 & (SEQ_ - 1)) != 0) {
            const v4u a2 = *(const v4u*)(cc + (size_t)(t0 - 2) * 512 + c0), b2 = *(const v4u*)(ch + (size_t)(t0 - 2) * 512 + c0);
            const v4u a1 = *(const v4u*)(cc + (size_t)(t0 - 1) * 512 + c0), b1 = *(const v4u*)(ch + (size_t)(t0 - 1) * 512 + c0);
            u2[0] = bf_lo(a2.x) * bf_lo(b2.x); u2[1] = bf_hi(a2.x) * bf_hi(b2.x); u2[2] = bf_lo(a2.y) * bf_lo(b2.y); u2[3] = bf_hi(a2.y) * bf_hi(b2.y);
            u2[4] = bf_lo(a2.z) * bf_lo(b2.z); u2[5] = bf_hi(a2.z) * bf_hi(b2.z); u2[6] = bf_lo(a2.w) * bf_lo(b2.w); u2[7] = bf_hi(a2.w) * bf_hi(b2.w);
            u1[0] = bf_lo(a1.x) * bf_lo(b1.x); u1[1] = bf_hi(a1.x) * bf_hi(b1.x); u1[2] = bf_lo(a1.y) * bf_lo(b1.y); u1[3] = bf_hi(a1.y) * bf_hi(b1.y);
            u1[4] = bf_lo(a1.z) * bf_lo(b1.z); u1[5] = bf_hi(a1.z) * bf_hi(b1.z); u1[6] = bf_lo(a1.w) * bf_lo(b1.w); u1[7] = bf_hi(a1.w) * bf_hi(b1.w);
        }
#pragma unroll 4
        for (int t = t0; t < t0 + 32; ++t) {
            const v4u a = *(const v4u*)(cc + (size_t)t * 512 + c0), b = *(const v4u*)(ch + (size_t)t * 512 + c0), g = *(const v4u*)(cb + (size_t)t * 512 + c0);
            float u0[8] = {bf_lo(a.x) * bf_lo(b.x), bf_hi(a.x) * bf_hi(b.x), bf_lo(a.y) * bf_lo(b.y), bf_hi(a.y) * bf_hi(b.y), bf_lo(a.z) * bf_lo(b.z), bf_hi(a.z) * bf_hi(b.z), bf_lo(a.w) * bf_lo(b.w), bf_hi(a.w) * bf_hi(b.w)};
            const float gb[8] = {bf_lo(g.x), bf_hi(g.x), bf_lo(g.y), bf_hi(g.y), bf_lo(g.z), bf_hi(g.z), bf_lo(g.w), bf_hi(g.w)};
            float y[8];
#pragma unroll
            for (int i = 0; i < 8; ++i) { y[i] = gb[i] * (w0[i] * u2[i] + w1[i] * u1[i] + w2[i] * u0[i]); u2[i] = u1[i]; u1[i] = u0[i]; }
            v4u o; o.x = cvt_pk_bf16(y[0], y[1]); o.y = cvt_pk_bf16(y[2], y[3]); o.z = cvt_pk_bf16(y[4], y[5]); o.w = cvt_pk_bf16(y[6], y[7]);
            *(v4u*)(cb + (size_t)t * 512 + c0) = o;
        }
    }
}
__device__ __forceinline__ void p_select(Frame& F) {
    const int lane_ = lane_id(), tid_ = F.wave * 64 + lane_; (void)tid_;
    const bf16* Q = (const bf16*)(F.ws + WS_S6); const float* kmean = (const float*)(F.ws + WS_KMEAN); unsigned* SEL = (unsigned*)(F.ws + WS_SEL);
    const int gt = F.vcu * 512 + tid_, NT = F.G * 512;
    for (int it = gt; it < NB_ * NH_ * SEQ_; it += NT) {
        const int s = it & (SEQ_ - 1), bh = it >> 12, b = bh >> 3, h = bh & 7;
        const int own = __builtin_amdgcn_readfirstlane(s >> 8);
        const int bhu = __builtin_amdgcn_readfirstlane(bh);
        float q[64];
        const bf16* qp = Q + ((size_t)(b * SEQ_ + s)) * 512 + h * 64;
#pragma unroll
        for (int i = 0; i < 8; ++i) { const v4u w = *(const v4u*)(qp + i * 8); q[i * 8 + 0] = bf_lo(w.x); q[i * 8 + 1] = bf_hi(w.x); q[i * 8 + 2] = bf_lo(w.y); q[i * 8 + 3] = bf_hi(w.y); q[i * 8 + 4] = bf_lo(w.z); q[i * 8 + 5] = bf_hi(w.z); q[i * 8 + 6] = bf_lo(w.w); q[i * 8 + 7] = bf_hi(w.w); }
        float v0 = -INFINITY, v1 = -INFINITY, v2 = -INFINITY; int i0 = -1, i1 = -1, i2 = -1;
        for (int j = 0; j < own; ++j) {
            const float* km = kmean + ((size_t)(bhu * NBLK_ + j)) * 64;
            float d = 0.f;
#pragma unroll
            for (int i = 0; i < 64; ++i) d += q[i] * km[i];
            if (d > v0) { v2 = v1; i2 = i1; v1 = v0; i1 = i0; v0 = d; i0 = j; }
            else if (d > v1) { v2 = v1; i2 = i1; v1 = d; i1 = j; }
            else if (d > v2) { v2 = d; i2 = j; }
        }
        unsigned m = 0u; if (i0 >= 0) m |= 1u << i0; if (i1 >= 0) m |= 1u << i1; if (i2 >= 0) m |= 1u << i2;
        SEL[it] = m;
    }
}

struct AttnOrder {
    int vcu;
    __device__ __forceinline__ bool next(int i, int& bh, int& qb) const { if (i >= 4 || vcu >= 256) return false; const int j = vcu & 3; bh = vcu >> 2; qb = (i == 0) ? 15 - j : (i == 1) ? 8 + j : (i == 2) ? 7 - j : j; return true; }
};

template <bool ADD_Y, bool WRITE_F32, bool WRITE_BF>
__device__ __forceinline__ void ln_row(Frame& F, const bf16* src, float* dst, bf16* dstb, const float* gam, const float* bet, const bf16* y0, const bf16* y1, int row) {
    const int lane_ = lane_id();
    float v[2][8];
#pragma unroll
    for (int h = 0; h < 2; ++h) { const v4u w = *(const v4u*)(src + (size_t)row * D_ + 512 * h + lane_ * 8);
        v[h][0] = bf_lo(w.x); v[h][1] = bf_hi(w.x); v[h][2] = bf_lo(w.y); v[h][3] = bf_hi(w.y); v[h][4] = bf_lo(w.z); v[h][5] = bf_hi(w.z); v[h][6] = bf_lo(w.w); v[h][7] = bf_hi(w.w); }
    if (ADD_Y) {
        const bf16* yb = (row < T_ / 2) ? y0 + (size_t)row * 8 * 1024 : y1 + (size_t)(row - T_ / 2) * 8 * 1024;
#pragma unroll
        for (int k = 0; k < 8; ++k)
#pragma unroll
            for (int h = 0; h < 2; ++h) { const v4u w = *(const v4u*)(yb + (size_t)k * 1024 + 512 * h + lane_ * 8);
                v[h][0] += bf_lo(w.x); v[h][1] += bf_hi(w.x); v[h][2] += bf_lo(w.y); v[h][3] += bf_hi(w.y); v[h][4] += bf_lo(w.z); v[h][5] += bf_hi(w.z); v[h][6] += bf_lo(w.w); v[h][7] += bf_hi(w.w); }
    }
    float s = 0.f;
#pragma unroll
    for (int h = 0; h < 2; ++h)
#pragma unroll
        for (int i = 0; i < 8; ++i) s += v[h][i];
    const float mean = wave_sum(s) * (1.f / D_); float s2 = 0.f;
#pragma unroll
    for (int h = 0; h < 2; ++h)
#pragma unroll
        for (int i = 0; i < 8; ++i) { v[h][i] -= mean; s2 += v[h][i] * v[h][i]; }
    const float rstd = 1.f / sqrtf(wave_sum(s2) * (1.f / D_) + LN_EPS_);
#pragma unroll
    for (int h = 0; h < 2; ++h) { const int c0 = 512 * h + lane_ * 8;
        const f32x4 g0 = *(const f32x4*)(gam + c0), g1 = *(const f32x4*)(gam + c0 + 4), b0 = *(const f32x4*)(bet + c0), b1 = *(const f32x4*)(bet + c0 + 4);
        f32x4 o0, o1; o0.x = v[h][0] * rstd * g0.x + b0.x; o0.y = v[h][1] * rstd * g0.y + b0.y; o0.z = v[h][2] * rstd * g0.z + b0.z; o0.w = v[h][3] * rstd * g0.w + b0.w;
        o1.x = v[h][4] * rstd * g1.x + b1.x; o1.y = v[h][5] * rstd * g1.y + b1.y; o1.z = v[h][6] * rstd * g1.z + b1.z; o1.w = v[h][7] * rstd * g1.w + b1.w;
        if (WRITE_F32) { *(f32x4*)(dst + (size_t)row * D_ + c0) = o0; *(f32x4*)(dst + (size_t)row * D_ + c0 + 4) = o1; }
        if (WRITE_BF) { v4u w; w.x = cvt_pk_bf16(o0.x, o0.y); w.y = cvt_pk_bf16(o0.z, o0.w); w.z = cvt_pk_bf16(o1.x, o1.y); w.w = cvt_pk_bf16(o1.z, o1.w); *(v4u*)(dstb + (size_t)row * D_ + c0) = w; } }
}

__device__ __forceinline__ void ln2_row(Frame& F, const bf16* src, bf16* dstb, const float* gam, const float* bet, const unsigned char* y8, int row) {
    const int lane_ = lane_id(); const int c0 = lane_ * 16;
    float v[16];
    { const v4u a = *(const v4u*)(src + (size_t)row * D_ + c0), b = *(const v4u*)(src + (size_t)row * D_ + c0 + 8);
      v[0] = bf_lo(a.x); v[1] = bf_hi(a.x); v[2] = bf_lo(a.y); v[3] = bf_hi(a.y); v[4] = bf_lo(a.z); v[5] = bf_hi(a.z); v[6] = bf_lo(a.w); v[7] = bf_hi(a.w);
      v[8] = bf_lo(b.x); v[9] = bf_hi(b.x); v[10] = bf_lo(b.y); v[11] = bf_hi(b.y); v[12] = bf_lo(b.z); v[13] = bf_hi(b.z); v[14] = bf_lo(b.w); v[15] = bf_hi(b.w); }
    v4u yw[8];
#pragma unroll
    for (int k = 0; k < 8; ++k) yw[k] = *(const v4u*)(y8 + ((size_t)row * 8 + k) * 1024 + c0);
#pragma unroll
    for (int k = 0; k < 8; ++k) { const unsigned wv[4] = {yw[k].x, yw[k].y, yw[k].z, yw[k].w};
#pragma unroll
        for (int q = 0; q < 4; ++q) { const f32x2 a = __builtin_amdgcn_cvt_pk_f32_fp8((int)wv[q], false), b = __builtin_amdgcn_cvt_pk_f32_fp8((int)wv[q], true);
            v[4 * q + 0] += a.x; v[4 * q + 1] += a.y; v[4 * q + 2] += b.x; v[4 * q + 3] += b.y; } }
    float s = 0.f;
#pragma unroll
    for (int i = 0; i < 16; ++i) s += v[i];
    const float mean = wave_sum(s) * (1.f / D_); float s2 = 0.f;
#pragma unroll
    for (int i = 0; i < 16; ++i) { v[i] -= mean; s2 += v[i] * v[i]; }
    const float rstd = 1.f / sqrtf(wave_sum(s2) * (1.f / D_) + LN_EPS_);
    float o[16];
#pragma unroll
    for (int q = 0; q < 4; ++q) { const f32x4 g = *(const f32x4*)(gam + c0 + 4 * q), bb = *(const f32x4*)(bet + c0 + 4 * q);
        o[4 * q] = v[4 * q] * rstd * g.x + bb.x; o[4 * q + 1] = v[4 * q + 1] * rstd * g.y + bb.y; o[4 * q + 2] = v[4 * q + 2] * rstd * g.z + bb.z; o[4 * q + 3] = v[4 * q + 3] * rstd * g.w + bb.w; }
    v4u w0, w1; w0.x = cvt_pk_bf16(o[0], o[1]); w0.y = cvt_pk_bf16(o[2], o[3]); w0.z = cvt_pk_bf16(o[4], o[5]); w0.w = cvt_pk_bf16(o[6], o[7]);
    w1.x = cvt_pk_bf16(o[8], o[9]); w1.y = cvt_pk_bf16(o[10], o[11]); w1.z = cvt_pk_bf16(o[12], o[13]); w1.w = cvt_pk_bf16(o[14], o[15]);
    *(v4u*)(dstb + (size_t)row * D_ + c0) = w0; *(v4u*)(dstb + (size_t)row * D_ + c0 + 8) = w1;
}

__device__ __forceinline__ void p_route(Frame& F, const float* router_bias) {
    const int lane_ = lane_id(), tid_ = F.wave * 64 + lane_; (void)tid_;
    LAS unsigned* hist = (LAS unsigned*)(F.lds + LX_HIST);
    const float* logits = (const float*)(F.ws + WS_LOGITS);
    int* topi = (int*)(F.ws + WS_TOPI); float* topw = (float*)(F.ws + WS_TOPW); int* lrank = (int*)(F.ws + WS_LRANK);
    unsigned* gcount = (unsigned*)(F.ws + WS_GCOUNT); unsigned* wgbase = (unsigned*)(F.ws + WS_WGBASE);
    { int* row_tok = (int*)(F.ws + WS_ROWTOK); int* row_dst = (int*)(F.ws + WS_ROWDST); float* row_w = (float*)(F.ws + WS_ROWW);
      for (int i = blockIdx.x * 512 + tid_; i < RMAX_; i += F.G * 512) { row_tok[i] = 0; row_dst[i] = -1; row_w[i] = 0.f; } }
    if (tid_ < 256) hist[tid_] = 0u;
    __syncthreads();
    const int lane = lane_;
    const f32x4 bias = *(const f32x4*)(router_bias + lane * 4);
    constexpr int NTK = 4;
    const int tstride = F.G * 8;
    for (int tok0 = blockIdx.x * 8 + F.wave; tok0 < T_; tok0 += NTK * tstride) {
        float sc[NTK][4], c[NTK][4]; bool live[NTK];
#pragma unroll
        for (int t = 0; t < NTK; ++t) { const int tok = tok0 + t * tstride; live[t] = tok < T_; const f32x4 lg = *(const f32x4*)(logits + (size_t)(live[t] ? tok : tok0) * 256 + lane * 4);
            sc[t][0] = sigmoidf_(lg.x); sc[t][1] = sigmoidf_(lg.y); sc[t][2] = sigmoidf_(lg.z); sc[t][3] = sigmoidf_(lg.w);
            c[t][0] = sc[t][0] + bias.x; c[t][1] = sc[t][1] + bias.y; c[t][2] = sc[t][2] + bias.z; c[t][3] = sc[t][3] + bias.w; }
        float a1[NTK], a2[NTK];
#pragma unroll
        for (int t = 0; t < NTK; ++t) { a1[t] = fmaxf(c[t][0], c[t][1]); a2[t] = fminf(c[t][0], c[t][1]); const float b1 = fmaxf(c[t][2], c[t][3]), b2 = fminf(c[t][2], c[t][3]); const float n1 = fmaxf(a1[t], b1), n2 = fmaxf(fminf(a1[t], b1), fmaxf(a2[t], b2)); a1[t] = n1; a2[t] = n2; }
#pragma unroll
        for (int off = 1; off < 8; off <<= 1)
#pragma unroll
            for (int t = 0; t < NTK; ++t) { const float b1 = __shfl_xor(a1[t], off), b2 = __shfl_xor(a2[t], off); const float n1 = fmaxf(a1[t], b1), n2 = fmaxf(fminf(a1[t], b1), fmaxf(a2[t], b2)); a1[t] = n1; a2[t] = n2; }
        const int g = lane >> 3;
        int rank[NTK];
#pragma unroll
        for (int t = 0; t < NTK; ++t) rank[t] = 0;
#pragma unroll
        for (int j = 0; j < 8; ++j)
#pragma unroll
            for (int t = 0; t < NTK; ++t) { const float gs = a1[t] + a2[t]; const float sj = __shfl(gs, j * 8); rank[t] += (sj > gs || (sj == gs && j < g)) ? 1 : 0; }
#pragma unroll
        for (int t = 0; t < NTK; ++t) if (rank[t] >= 4) { c[t][0] = -INFINITY; c[t][1] = -INFINITY; c[t][2] = -INFINITY; c[t][3] = -INFINITY; }
        int ridx[NTK]; float rs[NTK];
#pragma unroll
        for (int t = 0; t < NTK; ++t) { ridx[t] = 0; rs[t] = 0.f; }
#pragma unroll
        for (int k = 0; k < 8; ++k) {
            float v[NTK]; int ix[NTK];
#pragma unroll
            for (int t = 0; t < NTK; ++t) { float bv = c[t][0]; int bi = 0; if (c[t][1] > bv) { bv = c[t][1]; bi = 1; } if (c[t][2] > bv) { bv = c[t][2]; bi = 2; } if (c[t][3] > bv) { bv = c[t][3]; bi = 3; } v[t] = bv; ix[t] = lane * 4 + bi; }
#pragma unroll
            for (int off = 1; off < 64; off <<= 1)
#pragma unroll
                for (int t = 0; t < NTK; ++t) { const float ov = __shfl_xor(v[t], off); const int oi = __shfl_xor(ix[t], off); if (ov > v[t] || (ov == v[t] && oi < ix[t])) { v[t] = ov; ix[t] = oi; } }
#pragma unroll
            for (int t = 0; t < NTK; ++t) { const int ol = ix[t] >> 2, oj = ix[t] & 3;
                const float ssel = (oj == 0) ? sc[t][0] : (oj == 1) ? sc[t][1] : (oj == 2) ? sc[t][2] : sc[t][3];
                const float sv = __shfl(ssel, ol);
                if (lane == ol) { if (oj == 0) c[t][0] = -INFINITY; else if (oj == 1) c[t][1] = -INFINITY; else if (oj == 2) c[t][2] = -INFINITY; else c[t][3] = -INFINITY; }
                if (lane == k) { ridx[t] = ix[t]; rs[t] = sv; } }
        }
#pragma unroll
        for (int t = 0; t < NTK; ++t) { const int tok = tok0 + t * tstride;
            float sum = (lane < 8) ? rs[t] : 0.f; sum += __shfl_xor(sum, 1); sum += __shfl_xor(sum, 2); sum += __shfl_xor(sum, 4);
            if (lane < 8 && live[t]) { const float w = rs[t] / sum * ROUTED_SCALE_;
                topi[tok * 8 + lane] = ridx[t]; topw[tok * 8 + lane] = w;
                const unsigned lr = __hip_atomic_fetch_add(&hist[ridx[t]], 1u, __ATOMIC_RELAXED, __HIP_MEMORY_SCOPE_WORKGROUP);
                lrank[tok * 8 + lane] = (int)lr; } }
    }
    __syncthreads();
    if (tid_ < 256) { const unsigned hc = hist[tid_]; const unsigned base = __hip_atomic_fetch_add(gcount + tid_, hc, RLX_AGENT); wgbase[blockIdx.x * 256 + tid_] = base; }
}
__device__ __forceinline__ void p_assign(Frame& F) {
    const int lane_ = lane_id(), tid_ = F.wave * 64 + lane_; (void)tid_;
    moe_tables(F);
    LAS unsigned* PST = (LAS unsigned*)(F.lds + LX_PST);
    const int* topi = (const int*)(F.ws + WS_TOPI); const float* topw = (const float*)(F.ws + WS_TOPW); const int* lrank = (const int*)(F.ws + WS_LRANK);
    const unsigned* wgbase = (const unsigned*)(F.ws + WS_WGBASE);
    int* row_tok = (int*)(F.ws + WS_ROWTOK); int* row_dst = (int*)(F.ws + WS_ROWDST); float* row_w = (float*)(F.ws + WS_ROWW);
    for (int tok = blockIdx.x * 8 + F.wave; tok < T_; tok += F.G * 8) {
        if (lane_ < 8) { const int e = topi[tok * 8 + lane_]; const unsigned slot = PST[e] + wgbase[blockIdx.x * 256 + e] + (unsigned)lrank[tok * 8 + lane_];
            row_tok[slot] = tok; row_dst[slot] = tok * 8 + lane_; row_w[slot] = topw[tok * 8 + lane_]; }
    }
}

__global__ void __launch_bounds__(NWAVES * 64, 2) fwd_kernel(Args args) {
    extern __shared__ __attribute__((aligned(16))) unsigned char lds[];
    Frame F;
    F.lds = (LAS unsigned char*)lds;
    F.MISC = (volatile LAS unsigned*)(F.lds + MISC_OFF);
    F.wave = __builtin_amdgcn_readfirstlane((int)threadIdx.x >> 6);
    F.G = gridDim.x; { const int bx = blockIdx.x; F.vcu = (F.G % 8 == 0) ? (bx % 8) * (F.G / 8) + bx / 8 : bx; }
    F.ws = args.ws; F.out = args.out;
    F.ctl = (gu32*)(args.ws + WS_CTL);
    unsigned char* ws = args.ws;
    { const int tid_ = F.wave * 64 + lane_id(); for (int u = tid_; u < (LDS_BYTES - LDSCTL_OFF) / 4; u += NWAVES * 64) ((LAS unsigned*)(F.lds + LDSCTL_OFF))[u] = 0u; }
    __syncthreads();
    XcdBarrier bar; bar.bar = (unsigned*)(F.ctl + CW_BAR); bar.x = 0; bar.st = nullptr;
    if (N_LAUNCHES == 1) bar = xcd_barrier_post((unsigned*)(F.ctl + CW_BAR), F.MISC + 8, F.wave);
#define GRID_BAR() do { if (N_LAUNCHES == 1) xcd_barrier(bar, F.wave); } while (0)
    const int lo = args.ph_lo, hi = args.ph_hi;
#ifndef MK_PHMASK
#define MK_PHMASK 0x7fff
#endif
#ifndef MK_DOUBLE
#define MK_DOUBLE -1
#endif
#define REP(k) _Pragma("unroll") for (int rep_ = 0; rep_ < ((MK_DOUBLE) == (k) ? 2 : 1); ++rep_)
#define IN(k) ((((MK_PHMASK) >> (k)) & 1) && lo <= (k) && (k) < hi)
#define BOTH(k) (IN(k) && IN((k) + 1))
    bf16* S6 = (bf16*)(ws + WS_S6);
    float* X1 = args.out;
    bf16* TB = (bf16*)args.out;

    REP(0) if (IN(0)) { p0_prologue(F, args); if (BOTH(0)) GRID_BAR(); }

    REP(1) if (IN(1)) {
        pg8::DenseOrder S; S.init(ws + WS_XB, ws + WS_WIN, T_, INW_, D_, F.G, (int)blockIdx.x);
        EpiZ E{S6, (bf16*)(ws + WS_G), (const float*)(ws + WS_ROPE), (float*)(ws + WS_KMEAN)};
        pg8::gemm_phase<EpiZ, pg8::DenseOrder, true>(F.lds + RING_OFF, D_, S, E, F.wave);
        if (BOTH(1)) GRID_BAR();
    }
    if (IN(2)) { p_conv(F, args.in[3]); p_select(F); if (BOTH(2)) GRID_BAR(); }

    REP(3) if (IN(3)) {
        const AttnOrder S{F.vcu};
        int bh, qb;
        for (int i = 0; S.next(i, bh, qb); ++i)
            attn_body::attn_unit<8>(bh >> 3, bh & 7, qb, (const attn_body::bf16*)S6, (const attn_body::bf16*)(S6 + (size_t)T_ * 512), (const attn_body::bf16*)(S6 + (size_t)2 * T_ * 512),
                                    (attn_body::bf16*)(ws + WS_LOGITS), (const unsigned*)(ws + WS_SEL), (char*)lds + RING_OFF, F.wave);
        if (BOTH(3)) GRID_BAR();
    }
    REP(4) if (IN(4)) {
        { pg8::DenseOrder S; S.init(ws + WS_LOGITS, ws + WS_WAO, T_, D_, AW_, F.G, (int)blockIdx.x);
#ifdef MK_P4A_PLAIN
          EpiBf16Plain E{(bf16*)(ws + WS_P1), D_};
          pg8::gemm_phase<EpiBf16Plain, pg8::DenseOrder, true>(F.lds + RING_OFF, AW_, S, E, F.wave); }
#else
          EpiGate<false> E{(bf16*)(ws + WS_P1), (const bf16*)(ws + WS_G)};
          pg8::gemm_phase<EpiGate<false>, pg8::DenseOrder, true>(F.lds + RING_OFF, AW_, S, E, F.wave); }
#endif
        VM_WAIT(); __syncthreads();
#ifndef MK_SKIP_P4B
        { pg8::DenseOrder S; S.init(S6 + (size_t)3 * T_ * 512, ws + WS_WCO, T_, D_, CW_, F.G, (int)blockIdx.x);
          EpiGate<true> E{(bf16*)(ws + WS_P1), (const bf16*)(ws + WS_G) + (size_t)T_ * 1024};
          pg8::gemm_phase<EpiGate<true>, pg8::DenseOrder, true>(F.lds + RING_OFF, CW_, S, E, F.wave); }
#endif
        if (BOTH(4)) GRID_BAR();
    }
    REP(5) if (IN(5)) {
        pg8::DenseOrder S; S.init(ws + WS_P1, ws + WS_WOUT, T_, D_, D_, F.G, (int)blockIdx.x);
        EpiRes<false> E{TB, args.in[0]};
        pg8::gemm_phase<EpiRes<false>, pg8::DenseOrder, true>(F.lds + RING_OFF, D_, S, E, F.wave);
        if (BOTH(5)) GRID_BAR();
    }
    REP(6) if (IN(6)) {
        const int gw = F.vcu * NWAVES + F.wave, NGW = F.G * NWAVES;
        for (int m = gw; m < T_; m += NGW) ln_row<false, false, true>(F, TB, nullptr, (bf16*)(ws + WS_XB), args.in[7], args.in[8], nullptr, nullptr, m);
        if (BOTH(6)) GRID_BAR();
    }
    REP(7) if (IN(7)) {
        { pg8::DenseOrder S; S.init(ws + WS_XB, ws + WS_WSR, T_, 768, D_, F.G, (int)blockIdx.x);
          EpiShRouter E{(bf16*)(ws + WS_HS), (float*)(ws + WS_LOGITS)};
          pg8::gemm_phase<EpiShRouter, pg8::DenseOrder, true>(F.lds + RING_OFF, D_, S, E, F.wave); }
        { pg8::DenseOrder S; S.init(ws + WS_PB, ws + WS_WPP, T_, D_, PLE_, F.G, (int)blockIdx.x);
          EpiBf16Plain E{(bf16*)(ws + WS_PP), D_};
          pg8::gemm_phase<EpiBf16Plain, pg8::DenseOrder, true>(F.lds + RING_OFF, PLE_, S, E, F.wave); }
        if (BOTH(7)) GRID_BAR();
    }
    if (IN(8)) {
        p_route(F, args.in[10]);
        { pg8::DenseOrder S; S.init(ws + WS_HS, ws + WS_WSD, T_, D_, 256, F.G, (int)blockIdx.x);
          EpiRes<true> E{TB, (const void*)(ws + WS_XB)};
          pg8::gemm_phase<EpiRes<true>, pg8::DenseOrder, true>(F.lds + RING_OFF, 256, S, E, F.wave); }
        if (BOTH(8)) GRID_BAR();
    }
    if (IN(9)) { p_assign(F); if (BOTH(9)) GRID_BAR(); }

    REP(10) if (IN(10)) {
        moe_tables(F);
        MoeUpOrder S{(const LAS unsigned short*)(F.lds + LX_BLKE), (const LAS unsigned*)(F.lds + LX_XS), (const int*)(ws + WS_ROWTOK), (const char*)(ws + WS_XB), (const char*)(ws + WS_WGU), F.G >= 8 ? F.G / 8 : 1, F.vcu};
        EpiMoeUp E{(bf16*)(ws + WS_H)};
        pg8::gemm_phase<EpiMoeUp, MoeUpOrder, true>(F.lds + RING_OFF, D_, S, E, F.wave);
        if (BOTH(10)) GRID_BAR();
    }
    REP(11) if (IN(11)) {
        moe_tables(F);
        MoeDownOrder S{(const LAS unsigned short*)(F.lds + LX_BLKE), (const LAS unsigned*)(F.lds + LX_XS), (const char*)(ws + WS_H), (const char*)(ws + WS_WD), F.G >= 8 ? F.G / 8 : 1, F.vcu};
        EpiMoeDown E{(unsigned char*)(ws + WS_YLO), (const int*)(ws + WS_ROWDST), (const float*)(ws + WS_ROWW)};
        pg8::gemm_phase<EpiMoeDown, MoeDownOrder, true>(F.lds + RING_OFF, 256, S, E, F.wave);
#ifdef MK_P11_NULL
        { EpiNull E0; pg8::gemm_phase<EpiNull, MoeDownOrder, true>(F.lds + RING_OFF, 256, S, E0, F.wave); }
#endif
        if (BOTH(11)) GRID_BAR();
    }
    REP(12) if (IN(12)) {
        const int gw = F.vcu * NWAVES + F.wave, NGW = F.G * NWAVES;
        for (int m = gw; m < T_; m += NGW) ln2_row(F, TB, (bf16*)(ws + WS_XB), args.in[17], args.in[18], (const unsigned char*)(ws + WS_YLO), m);
        if (BOTH(12)) GRID_BAR();
    }
    REP(13) if (IN(13)) {
        pg8::DenseOrder S; S.init(ws + WS_XB, ws + WS_WPG, T_, D_, D_, F.G, (int)blockIdx.x);
        EpiPle E{(bf16*)(ws + WS_H), (const bf16*)(ws + WS_XB), (const bf16*)(ws + WS_PP)};
        pg8::gemm_phase<EpiPle, pg8::DenseOrder, true>(F.lds + RING_OFF, D_, S, E, F.wave);
        if (BOTH(13)) GRID_BAR();
    }
    REP(14) if (IN(14)) {
        const int gw = F.vcu * NWAVES + F.wave, NGW = F.G * NWAVES;
        for (int m = gw; m < T_; m += NGW) ln_row<false, true, false>(F, (const bf16*)(ws + WS_H), X1, nullptr, args.in[21], args.in[22], nullptr, nullptr, m);
    }
#if defined(MK_DBG_OFF)
    if (lo <= 14 && 14 < hi) { const int lane_ = lane_id(), tid_ = F.wave * 64 + lane_; const bf16* src = (const bf16*)(ws + (size_t)(MK_DBG_OFF));
        for (size_t i = (size_t)F.vcu * 512 + tid_; i < (size_t)T_ * D_ / 8; i += (size_t)F.G * 512) { const v4u w = *(const v4u*)(src + (i % (size_t)(MK_DBG_WRAP)) * 8);
            f32x4 a, b; a.x = bf_lo(w.x); a.y = bf_hi(w.x); a.z = bf_lo(w.y); a.w = bf_hi(w.y); b.x = bf_lo(w.z); b.y = bf_hi(w.z); b.z = bf_lo(w.w); b.w = bf_hi(w.w);
            *(f32x4*)(args.out + i * 8) = a; *(f32x4*)(args.out + i * 8 + 4) = b; } }
#endif
#undef IN
#undef BOTH
#undef GRID_BAR
}

extern "C" void kernel_launch(void* const* d_in, const int* in_sizes, int n_in, void* d_out, int out_size, void* d_ws, size_t ws_size, hipStream_t stream) {
    static int grid = 0;
    if (grid == 0) {
        if (n_in != 23 || in_sizes[0] != T_ * D_ || out_size != T_ * D_ || ws_size < WS_END) { fprintf(stderr, "kernel_launch: unexpected shapes (n_in %d, in0 %d, out %d, ws %zu); nothing launched\n", n_in, n_in > 0 ? in_sizes[0] : -1, out_size, ws_size); grid = -1; return; }
        int dev = 0, cus = 0, per_cu = 0;
        if (hipGetDevice(&dev) != hipSuccess || hipDeviceGetAttribute(&cus, hipDeviceAttributeMultiprocessorCount, dev) != hipSuccess) { fprintf(stderr, "kernel_launch: device query failed\n"); grid = -1; return; }
        if (hipFuncSetAttribute((const void*)fwd_kernel, hipFuncAttributeMaxDynamicSharedMemorySize, LDS_BYTES) != hipSuccess) { fprintf(stderr, "kernel_launch: hipFuncSetAttribute failed\n"); grid = -1; return; }
        if (hipOccupancyMaxActiveBlocksPerMultiprocessor(&per_cu, (const void*)fwd_kernel, NWAVES * 64, LDS_BYTES) != hipSuccess || per_cu < 1)
            fprintf(stderr, "kernel_launch: note: occupancy query reports %d workgroups per CU\n", per_cu);
        (void)hipGetLastError();
        grid = cus;
    }
    if (grid < 0) return;
    if (hipMemsetAsync((char*)d_ws + WS_CTL, 0, CTL_ZERO_BYTES, stream) != hipSuccess) { fprintf(stderr, "kernel_launch: memset failed\n"); return; }
    Args a{};
    for (int i = 0; i < 23; ++i) a.in[i] = (const float*)d_in[i];
    a.out = (float*)d_out; a.ws = (unsigned char*)d_ws; a.pad = 0;
    for (int li = 0; li < N_LAUNCHES; ++li) {
        a.ph_lo = (N_LAUNCHES == 1) ? 0 : li; a.ph_hi = (N_LAUNCHES == 1) ? NPH : li + 1; a.li = li;
        hipLaunchKernelGGL(fwd_kernel, dim3(grid), dim3(NWAVES * 64), LDS_BYTES, stream, a);
        const hipError_t le = hipPeekAtLastError();
        if (le != hipSuccess) { fprintf(stderr, "kernel_launch: launch %d failed: %s\n", li, hipGetErrorName(le)); break; }
    }
}
```

```cpp
#include <hip/hip_runtime.h>
#include <hip/hip_bf16.h>
#include <cstdio>
#include <cstdint>
#include <cmath>

#ifndef MK_N_LAUNCHES
#define MK_N_LAUNCHES 1
#endif

constexpr int NB_ = 8, SEQ_ = 4096, T_ = NB_ * SEQ_, D_ = 1024;
constexpr int NH_ = 8, HD_ = 64, AW_ = 512, CW_ = 512, INW_ = 5120;
constexpr int NE_ = 256, ED_ = 256, TOPK_ = 8, PLE_ = 256;
constexpr int NBLK_ = 16;
constexpr float LN_EPS_ = 1e-5f;
constexpr float DN_ALPHA_ = 1.189207115002721f;
constexpr float ROUTED_SCALE_ = 2.5f;
constexpr int RMAX_ = T_ * TOPK_ + NE_ * 256;

#define GAS __attribute__((address_space(1)))
#define LAS __attribute__((address_space(3)))
typedef unsigned short bf16;
typedef unsigned v4u __attribute__((ext_vector_type(4)));
typedef float f32x4 __attribute__((ext_vector_type(4)));
typedef float f32x2 __attribute__((ext_vector_type(2)));
typedef unsigned u32x2 __attribute__((ext_vector_type(2)));
typedef short bf16x8 __attribute__((ext_vector_type(8)));
typedef GAS unsigned gu32;
#define RLX_AGENT __ATOMIC_RELAXED, __HIP_MEMORY_SCOPE_AGENT
#define LDS_WAIT() asm volatile("s_waitcnt lgkmcnt(0)" ::: "memory")
#define VM_WAIT() asm volatile("s_waitcnt vmcnt(0)" ::: "memory")

typedef float cvt_f32x2_t __attribute__((ext_vector_type(2))); typedef __bf16 cvt_bf16x2_t __attribute__((ext_vector_type(2)));
__device__ __forceinline__ unsigned cvt_pk_bf16(float lo, float hi) { cvt_f32x2_t v = {lo, hi}; cvt_bf16x2_t b = __builtin_convertvector(v, cvt_bf16x2_t); return __builtin_bit_cast(unsigned, b); }
__device__ __forceinline__ float bf_lo(unsigned w) { return __builtin_bit_cast(float, w << 16); }
__device__ __forceinline__ float bf_hi(unsigned w) { return __builtin_bit_cast(float, w & 0xffff0000u); }
__device__ __forceinline__ int lane_id() { unsigned ones = ~0u; asm volatile("" : "+s"(ones)); return (int)__builtin_amdgcn_mbcnt_hi(ones, __builtin_amdgcn_mbcnt_lo(ones, 0u)); }
__device__ __forceinline__ float sigmoidf_(float x) { return __builtin_amdgcn_rcpf(1.0f + __builtin_amdgcn_exp2f(-1.4426950408889634f * x)); }

namespace pg8 {
#define PG8_LAS __attribute__((address_space(3)))
constexpr int BM = 256, BK = 64, HALF = 128, HTB = HALF * BK * 2  , STAGE_BYTES = 8 * HTB, NXCD = 8, WGM = 8;

__host__ __device__ __forceinline__ int lds_byte(int r, int c) { const int st = (r >> 4) * 2 + (c >> 5), rr = r & 15, cc = c & 31, ob = rr * 64 + cc * 2; return st * 1024 + (ob ^ (((ob >> 9) & 1) << 5)); }
__host__ __device__ __forceinline__ void stage_rc(int b, int& R, int& C) { const int st = b / 1024, sb = b % 1024, swz = sb ^ (((sb >> 9) & 1) << 5); R = (st >> 1) * 16 + swz / 64; C = (st & 1) * 32 + (swz % 64) / 2; }
__host__ __device__ __forceinline__ int perm32(int rho) { const int n = rho >> 4, i = rho & 15; return 8 * (i >> 2) + 4 * n + (i & 3); }

struct Unit { const char* a; const char* b; int row0, pn, e; };

struct DenseOrder {
    const char* A; const char* Bt; int K, nM, nN, nwg, G, c;
    static constexpr bool GATHER = false;
    __device__ __forceinline__ void init(const void* A_, const void* Bt_, int M, int N, int K_, int G_, int c_) { A = (const char*)A_; Bt = (const char*)Bt_; K = K_; nM = M / BM; nN = N / BM; nwg = nM * nN; G = G_; c = c_; }
    __device__ __forceinline__ bool next(int i, Unit& u) const {
        const long L = (long)i * G + c; if (L >= nwg) return false;
        int wgid = (int)L; { const int q = nwg / NXCD, r = nwg % NXCD, xcd = wgid % NXCD, off = wgid / NXCD; wgid = (xcd < r ? xcd * (q + 1) : r * (q + 1) + (xcd - r) * q) + off; }
        const int nig = WGM * nN, gid = wgid / nig, fm = gid * WGM, gsz = (nM - fm) < WGM ? (nM - fm) : WGM;
        const int pm = fm + ((wgid % nig) % gsz); int pn = (wgid % nig) / gsz;
#ifdef MK_REV_PN
        if (nN == 20) pn = 19 - pn;
#endif
        u.a = A + (size_t)pm * BM * K * 2; u.b = Bt + (size_t)pn * BM * K * 2; u.row0 = pm * BM; u.pn = pn; u.e = 0; return true;
    }
};

template <class Epi, class Sched, bool ALIGN_EPI>
__device__ __forceinline__ void gemm_phase(PG8_LAS unsigned char* lds, const int K, const Sched& S, const Epi& E, const int wid) {
    const int lane = lane_id(), tid = wid * 64 + lane, wr = wid >> 2, wc = wid & 3, fr = lane & 15, fq = lane >> 4;
    const int nt = K / BK;
    constexpr int NVA = Sched::GATHER ? 2 : 1;
    unsigned voffA[NVA][2], voffB[2];
#pragma unroll
    for (int i = 0; i < 2; ++i) { int R, C; stage_rc(tid * 16 + i * 8192, R, C); static_assert(Epi::PERM, "all epilogues use the permuted layout");
        voffB[i] = (unsigned)((64 * (R >> 5) + perm32(R & 31)) * K + C) * 2u;
        if constexpr (!Sched::GATHER) voffA[0][i] = (unsigned)(R * K + C) * 2u; }
    const size_t kstep = (size_t)(BK * 2);
    const size_t hstep = (size_t)32 * K * 2;
    const size_t hstepA = Sched::GATHER ? 0 : (size_t)HALF * K * 2;
    const unsigned ldsw = (unsigned)wid * 1024u;
    const int aoff = lds_byte(wr * 64 + fr, fq * 8), boff = lds_byte(wc * 32 + fr, fq * 8);
#define PG8_SA(b, h) (((b) * 2 + (h)) * HTB)
#define PG8_SB(b, h) ((4 + (b) * 2 + (h)) * HTB)
#define PG8_STAGE(bufoff, gbase, voff) do { _Pragma("unroll") for (int _i = 0; _i < 2; ++_i) \
        __builtin_amdgcn_global_load_lds((const unsigned*)((const char*)(gbase) + (voff)[_i]), (PG8_LAS unsigned*)(lds + (bufoff) + ldsw + _i * 8192), 16, 0, 0); } while (0)
#define PG8_LDA(dst, b, h) do { _Pragma("unroll") for (int m = 0; m < 4; ++m) _Pragma("unroll") for (int k = 0; k < 2; ++k) dst[m][k] = *(const PG8_LAS bf16x8*)(lds + PG8_SA(b, h) + aoff + m * 2048 + k * 1024); } while (0)
#define PG8_LDB(dst, b, h) do { _Pragma("unroll") for (int n = 0; n < 2; ++n) _Pragma("unroll") for (int k = 0; k < 2; ++k) dst[n][k] = *(const PG8_LAS bf16x8*)(lds + PG8_SB(b, h) + boff + n * 2048 + k * 1024); } while (0)
#define PG8_MMA(ai, bj, At, Bt) do { __builtin_amdgcn_s_setprio(1); _Pragma("unroll") for (int m = 0; m < 4; ++m) _Pragma("unroll") for (int n = 0; n < 2; ++n) _Pragma("unroll") for (int k = 0; k < 2; ++k) \
        acc[ai][bj][m][n] = __builtin_amdgcn_mfma_f32_16x16x32_bf16(Bt[n][k], At[m][k], acc[ai][bj][m][n], 0, 0, 0); __builtin_amdgcn_s_setprio(0); } while (0)
#ifdef MK_DRAIN
#define PG8_WAIT_V(n) asm volatile("s_waitcnt vmcnt(0)" ::: "memory")
#else
#define PG8_WAIT_V(n) asm volatile("s_waitcnt vmcnt(" #n ")" ::: "memory")
#endif
#define PG8_WAIT_L(n) asm volatile("s_waitcnt lgkmcnt(" #n ")" ::: "memory")
#define PG8_BAR __builtin_amdgcn_s_barrier()
#define PG8_SCHED __builtin_amdgcn_sched_barrier(0)
    Unit cur, nxt; int ui = 0;
    if (!S.next(0, cur)) return;
    if constexpr (Sched::GATHER) S.aoff(cur, tid, voffA);
    f32x4 acc[2][2][4][2];
#pragma unroll
    for (int a = 0; a < 2; ++a)
#pragma unroll
        for (int b = 0; b < 2; ++b)
#pragma unroll
            for (int m = 0; m < 4; ++m)
#pragma unroll
                for (int n = 0; n < 2; ++n) acc[a][b][m][n] = (f32x4){0.f, 0.f, 0.f, 0.f};
    bf16x8 At[4][2], B0[2][2], B1[2][2];
    PG8_STAGE(PG8_SB(0, 0), cur.b, voffB); PG8_STAGE(PG8_SB(0, 1), cur.b + hstep, voffB); PG8_STAGE(PG8_SA(0, 0), cur.a, voffA[0]); PG8_STAGE(PG8_SA(0, 1), cur.a + hstepA, voffA[NVA - 1]);
    if (wr == 1) PG8_BAR;
    PG8_WAIT_V(2); PG8_BAR;
    PG8_STAGE(PG8_SB(1, 0), cur.b + kstep, voffB); PG8_STAGE(PG8_SA(1, 0), cur.a + kstep, voffA[0]); PG8_STAGE(PG8_SB(1, 1), cur.b + hstep + kstep, voffB);
    PG8_WAIT_V(6); PG8_BAR;
    for (;;) {
        const bool has_next = S.next(ui + 1, nxt);
        const char* nA = has_next ? nxt.a : cur.a; const char* nB = has_next ? nxt.b : cur.b;
#pragma nounroll
        for (int t = 0; t < nt; t += 2) {
            const bool last = (t == nt - 2);
            const char* a1 = cur.a + (size_t)(t + 1) * kstep;
            const char* a2 = last ? nA : cur.a + (size_t)(t + 2) * kstep; const char* b2 = last ? nB : cur.b + (size_t)(t + 2) * kstep;
            const char* a3 = a2 + kstep; const char* b3 = b2 + kstep;
            PG8_LDB(B0, 0, 0); PG8_LDB(B1, 0, 1); PG8_SCHED; PG8_LDA(At, 0, 0); PG8_STAGE(PG8_SA(1, 1), a1 + hstepA, voffA[NVA - 1]);
            if constexpr (Sched::GATHER) { if (last && has_next) S.aoff(nxt, tid, voffA); }
            PG8_WAIT_V(8); PG8_WAIT_L(0); PG8_BAR; PG8_MMA(0, 0, At, B0); PG8_MMA(0, 1, At, B1); PG8_BAR; PG8_SCHED;
            PG8_LDA(At, 0, 1); PG8_STAGE(PG8_SB(0, 0), b2, voffB); PG8_STAGE(PG8_SB(0, 1), b2 + hstep, voffB); PG8_STAGE(PG8_SA(0, 0), a2, voffA[0]);
            PG8_WAIT_V(8); PG8_WAIT_L(0); PG8_BAR; PG8_MMA(1, 0, At, B0); PG8_MMA(1, 1, At, B1); PG8_BAR; PG8_SCHED;
            PG8_LDB(B0, 1, 0); PG8_LDB(B1, 1, 1); PG8_SCHED; PG8_LDA(At, 1, 0); PG8_STAGE(PG8_SA(0, 1), a2 + hstepA, voffA[NVA - 1]);
            PG8_WAIT_V(8); PG8_WAIT_L(0); PG8_BAR; PG8_MMA(0, 0, At, B0); PG8_MMA(0, 1, At, B1); PG8_BAR; PG8_SCHED;
            PG8_LDA(At, 1, 1); PG8_STAGE(PG8_SB(1, 0), b3, voffB); PG8_STAGE(PG8_SB(1, 1), b3 + hstep, voffB); PG8_STAGE(PG8_SA(1, 0), a3, voffA[0]);
            PG8_WAIT_V(8); PG8_WAIT_L(0); PG8_BAR; PG8_MMA(1, 0, At, B0); PG8_MMA(1, 1, At, B1); PG8_BAR; PG8_SCHED;
        }
        if constexpr (ALIGN_EPI) { if (wr == 0) PG8_BAR; }
        E(acc, cur, wr, wc, fr, fq);
        if (!has_next) break;
#pragma unroll
        for (int a = 0; a < 2; ++a)
#pragma unroll
            for (int b = 0; b < 2; ++b)
#pragma unroll
                for (int m = 0; m < 4; ++m)
#pragma unroll
                    for (int n = 0; n < 2; ++n) acc[a][b][m][n] = (f32x4){0.f, 0.f, 0.f, 0.f};
        cur = nxt; ++ui;
        if constexpr (ALIGN_EPI) { if (wr == 1) PG8_BAR; }
    }
    PG8_WAIT_V(0);
    if constexpr (!ALIGN_EPI) { if (wr == 0) PG8_BAR; }
    PG8_BAR;
#undef PG8_SA
#undef PG8_SB
#undef PG8_STAGE
#undef PG8_LDA
#undef PG8_LDB
#undef PG8_MMA
#undef PG8_WAIT_V
#undef PG8_WAIT_L
#undef PG8_BAR
#undef PG8_SCHED
}
}

namespace attn_body {
using bf16=__hip_bfloat16;
using bf16x8=__attribute__((ext_vector_type(8)))short;
using s16x4=__attribute__((ext_vector_type(4)))short;
using f32x16=__attribute__((ext_vector_type(16)))float;
using u32x4=__attribute__((ext_vector_type(4)))unsigned;
constexpr int BATCH=8,NHEAD=8,SEQ=4096,D=64,DM=NHEAD*D;
constexpr int NW=8,QBLK=32,QB=QBLK*NW,KVBLK=64,NQB=SEQ/QB;
__device__ __forceinline__ int crow(int r,int hi){return (r&3)+8*(r>>2)+4*hi;}
#define SBAR() __builtin_amdgcn_sched_barrier(0)
__device__ __forceinline__ void cmask(f32x16&p0,f32x16&p1,int qe,int hi){
  const float NEG=-INFINITY; int kb=4*hi;
  #pragma unroll
  for(int r=0;r<16;++r){int kv=kb+(r&3)+8*(r>>2); if(kv>qe)p0[r]=NEG; if(kv+32>qe)p1[r]=NEG;}
}
__device__ __forceinline__ void bmask(f32x16&p0,f32x16&p1,bool keep,float mhat){
  float pen=keep?-mhat:-INFINITY; asm volatile("":"+v"(pen));
  #pragma unroll
  for(int r=0;r<16;++r){p0[r]+=pen; p1[r]+=pen;}
}

constexpr int NSLOT=3, SLOTB=8192;
constexpr int LDS_K=0, LDS_V=NSLOT*SLOTB, LDS_WS=2*NSLOT*SLOTB, LDS_OST=LDS_WS+NW*64*4, LDS_BYTES=LDS_OST+NW*4096;
constexpr float C2=0.125f*1.4426950408889634f;
__device__ __forceinline__ void glds16(const void*gsrc,unsigned lds_dst){unsigned keep;
  asm volatile("s_mov_b32 %0, m0\n\ts_mov_b32 m0, %2\n\ts_nop 0\n\tglobal_load_lds_dwordx4 %1, off\n\ts_mov_b32 m0, %0":"=&s"(keep):"v"(gsrc),"s"(lds_dst):"memory");}
__device__ __forceinline__ float max3f(float a,float b,float c){float r;asm("v_max3_f32 %0, %1, %2, %3":"=v"(r):"v"(a),"v"(b),"v"(c));return r;}
__device__ __forceinline__ float max2f(float a,float b){float r;asm("v_max_f32_e32 %0, %1, %2":"=v"(r):"v"(a),"v"(b));return r;}
__device__ __forceinline__ float fadd_s(float a,float b){float r;asm("v_add_f32_e32 %0, %1, %2":"=v"(r):"v"(a),"v"(b));return r;}
__device__ __forceinline__ float fsub_s(float a,float b){float r;asm("v_sub_f32_e32 %0, %1, %2":"=v"(r):"v"(a),"v"(b));return r;}
typedef float f32x2_t __attribute__((ext_vector_type(2))); typedef __bf16 bf16x2_t __attribute__((ext_vector_type(2)));
__device__ __forceinline__ unsigned cvtpk_s(float lo,float hi){f32x2_t v={lo,hi};bf16x2_t b=__builtin_convertvector(v,bf16x2_t);return __builtin_bit_cast(unsigned,b);}
#define WAIT_BAR(N) asm volatile("s_waitcnt vmcnt(" #N ") lgkmcnt(0)\n\ts_barrier":::"memory")

__device__ __forceinline__ void qkt(f32x16&p0,f32x16&p1,const char*Kslot,const bf16x8*qr,int r32,int hi){
  const char*kb=Kslot+hi*1024+r32*16;
  #pragma unroll
  for(int d0=0;d0<4;++d0){
    const bf16x8 b0=*reinterpret_cast<const bf16x8*>(kb+d0*2048);
    const bf16x8 b1=*reinterpret_cast<const bf16x8*>(kb+d0*2048+512);
    if(d0==0){p0=__builtin_amdgcn_mfma_f32_32x32x16_bf16(b0,qr[0],f32x16{},0,0,0);p1=__builtin_amdgcn_mfma_f32_32x32x16_bf16(b1,qr[0],f32x16{},0,0,0);}
    else{p0=__builtin_amdgcn_mfma_f32_32x32x16_bf16(b0,qr[d0],p0,0,0,0);p1=__builtin_amdgcn_mfma_f32_32x32x16_bf16(b1,qr[d0],p1,0,0,0);}}
}
typedef __attribute__((address_space(3))) const char* lds_cptr;
typedef short v4i16_t __attribute__((ext_vector_type(4)));
__device__ __forceinline__ void kload8(bf16x8*kf,lds_cptr kp){
  kf[0]=*(const __attribute__((address_space(3))) bf16x8*)(kp);      kf[1]=*(const __attribute__((address_space(3))) bf16x8*)(kp+512);
  kf[2]=*(const __attribute__((address_space(3))) bf16x8*)(kp+2048); kf[3]=*(const __attribute__((address_space(3))) bf16x8*)(kp+2560);
  kf[4]=*(const __attribute__((address_space(3))) bf16x8*)(kp+4096); kf[5]=*(const __attribute__((address_space(3))) bf16x8*)(kp+4608);
  kf[6]=*(const __attribute__((address_space(3))) bf16x8*)(kp+6144); kf[7]=*(const __attribute__((address_space(3))) bf16x8*)(kp+6656);
}
__device__ __forceinline__ void kload2(bf16x8*kf,lds_cptr kp,int j){ kf[2*j]=*(const __attribute__((address_space(3))) bf16x8*)(kp+j*2048); kf[2*j+1]=*(const __attribute__((address_space(3))) bf16x8*)(kp+j*2048+512); }
__device__ __forceinline__ s16x4 vtr(lds_cptr p){ return __builtin_bit_cast(s16x4,__builtin_amdgcn_ds_read_tr16_b64_v4i16((__attribute__((address_space(3))) v4i16_t*)p)); }
__device__ __forceinline__ float rowmax(const f32x16&p0,const f32x16&p1){
  float a=max3f(p0[0],p0[1],p1[0]),b=max3f(p0[2],p0[3],p1[1]);a=max3f(a,p1[2],p1[3]);
  #pragma unroll
  for(int r=4;r<16;r+=4){a=max3f(a,p0[r],p0[r+1]);b=max3f(b,p0[r+2],p0[r+3]);a=max3f(a,p1[r],p1[r+1]);b=max3f(b,p1[r+2],p1[r+3]);}
  const float m=max2f(a,b);
  auto rr=__builtin_amdgcn_permlane32_swap(__float_as_uint(m),__float_as_uint(m),false,false);
  return max2f(__uint_as_float(rr[0]),__uint_as_float(rr[1]));
}
__device__ __forceinline__ void pv(f32x16*o,int vb,bf16x8 pa0,bf16x8 pa1,bf16x8 pa2,bf16x8 pa3){
  #pragma unroll
  for(int d0=0;d0<2;++d0){s16x4 lo[4],hi[4];
    #pragma unroll
    for(int ks=0;ks<4;++ks){
      asm volatile("ds_read_b64_tr_b16 %0,%1 offset:%c2":"=&v"(lo[ks]):"v"(vb),"i"(d0*4096+ks*1024):"memory");
      asm volatile("ds_read_b64_tr_b16 %0,%1 offset:%c2":"=&v"(hi[ks]):"v"(vb),"i"(d0*4096+ks*1024+512):"memory");}
    asm volatile("s_waitcnt lgkmcnt(0)":::"memory");SBAR();
    #define PK(k) (bf16x8){lo[k][0],lo[k][1],lo[k][2],lo[k][3],hi[k][0],hi[k][1],hi[k][2],hi[k][3]}
    o[d0]=__builtin_amdgcn_mfma_f32_32x32x16_bf16(pa0,PK(0),o[d0],0,0,0);
    o[d0]=__builtin_amdgcn_mfma_f32_32x32x16_bf16(pa1,PK(1),o[d0],0,0,0);
    o[d0]=__builtin_amdgcn_mfma_f32_32x32x16_bf16(pa2,PK(2),o[d0],0,0,0);
    o[d0]=__builtin_amdgcn_mfma_f32_32x32x16_bf16(pa3,PK(3),o[d0],0,0,0);
    #undef PK
  }
}

#define ATTN_STORE16(p,v) (*(u32x4*)(p)=(v))
template<int THRL> __device__ __forceinline__ void attn_unit(int b,int h,int qb,const bf16*Q,const bf16*__restrict__ K,const bf16*__restrict__ V,bf16*O,const unsigned*SEL,char*shm,const int wid_){
  const int lane=lane_id(),r32=lane&31,hi=lane>>5; const int wid=wid_;
  const long rowbase=(long)b*SEQ; const int q0=qb*QB;
  const bf16*Qw=Q+(rowbase+q0+wid*QBLK)*DM+h*D;
  const bf16*Kh=K+rowbase*DM+h*D,*Vh=V+rowbase*DM+h*D;
  const unsigned lds0=(unsigned)(uintptr_t)shm;
  float*wsf=(float*)(shm+LDS_WS)+wid*64;
  const unsigned selm=SEL[((long)(b*NHEAD+h))*SEQ+q0+wid*QBLK+r32];
  const bf16*ksrc=Kh+(long)lane*DM+wid*8;
  const bf16*vsrc=Vh+(long)(16*(wid&3)+(lane>>2))*DM+(wid>>2)*32+(lane&3)*8;
  const unsigned kdst=lds0+LDS_K+wid*1024, vdst=lds0+LDS_V+wid*1024;
  #define DMA_K(t,slot) glds16(ksrc+(long)(t)*KVBLK*DM,(unsigned)__builtin_amdgcn_readfirstlane(kdst+(slot)))
  #define DMA_V(t,slot) glds16(vsrc+(long)(t)*KVBLK*DM,(unsigned)__builtin_amdgcn_readfirstlane(vdst+(slot)))
  const int vb0=(int)(lds0+LDS_V)+((lane>>4)&1)*32+(lane&3)*8+(4*hi+((lane&15)>>2))*64;
  const char*Kbase=shm+LDS_K; bf16x8 kf[8];
  const lds_cptr shm3=(lds_cptr)shm; const lds_cptr kp0=shm3+LDS_K+hi*1024+r32*16; const lds_cptr vp0=shm3+LDS_V+((lane>>4)&1)*32+(lane&3)*8+(4*hi+((lane&15)>>2))*64;
  const int NT=(q0+QB)/KVBLK;
  DMA_K(0,0);DMA_V(0,0);DMA_K(1,SLOTB);
  bf16x8 qr[4];
  #pragma unroll
  for(int d0=0;d0<4;++d0)qr[d0]=*reinterpret_cast<const bf16x8*>(&Qw[(long)r32*DM+d0*16+hi*8]);
  float mhat=0.f,l_reg=0.f;f32x16 o[2];o[0]=f32x16{};o[1]=f32x16{};
  const int qrel=wid*QBLK+r32;
  #define CMASK(P0,P1,t) do{const int jb_=(t)-(NT-4); if(jb_>=0){cmask(P0,P1,qrel-64*jb_,hi); bmask(P0,P1,true,mhat);} else bmask(P0,P1,((selm>>((t)>>2))&1u)!=0u,mhat);}while(0)
  bool resc=false;
  #define START(P0,P1) do{ const float rm=rowmax(P0,P1); resc=false; \
    { const float dl=__builtin_fmaxf(rm,-60.f); mhat=fadd_s(mhat,dl); \
      _Pragma("unroll") for(int r=0;r<16;++r){P0[r]=fsub_s(P0[r],dl);P1[r]=fsub_s(P1[r],dl);} } \
    _Pragma("unroll") for(int r=0;r<16;++r)P0[r]=__builtin_amdgcn_exp2f(P0[r]); }while(0)
  #define RESC() do{ if(resc){ asm volatile("s_waitcnt lgkmcnt(0)":::"memory"); \
      _Pragma("unroll") for(int d_=0;d_<2;++d_) _Pragma("unroll") for(int r=0;r<16;++r)o[d_][r]*=wsf[crow(r,hi)]; } }while(0)
  f32x16 pA0,pA1,pB0,pB1;
  int sl_prev=0,sl_cur=0,sl_next=SLOTB;
  #define ROT() do{sl_prev=sl_cur;sl_cur=sl_next;sl_next=(sl_next==(NSLOT-1)*SLOTB)?0:sl_next+SLOTB;}while(0)
  DMA_K(2,2*SLOTB);
  WAIT_BAR(3);
  qkt(pA0,pA1,Kbase,qr,r32,hi);asm volatile("s_nop 15\n\ts_nop 7":"+v"(pA0),"+v"(pA1));CMASK(pA0,pA1,0);
  START(pA0,pA1);
  _Pragma("unroll") for(int r=0;r<16;++r)pA1[r]=__builtin_amdgcn_exp2f(pA1[r]);
  WAIT_BAR(0);
  DMA_K(3,0);DMA_V(1,SLOTB);
  ROT();
  kload8(kf,kp0+sl_cur);
  WAIT_BAR(2);
  s16x4 vlo[8],vhi[8]; u32x4 pw0,pw1,pw2,pw3;
  #define PKW(P,B) cvtpk_s(P[B],P[B+1])
  #define PAF(k) __builtin_bit_cast(bf16x8,pw##k)
  #define VFR(i) (bf16x8){vlo[i][0],vlo[i][1],vlo[i][2],vlo[i][3],vhi[i][0],vhi[i][1],vhi[i][2],vhi[i][3]}
  #define PIN(x) asm volatile("":"+v"(x))
  #define MX3(a,b,c) __builtin_fmaxf(__builtin_fmaxf((a),(b)),(c))
  #define GAPA(MF,A0,A1,A2,A3,W0,W1,PW) do{ MF; sacc+=A0; sacc+=A1; sacc+=A2; sacc+=A3; PIN(sacc); W0; W1; PIN(PW); SBAR(); }while(0)
  #define EX(v) __builtin_amdgcn_exp2f(v)
  #define GAPB(MF,X,B) do{ MF; X[B]=EX(X[B]); X[B+1]=EX(X[B+1]); X[B+2]=EX(X[B+2]); X[B+3]=EX(X[B+3]); PIN(X); SBAR(); }while(0)
  #define VRD(i) do{ vlo[i]=vtr(vp_+(((i)>>2)*4096+((i)&3)*1024)); vhi[i]=vtr(vp_+(((i)>>2)*4096+((i)&3)*1024+512)); }while(0)
  #define KRD(G,j) do{ if(G){ kload2(kf,kp0+sl_next,j); SBAR(); } }while(0)
  #define STEP(C0,C1,P0,P1,t,GK,GV,GL) do{ SBAR(); \
    const lds_cptr vp_=vp0+sl_prev; \
    VRD(0); SBAR(); float sacc=(P0[0]+P0[1]); \
    GAPA(C0=__builtin_amdgcn_mfma_f32_32x32x16_bf16(kf[0],qr[0],f32x16{},0,0,0), P0[2],P0[3],P0[4],P0[5],     pw0[0]=PKW(P0,0), pw0[1]=PKW(P0,2), pw0); \
    VRD(4); SBAR(); GAPA(C1=__builtin_amdgcn_mfma_f32_32x32x16_bf16(kf[1],qr[0],f32x16{},0,0,0), P0[6],P0[7],P0[8],P0[9],     pw0[2]=PKW(P0,4), pw0[3]=PKW(P0,6), pw0); \
    VRD(1); SBAR(); GAPA(C0=__builtin_amdgcn_mfma_f32_32x32x16_bf16(kf[2],qr[1],C0,0,0,0),   P0[10],P0[11],P0[12],P0[13], pw1[0]=PKW(P0,8), pw1[1]=PKW(P0,10), pw1); \
    VRD(5); SBAR(); GAPA(C1=__builtin_amdgcn_mfma_f32_32x32x16_bf16(kf[3],qr[1],C1,0,0,0),   P0[14],P0[15],P1[0],P1[1],   pw1[2]=PKW(P0,12),pw1[3]=PKW(P0,14), pw1); \
    VRD(2); SBAR(); GAPA(C0=__builtin_amdgcn_mfma_f32_32x32x16_bf16(kf[4],qr[2],C0,0,0,0),   P1[2],P1[3],P1[4],P1[5],     pw2[0]=PKW(P1,0), pw2[1]=PKW(P1,2), pw2); \
    VRD(6); SBAR(); GAPA(C1=__builtin_amdgcn_mfma_f32_32x32x16_bf16(kf[5],qr[2],C1,0,0,0),   P1[6],P1[7],P1[8],P1[9],     pw2[2]=PKW(P1,4), pw2[3]=PKW(P1,6), pw2); \
    VRD(3); SBAR(); GAPA(C0=__builtin_amdgcn_mfma_f32_32x32x16_bf16(kf[6],qr[3],C0,0,0,0),   P1[10],P1[11],P1[12],P1[13], pw3[0]=PKW(P1,8), pw3[1]=PKW(P1,10), pw3); \
    VRD(7); SBAR(); GAPA(C1=__builtin_amdgcn_mfma_f32_32x32x16_bf16(kf[7],qr[3],C1,0,0,0),   P1[14],P1[15],0.f,0.f,       pw3[2]=PKW(P1,12),pw3[3]=PKW(P1,14), pw3); \
    l_reg+=sacc; \
    if(GK){DMA_K((t)+3,sl_cur);} if(GV){DMA_V((t)+1,sl_next);} \
    CMASK(C0,C1,t); \
    { float a=MX3(C0[0],C0[1],C1[0]),b=MX3(C0[2],C0[3],C1[1]); a=MX3(a,C1[2],C1[3]); \
      _Pragma("unroll") for(int r=4;r<16;r+=4){a=MX3(a,C0[r],C0[r+1]);b=MX3(b,C0[r+2],C0[r+3]);a=MX3(a,C1[r],C1[r+1]);b=MX3(b,C1[r+2],C1[r+3]);} \
      float rm=__builtin_fmaxf(a,b); { auto rr=__builtin_amdgcn_permlane32_swap(__float_as_uint(rm),__float_as_uint(rm),false,false); rm=__builtin_fmaxf(__uint_as_float(rr[0]),__uint_as_float(rr[1])); } \
      resc=false; \
      if(__builtin_expect(__any(rm>(float)THRL),0)){ const float dl=__builtin_fmaxf(rm,0.f); mhat+=dl; \
        _Pragma("unroll") for(int r=0;r<16;++r){C0[r]-=dl;C1[r]-=dl;} \
        const float f=__builtin_amdgcn_exp2f(-dl); l_reg*=f; if(hi==0)wsf[r32]=f; resc=true; } } \
    SBAR(); \
    GAPB(o[0]=__builtin_amdgcn_mfma_f32_32x32x16_bf16(PAF(0),VFR(0),o[0],0,0,0), C0,0); \
    GAPB(o[1]=__builtin_amdgcn_mfma_f32_32x32x16_bf16(PAF(0),VFR(4),o[1],0,0,0), C0,4); \
    KRD(GL,0); GAPB(o[0]=__builtin_amdgcn_mfma_f32_32x32x16_bf16(PAF(1),VFR(1),o[0],0,0,0), C0,8); \
    KRD(GL,1); GAPB(o[1]=__builtin_amdgcn_mfma_f32_32x32x16_bf16(PAF(1),VFR(5),o[1],0,0,0), C0,12); \
    KRD(GL,2); GAPB(o[0]=__builtin_amdgcn_mfma_f32_32x32x16_bf16(PAF(2),VFR(2),o[0],0,0,0), C1,0); \
    KRD(GL,3); GAPB(o[1]=__builtin_amdgcn_mfma_f32_32x32x16_bf16(PAF(2),VFR(6),o[1],0,0,0), C1,4); \
    GAPB(o[0]=__builtin_amdgcn_mfma_f32_32x32x16_bf16(PAF(3),VFR(3),o[0],0,0,0), C1,8); \
    GAPB(o[1]=__builtin_amdgcn_mfma_f32_32x32x16_bf16(PAF(3),VFR(7),o[1],0,0,0), C1,12); \
    }while(0)
  int t=1;
  #undef CMASK
  #define CMASK(P0,P1,t) bmask(P0,P1,((selm>>((t)>>2))&1u)!=0u,mhat)
  for(;t+5<NT;t+=2){
    STEP(pB0,pB1,pA0,pA1,t,true,true,true);     WAIT_BAR(2); RESC(); ROT();
    STEP(pA0,pA1,pB0,pB1,t+1,true,true,true);   WAIT_BAR(2); RESC(); ROT();
  }
  #undef CMASK
  #define CMASK(P0,P1,t) do{const int jb_=(t)-(NT-4); if(jb_>=0){cmask(P0,P1,qrel-64*jb_,hi); bmask(P0,P1,true,mhat);} else bmask(P0,P1,((selm>>((t)>>2))&1u)!=0u,mhat);}while(0)
  #define ENDW(tt) do{ if((tt)+3<NT){WAIT_BAR(2);} else if((tt)+2<NT){WAIT_BAR(1);} else {WAIT_BAR(0);} }while(0)
  for(;t+1<NT;t+=2){
    STEP(pB0,pB1,pA0,pA1,t,(t+3<NT),(t+1<NT),(t+1<NT));       ENDW(t);   RESC(); ROT();
    STEP(pA0,pA1,pB0,pB1,t+1,(t+4<NT),(t+2<NT),(t+2<NT));     ENDW(t+1); RESC(); ROT();
  }
  STEP(pB0,pB1,pA0,pA1,NT-1,false,false,false); RESC();
  { float sacc=pB0[0]+pB0[1]; _Pragma("unroll") for(int r=2;r<16;++r)sacc+=pB0[r]; _Pragma("unroll") for(int r=0;r<16;++r)sacc+=pB1[r]; l_reg+=sacc;
    pw0=(u32x4){PKW(pB0,0),PKW(pB0,2),PKW(pB0,4),PKW(pB0,6)};pw1=(u32x4){PKW(pB0,8),PKW(pB0,10),PKW(pB0,12),PKW(pB0,14)};pw2=(u32x4){PKW(pB1,0),PKW(pB1,2),PKW(pB1,4),PKW(pB1,6)};pw3=(u32x4){PKW(pB1,8),PKW(pB1,10),PKW(pB1,12),PKW(pB1,14)};
    SBAR(); pv(o,vb0+sl_cur,PAF(0),PAF(1),PAF(2),PAF(3)); }
  #undef PKW
  #undef PAF
  #undef VFR
  #undef PIN
  #undef MX3
  #undef GAPA
  #undef GAPB
  #undef EX
  #undef VRD
  #undef KRD
  #undef STEP
  #undef ENDW
  {auto rr=__builtin_amdgcn_permlane32_swap(__float_as_uint(l_reg),__float_as_uint(l_reg),false,false);l_reg=__uint_as_float(rr[0])+__uint_as_float(rr[1]);}
  if(hi==0)wsf[32+r32]=l_reg;asm volatile("s_waitcnt lgkmcnt(0)":::"memory");
  float rli[16];
  #pragma unroll
  for(int r=0;r<16;++r)rli[r]=__builtin_amdgcn_rcpf(wsf[32+crow(r,hi)]);
  bf16*Ow=O+(rowbase+q0+wid*QBLK)*DM+h*D;
  { bf16*stg=(bf16*)(shm+LDS_OST)+wid*2048;
    #pragma unroll
    for(int r=0;r<16;++r){const int orow=crow(r,hi);
      #pragma unroll
      for(int d0=0;d0<2;++d0)stg[orow*64+d0*32+r32]=__float2bfloat16(o[d0][r]*rli[r]);}
    asm volatile("s_waitcnt lgkmcnt(0)":::"memory");
    #pragma unroll
    for(int i=0;i<4;++i){const int row=i*8+(lane>>3),ch=lane&7; const u32x4 v=*(const u32x4*)(stg+row*64+ch*8); ATTN_STORE16(Ow+(long)row*DM+ch*8,v);} }
  asm volatile("s_waitcnt lgkmcnt(0)\n\ts_barrier":::"memory");
  #undef DMA_K
  #undef DMA_V
  #undef CMASK
  #undef START
  #undef RESC
  #undef ROT
}
constexpr int ATTN_LDS_BYTES=LDS_BYTES;
#undef SBAR
#undef WAIT_BAR
}

constexpr int NWAVES = 8;
constexpr int NPH = 15;
constexpr int N_LAUNCHES = MK_N_LAUNCHES;
static_assert(N_LAUNCHES == 1 || N_LAUNCHES == NPH, "MK_N_LAUNCHES is 1 or NPH");

constexpr size_t MiB = 1u << 20;
constexpr size_t WS_CTL = 0, CTL_ZERO_BYTES = 2 * MiB;
constexpr size_t WS_KMEAN = 1 * MiB;
constexpr size_t WS_GCOUNT = 1 * MiB + 512 * 1024;
constexpr size_t WS_WIN = 2 * MiB;
constexpr size_t WS_WAO = 12 * MiB, WS_WCO = 13 * MiB, WS_WOUT = 14 * MiB;
constexpr size_t WS_WSR = 16 * MiB;
constexpr size_t WS_WSD = 18 * MiB;
constexpr size_t WS_WPG = 19 * MiB, WS_WPP = 21 * MiB;
constexpr size_t WS_ROPE = 22 * MiB;
constexpr size_t WS_SEL = 22 * MiB + 512 * 1024;
constexpr size_t WS_PB = 24 * MiB;
constexpr size_t WS_TOPI = 40 * MiB, WS_TOPW = 41 * MiB, WS_LRANK = 42 * MiB;
constexpr size_t WS_ROWTOK = 43 * MiB, WS_ROWDST = 44 * MiB + 512 * 1024, WS_ROWW = 46 * MiB, WS_WGBASE = 47 * MiB + 256 * 1024;
constexpr size_t WS_WD = 48 * MiB;
constexpr size_t WS_WGU = 176 * MiB;
constexpr size_t WS_YLO = 176 * MiB;
constexpr size_t WS_XB = 432 * MiB;
constexpr size_t WS_S6 = 496 * MiB;
constexpr size_t WS_H = 496 * MiB;
constexpr size_t WS_YHI = 656 * MiB;
constexpr size_t WS_G = 688 * MiB;
constexpr size_t WS_P1 = 816 * MiB;
constexpr size_t WS_LOGITS = 912 * MiB;
constexpr size_t WS_HS = 944 * MiB;
constexpr size_t WS_PP = 960 * MiB;
constexpr size_t WS_END = 1024 * MiB;
static_assert(WS_H + (size_t)RMAX_ * 256 * 2 <= WS_YHI && WS_YHI + (size_t)T_ * 4 * 1024 * 2 <= WS_LOGITS && WS_WGU + (size_t)NE_ * 512 * 1024 * 2 <= WS_XB, "ws map");
static_assert(WS_ROWTOK + (size_t)RMAX_ * 4 <= WS_ROWDST && WS_ROWDST + (size_t)RMAX_ * 4 <= WS_ROWW && WS_ROWW + (size_t)RMAX_ * 4 <= WS_WGBASE, "ws tables");
constexpr int CW_BAR = 4096;

constexpr int RING_OFF = 0, RING_BYTES = 131072;
constexpr int LDSCTL_OFF = RING_BYTES, MISC_OFF = LDSCTL_OFF + 320;
constexpr int LX_HIST = LDSCTL_OFF + 512;
constexpr int LX_PST = LX_HIST + 1024;
constexpr int LX_NB = LX_PST + 1040;
constexpr int LX_BLKE = LX_NB + 1024;
constexpr int LX_XS = LX_BLKE + 2560;
constexpr int LDS_BYTES = 147456;
static_assert(LX_XS + 64 <= LDS_BYTES && attn_body::ATTN_LDS_BYTES <= RING_BYTES, "LDS map");

#define XB_TMO      128
#define XB_XCNT(j)  (256  + 64 * (j))
#define XB_XSUB(j)  (1280 + 64 * (j))
#define XB_XGEN(j)  (2304 + 64 * (j))
#define XB_TOP      3328
#define XB_TOPGEN   3392
#define XCD_BAR_WORDS 3456
#define XB_SPIN_CAP (1u << 18)

__device__ __forceinline__ unsigned xb_ld(unsigned* p)              { return __hip_atomic_load(p, __ATOMIC_RELAXED, __HIP_MEMORY_SCOPE_AGENT); }
__device__ __forceinline__ unsigned xb_add(unsigned* p, unsigned v) { return __hip_atomic_fetch_add(p, v, __ATOMIC_RELAXED, __HIP_MEMORY_SCOPE_AGENT); }
__device__ __forceinline__ unsigned xb_xcc_id() { return (unsigned)__builtin_amdgcn_s_getreg((3 << 11) | 20) & 0xFu; }
#define XB_SPIN(cond, bar) do { unsigned _sp = 0; while (cond) { __builtin_amdgcn_s_sleep(1); \
    if ((++_sp & 255u) == 0u) { if (xb_ld(&(bar)[XB_TMO])) break; if (_sp > XB_SPIN_CAP) { atomicAdd(&(bar)[XB_TMO], 1u); break; } } } } while (0)

struct XcdBarrier {
    unsigned* bar; unsigned x;
    volatile LAS unsigned* st;
};
__device__ __forceinline__ XcdBarrier xcd_barrier_post(unsigned* bar, volatile LAS unsigned* st, int wave) {
    XcdBarrier b; b.bar = bar; b.x = xb_xcc_id(); b.st = st;
    if (wave == 0 && lane_id() == 0) (void)xb_add(&bar[XB_XCNT(b.x)], 1u);
    return b;
}
__device__ __forceinline__ void xcd_barrier_complete(unsigned* bar, unsigned x, unsigned& nloc, unsigned& nx) {
    const unsigned G = gridDim.x * gridDim.y * gridDim.z;
    unsigned sum, cnt, mine, sp = 0u;
    for (;;) {
        sum = 0u; cnt = 0u; mine = 0u;
#pragma unroll
        for (unsigned j = 0; j < 16; ++j) { const unsigned c = xb_ld(&bar[XB_XCNT(j)]); sum += c; cnt += (c > 0u) ? 1u : 0u; mine = (j == x) ? c : mine; }
        if (sum == G) break;
        __builtin_amdgcn_s_sleep(1);
        if ((++sp & 255u) == 0u) { if (xb_ld(&bar[XB_TMO])) break; if (sp > XB_SPIN_CAP) { atomicAdd(&bar[XB_TMO], 1u); break; } }
    }
    nloc = mine > 0u ? mine : 1u; nx = cnt > 0u ? cnt : 1u;
}
__device__ __forceinline__ void xcd_barrier(const XcdBarrier& b, int wave) {
    asm volatile("s_waitcnt vmcnt(0)" ::: "memory");
    __syncthreads();
    if (wave == 0 && lane_id() == 0) {
        unsigned* bar = b.bar;
        __builtin_amdgcn_s_waitcnt(0);
        unsigned nloc = b.st[0], nx = b.st[1];
        if (nloc == 0u) { xcd_barrier_complete(bar, b.x, nloc, nx); b.st[0] = nloc; b.st[1] = nx; }
        const unsigned old = xb_add(&bar[XB_XSUB(b.x)], 1u);
        const unsigned gen = old / nloc;
        if (old + 1u == (gen + 1u) * nloc) {
            __builtin_amdgcn_fence(__ATOMIC_RELEASE, "agent");
            asm volatile("s_waitcnt vmcnt(0)" ::: "memory");
            const unsigned og = xb_add(&bar[XB_TOP], 1u);
            const unsigned tg = og / nx;
            if (og + 1u == (tg + 1u) * nx) xb_add(&bar[XB_TOPGEN], 1u);
            else XB_SPIN(xb_ld(&bar[XB_TOPGEN]) == tg, bar);
            __builtin_amdgcn_fence(__ATOMIC_ACQUIRE, "agent");
            xb_add(&bar[XB_XGEN(b.x)], 1u);
            asm volatile("s_waitcnt vmcnt(0)" ::: "memory");
        } else {
            XB_SPIN(xb_ld(&bar[XB_XGEN(b.x)]) == gen, bar);
            __builtin_amdgcn_fence(__ATOMIC_ACQUIRE, "agent");
            asm volatile("s_waitcnt vmcnt(0)" ::: "memory");
        }
    }
    __syncthreads();
}

struct Args { const float* in[23]; float* out; unsigned char* ws; int ph_lo, ph_hi, li, pad; };

struct Frame {
    LAS unsigned char* lds;
    volatile LAS unsigned* MISC;
    gu32* ctl;
    int wave;
    int vcu, G;
    unsigned char* ws; float* out;
};

__device__ __forceinline__ float wave_sum(float v) {
#pragma unroll
    for (int o = 1; o < 64; o <<= 1) v += __shfl_xor(v, o);
    return v;
}

__device__ __forceinline__ void xpose_item(const float* W, int N, int k0, int n0, bf16* dst, int Kd, LAS float* scr, int lane) {
#pragma unroll 8
    for (int i = 0; i < 32; ++i) { const int kk = 2 * i + (lane >> 5); scr[kk * 33 + (lane & 31)] = W[(size_t)(k0 + kk) * N + n0 + (lane & 31)]; }
    LDS_WAIT(); asm volatile("" ::: "memory");
    const int c = lane & 7;
#pragma unroll
    for (int j = 0; j < 4; ++j) { const int n = (lane >> 3) + 8 * j; const LAS float* s = scr + (8 * c) * 33 + n;
        v4u o; o.x = cvt_pk_bf16(s[0 * 33], s[1 * 33]); o.y = cvt_pk_bf16(s[2 * 33], s[3 * 33]); o.z = cvt_pk_bf16(s[4 * 33], s[5 * 33]); o.w = cvt_pk_bf16(s[6 * 33], s[7 * 33]);
        *(v4u*)(dst + (size_t)n * Kd + 8 * c) = o; }
    LDS_WAIT(); asm volatile("" ::: "memory");
}
__device__ __forceinline__ void xpose_mat(const float* W, int K, int N, bf16* WT, int rbase, int mode, int half, int r, LAS float* scr, int lane) {
    const int nblk = N / 32, kb = r / nblk, nb = r % nblk, k0 = 64 * kb, n0 = 32 * nb;
    const int drow = mode ? (rbase + (n0 >> 7) * 256 + ((n0 & 127) >> 5) * 64 + half * 32 + (n0 & 31)) : (rbase + n0);
    xpose_item(W, N, k0, n0, WT + (size_t)drow * K + k0, K, scr, lane);
}
__device__ __forceinline__ void p0_prologue(Frame& F, const Args& A) {
    const int lane_ = lane_id(), tid_ = F.wave * 64 + lane_; (void)tid_;
    LAS float* scr = (LAS float*)(F.lds + RING_OFF + F.wave * 16384);
    unsigned char* ws = F.ws;
    const int gw = F.vcu * NWAVES + F.wave, NGW = F.G * NWAVES;
    constexpr int I_IN = 16 * 160, I_AO = 8 * 32, I_CO = 8 * 32, I_OUT = 16 * 32, I_R = 16 * 8, I_SG = 16 * 8, I_SU = 16 * 8, I_SD = 4 * 32, I_PG = 16 * 32, I_PP = 4 * 32;
    constexpr int NSMALL = I_IN + I_AO + I_CO + I_OUT + I_R + I_SG + I_SU + I_SD + I_PG + I_PP;
    for (int it = gw; it < NSMALL; it += NGW) {
        int r = it;
        if (r < I_IN) { xpose_mat(A.in[2], 1024, 5120, (bf16*)(ws + WS_WIN), 0, 0, 0, r, scr, lane_); continue; } r -= I_IN;
        if (r < I_AO) { xpose_mat(A.in[4], 512, 1024, (bf16*)(ws + WS_WAO), 0, 0, 0, r, scr, lane_); continue; } r -= I_AO;
        if (r < I_CO) { xpose_mat(A.in[5], 512, 1024, (bf16*)(ws + WS_WCO), 0, 0, 0, r, scr, lane_); continue; } r -= I_CO;
        if (r < I_OUT) { xpose_mat(A.in[6], 1024, 1024, (bf16*)(ws + WS_WOUT), 0, 0, 0, r, scr, lane_); continue; } r -= I_OUT;
        if (r < I_R) { xpose_mat(A.in[9], 1024, 256, (bf16*)(ws + WS_WSR), 512, 0, 0, r, scr, lane_); continue; } r -= I_R;
        if (r < I_SG) { xpose_mat(A.in[14], 1024, 256, (bf16*)(ws + WS_WSR), 0, 1, 0, r, scr, lane_); continue; } r -= I_SG;
        if (r < I_SU) { xpose_mat(A.in[15], 1024, 256, (bf16*)(ws + WS_WSR), 0, 1, 1, r, scr, lane_); continue; } r -= I_SU;
        if (r < I_SD) { xpose_mat(A.in[16], 256, 1024, (bf16*)(ws + WS_WSD), 0, 0, 0, r, scr, lane_); continue; } r -= I_SD;
        if (r < I_PG) { xpose_mat(A.in[19], 1024, 1024, (bf16*)(ws + WS_WPG), 0, 0, 0, r, scr, lane_); continue; } r -= I_PG;
        xpose_mat(A.in[20], 256, 1024, (bf16*)(ws + WS_WPP), 0, 0, 0, r, scr, lane_);
    }
    for (int it = gw; it < NE_ * 384; it += NGW) {
        const int e = it / 384; int r = it % 384;
        if (r < 128) { xpose_mat(A.in[11] + (size_t)e * 1024 * 256, 1024, 256, (bf16*)(ws + WS_WGU), e * 512, 1, 0, r, scr, lane_); continue; } r -= 128;
        if (r < 128) { xpose_mat(A.in[12] + (size_t)e * 1024 * 256, 1024, 256, (bf16*)(ws + WS_WGU), e * 512, 1, 1, r, scr, lane_); continue; } r -= 128;
        xpose_mat(A.in[13] + (size_t)e * 256 * 1024, 256, 1024, (bf16*)(ws + WS_WD), e * 1024, 0, 0, r, scr, lane_);
    }
    {
        const size_t gt = (size_t)F.vcu * 512 + tid_, NT = (size_t)F.G * 512;
#ifdef MK_FILL_G
        { v4u z; z.x = z.y = z.z = z.w = 0u; unsigned char* gp = ws + WS_G; for (size_t i = gt; i < (size_t)(128u << 20) / 16; i += NT) *(v4u*)(gp + i * 16) = z; }
#endif
        const float* x = A.in[0]; bf16* xb = (bf16*)(ws + WS_XB);
        for (size_t i = gt; i < (size_t)T_ * D_ / 8; i += NT) { const f32x4 a = *(const f32x4*)(x + i * 8), b = *(const f32x4*)(x + i * 8 + 4);
            v4u o; o.x = cvt_pk_bf16(a.x, a.y); o.y = cvt_pk_bf16(a.z, a.w); o.z = cvt_pk_bf16(b.x, b.y); o.w = cvt_pk_bf16(b.z, b.w); *(v4u*)(xb + i * 8) = o; }
        const float* p = A.in[1]; bf16* pb = (bf16*)(ws + WS_PB);
        for (size_t i = gt; i < (size_t)T_ * PLE_ / 8; i += NT) { const f32x4 a = *(const f32x4*)(p + i * 8), b = *(const f32x4*)(p + i * 8 + 4);
            v4u o; o.x = cvt_pk_bf16(a.x, a.y); o.y = cvt_pk_bf16(a.z, a.w); o.z = cvt_pk_bf16(b.x, b.y); o.w = cvt_pk_bf16(b.z, b.w); *(v4u*)(pb + i * 8) = o; }
        float* rope = (float*)(ws + WS_ROPE);
        for (size_t i = gt; i < (size_t)SEQ_ * 8; i += NT) {
            const int pos = (int)(i >> 3), fi = (int)(i & 7);
            const float invf = (float)exp(-(double)fi * 0.125 * log(500000.0));
            const float angf = (float)pos * invf;
            const double ang = (double)angf;
            const double kq = rint(ang * 0.63661977236758134308);
            const double rr = (ang - kq * 1.57079632679489655800) - kq * 6.12323399573676603587e-17;
            const double r2 = rr * rr;
            const double sn = rr * (1.0 + r2 * (-1.0 / 6 + r2 * (1.0 / 120 + r2 * (-1.0 / 5040 + r2 * (1.0 / 362880 + r2 * (-1.0 / 39916800 + r2 * (1.0 / 6227020800.0)))))));
            const double cs = 1.0 + r2 * (-0.5 + r2 * (1.0 / 24 + r2 * (-1.0 / 720 + r2 * (1.0 / 40320 + r2 * (-1.0 / 3628800 + r2 * (1.0 / 479001600.0 + r2 * (-1.0 / 87178291200.0)))))));
            const int q = (int)(((long long)kq) & 3);
            const double c = (q == 0) ? cs : (q == 1) ? -sn : (q == 2) ? -cs : sn;
            const double s = (q == 0) ? sn : (q == 1) ? cs : (q == 2) ? -sn : -cs;
            rope[pos * 16 + fi] = (float)c; rope[pos * 16 + 8 + fi] = (float)s;
        }
    }
}

typedef const f32x4 (&AccRef)[2][2][4][2];
__device__ __forceinline__ void store_rows128(bf16* rowA, bf16* rowB, int fr, int fq, v4u p0, v4u p1) {
    const bool low = (fr & 8) == 0;
    const v4u snd = low ? p1 : p0; v4u rcv;
    rcv.x = __shfl_xor(snd.x, 8); rcv.y = __shfl_xor(snd.y, 8); rcv.z = __shfl_xor(snd.z, 8); rcv.w = __shfl_xor(snd.w, 8);
    const v4u dA = low ? p0 : rcv, dB = low ? rcv : p1;
    const int colb = (low ? 0 : 32) + 8 * fq;
    if (rowA) *(v4u*)(rowA + colb) = dA;
    if (rowB) *(v4u*)(rowB + colb) = dB;
}

struct EpiZ {
    static constexpr bool PERM = true;
    bf16* S6; bf16* Gt; const float* rope; float* kmean;
    __device__ __forceinline__ void operator()(AccRef acc, const pg8::Unit& u, int wr, int wc, int fr, int fq) const {
        const int pn = u.pn, row0 = u.row0 + wr * 64 + fr, ct0 = wc * 64 + 8 * fq, rg0 = u.row0 + wr * 64 + (fr & 7);
        if (pn < 12) {
            bf16* base = S6 + (size_t)(pn >> 1) * T_ * 512 + (pn & 1) * 256 + wc * 64;
            const bool ropew = (pn < 4);
            const bool isk = (pn == 2) || (pn == 3);
            const float sc = (pn < 2) ? attn_body::C2 : 1.f;
            float ks[2][8];
#pragma unroll
            for (int bj = 0; bj < 2; ++bj)
#pragma unroll
                for (int i = 0; i < 8; ++i) ks[bj][i] = 0.f;
#pragma unroll
            for (int ai = 0; ai < 2; ++ai)
#pragma unroll
                for (int m = 0; m < 4; ++m) {
                    const int r = row0 + ai * 128 + m * 16;
                    float cs[8], sn[8];
                    if (ropew) { const float* rp = rope + (size_t)(r & (SEQ_ - 1)) * 16; const f32x4 c0 = *(const f32x4*)rp, c1 = *(const f32x4*)(rp + 4), s0 = *(const f32x4*)(rp + 8), s1 = *(const f32x4*)(rp + 12);
                        cs[0] = c0.x; cs[1] = c0.y; cs[2] = c0.z; cs[3] = c0.w; cs[4] = c1.x; cs[5] = c1.y; cs[6] = c1.z; cs[7] = c1.w;
                        sn[0] = s0.x; sn[1] = s0.y; sn[2] = s0.z; sn[3] = s0.w; sn[4] = s1.x; sn[5] = s1.y; sn[6] = s1.z; sn[7] = s1.w; }
                    v4u pc[2];
#pragma unroll
                    for (int bj = 0; bj < 2; ++bj) {
                        const f32x4 v0 = acc[ai][bj][m][0], v1 = acc[ai][bj][m][1];
                        float x[8] = {v0.x, v0.y, v0.z, v0.w, v1.x, v1.y, v1.z, v1.w};
                        if (ropew && bj == 0) {
#pragma unroll
                            for (int i = 0; i < 8; ++i) { const float o = __shfl_xor(x[i], 16);
                                const float a = x[i] * cs[i] - o * sn[i];
                                const float b = o * sn[i] + x[i] * cs[i];
                                x[i] = (fq == 0) ? a : (fq == 1) ? b : x[i]; }
                        }
                        if (isk) {
#pragma unroll
                            for (int i = 0; i < 8; ++i) ks[bj][i] += x[i];
                        }
                        v4u w; w.x = cvt_pk_bf16(x[0] * sc, x[1] * sc); w.y = cvt_pk_bf16(x[2] * sc, x[3] * sc); w.z = cvt_pk_bf16(x[4] * sc, x[5] * sc); w.w = cvt_pk_bf16(x[6] * sc, x[7] * sc);
                        pc[bj] = w;
                    }
                    { bf16* ra = base + (size_t)(rg0 + ai * 128 + m * 16) * 512; store_rows128(ra, ra + 8 * 512, fr, fq, pc[0], pc[1]); }
                }
            if (isk) {
                const int b = u.row0 / SEQ_, blk = (u.row0 % SEQ_) / 256;
#pragma unroll
                for (int bj = 0; bj < 2; ++bj)
#pragma unroll
                    for (int i = 0; i < 8; ++i) { float s = ks[bj][i]; s += __shfl_xor(s, 1); s += __shfl_xor(s, 2); s += __shfl_xor(s, 4); s += __shfl_xor(s, 8);
                        if (fr == 0) { const int c = (pn - 2) * 256 + bj * 32 + ct0 + i; atomicAdd(kmean + ((size_t)((b * NH_ + (c >> 6)) * NBLK_ + blk)) * 64 + (c & 63), s * (1.0f / 256.0f)); } }
            }
        } else {
            bf16* base = Gt + (size_t)((pn - 12) >> 2) * T_ * 1024 + (size_t)((pn - 12) & 3) * 256 + wc * 64;
#pragma unroll
            for (int ai = 0; ai < 2; ++ai)
#pragma unroll
                for (int m = 0; m < 4; ++m) { v4u pc[2];
#pragma unroll
                    for (int bj = 0; bj < 2; ++bj) { const f32x4 v0 = acc[ai][bj][m][0], v1 = acc[ai][bj][m][1];
                        v4u w; w.x = cvt_pk_bf16(sigmoidf_(v0.x), sigmoidf_(v0.y)); w.y = cvt_pk_bf16(sigmoidf_(v0.z), sigmoidf_(v0.w)); w.z = cvt_pk_bf16(sigmoidf_(v1.x), sigmoidf_(v1.y)); w.w = cvt_pk_bf16(sigmoidf_(v1.z), sigmoidf_(v1.w));
                        pc[bj] = w; }
                    bf16* ra = base + (size_t)(rg0 + ai * 128 + m * 16) * 1024; store_rows128(ra, ra + 8 * 1024, fr, fq, pc[0], pc[1]); }
        }
    }
};

template <bool ADD> struct EpiGate {
    static constexpr bool PERM = true;
    bf16* O; const bf16* gate;
    __device__ __forceinline__ void operator()(AccRef acc, const pg8::Unit& u, int wr, int wc, int fr, int fq) const {
        const int row0 = u.row0 + wr * 64 + fr, col0 = u.pn * 256 + wc * 64 + 8 * fq, rg0 = u.row0 + wr * 64 + (fr & 7);
#pragma unroll
        for (int ai = 0; ai < 2; ++ai) {
            v4u g[4][2], p[4][2];
#pragma unroll
            for (int m = 0; m < 4; ++m)
#pragma unroll
                for (int bj = 0; bj < 2; ++bj) { const size_t off = (size_t)(row0 + ai * 128 + m * 16) * 1024 + col0 + bj * 32; g[m][bj] = *(const v4u*)(gate + off); if (ADD) p[m][bj] = *(const v4u*)(O + off); }
            asm volatile("" ::: "memory");
#pragma unroll
            for (int m = 0; m < 4; ++m) { v4u pc[2];
#pragma unroll
                for (int bj = 0; bj < 2; ++bj) { const f32x4 v0 = acc[ai][bj][m][0], v1 = acc[ai][bj][m][1]; const v4u gg = g[m][bj];
                    float y[8] = {bf_lo(gg.x) * v0.x, bf_hi(gg.x) * v0.y, bf_lo(gg.y) * v0.z, bf_hi(gg.y) * v0.w, bf_lo(gg.z) * v1.x, bf_hi(gg.z) * v1.y, bf_lo(gg.w) * v1.z, bf_hi(gg.w) * v1.w};
                    if (ADD) { const v4u pp = p[m][bj]; y[0] += bf_lo(pp.x); y[1] += bf_hi(pp.x); y[2] += bf_lo(pp.y); y[3] += bf_hi(pp.y); y[4] += bf_lo(pp.z); y[5] += bf_hi(pp.z); y[6] += bf_lo(pp.w); y[7] += bf_hi(pp.w); }
                    v4u w; w.x = cvt_pk_bf16(y[0], y[1]); w.y = cvt_pk_bf16(y[2], y[3]); w.z = cvt_pk_bf16(y[4], y[5]); w.w = cvt_pk_bf16(y[6], y[7]);
                    pc[bj] = w; }
                bf16* ra = O + (size_t)(rg0 + ai * 128 + m * 16) * 1024 + u.pn * 256 + wc * 64; store_rows128(ra, ra + 8 * 1024, fr, fq, pc[0], pc[1]); }
            asm volatile("" ::: "memory");
        }
    }
};

template <bool RBF> struct EpiRes {
    static constexpr bool PERM = true;
    bf16* O; const void* R;
    __device__ __forceinline__ void operator()(AccRef acc, const pg8::Unit& u, int wr, int wc, int fr, int fq) const {
        const int row0 = u.row0 + wr * 64 + fr, col0 = u.pn * 256 + wc * 64 + 8 * fq, rg0 = u.row0 + wr * 64 + (fr & 7);
#pragma unroll
        for (int ai = 0; ai < 2; ++ai) {
            f32x4 ra[4][2], rb[4][2]; v4u rh[4][2];
#pragma unroll
            for (int m = 0; m < 4; ++m)
#pragma unroll
                for (int bj = 0; bj < 2; ++bj) { const size_t off = (size_t)(row0 + ai * 128 + m * 16) * D_ + col0 + bj * 32;
                    if (RBF) rh[m][bj] = *(const v4u*)((const bf16*)R + off); else { ra[m][bj] = *(const f32x4*)((const float*)R + off); rb[m][bj] = *(const f32x4*)((const float*)R + off + 4); } }
            asm volatile("" ::: "memory");
#pragma unroll
            for (int m = 0; m < 4; ++m) { v4u pc[2];
#pragma unroll
                for (int bj = 0; bj < 2; ++bj) { const f32x4 v0 = acc[ai][bj][m][0], v1 = acc[ai][bj][m][1];
                    float r[8];
                    if (RBF) { const v4u h = rh[m][bj]; r[0] = bf_lo(h.x); r[1] = bf_hi(h.x); r[2] = bf_lo(h.y); r[3] = bf_hi(h.y); r[4] = bf_lo(h.z); r[5] = bf_hi(h.z); r[6] = bf_lo(h.w); r[7] = bf_hi(h.w); }
                    else { const f32x4 a = ra[m][bj], b = rb[m][bj]; r[0] = a.x; r[1] = a.y; r[2] = a.z; r[3] = a.w; r[4] = b.x; r[5] = b.y; r[6] = b.z; r[7] = b.w; }
                    v4u w; w.x = cvt_pk_bf16(r[0] * DN_ALPHA_ + v0.x, r[1] * DN_ALPHA_ + v0.y); w.y = cvt_pk_bf16(r[2] * DN_ALPHA_ + v0.z, r[3] * DN_ALPHA_ + v0.w);
                    w.z = cvt_pk_bf16(r[4] * DN_ALPHA_ + v1.x, r[5] * DN_ALPHA_ + v1.y); w.w = cvt_pk_bf16(r[6] * DN_ALPHA_ + v1.z, r[7] * DN_ALPHA_ + v1.w);
                    pc[bj] = w; }
                bf16* rowa = O + (size_t)(rg0 + ai * 128 + m * 16) * D_ + u.pn * 256 + wc * 64; store_rows128(rowa, rowa + 8 * D_, fr, fq, pc[0], pc[1]); }
            asm volatile("" ::: "memory");
        }
    }
};

__device__ __forceinline__ void swiglu_store(AccRef acc, bf16* Hrow0  , int ld, int wr, int wc, int fr, int fq) {
#pragma unroll
    for (int ai = 0; ai < 2; ++ai)
#pragma unroll
        for (int m = 0; m < 4; ++m) { bf16* hp = Hrow0 + (size_t)(wr * 64 + fr + ai * 128 + m * 16) * ld + wc * 32 + 8 * fq;
            float y[8];
#pragma unroll
            for (int n = 0; n < 2; ++n)
#pragma unroll
                for (int j = 0; j < 4; ++j) { const float g = acc[ai][0][m][n][j], up = acc[ai][1][m][n][j]; y[n * 4 + j] = g * sigmoidf_(g) * up; }
            v4u w; w.x = cvt_pk_bf16(y[0], y[1]); w.y = cvt_pk_bf16(y[2], y[3]); w.z = cvt_pk_bf16(y[4], y[5]); w.w = cvt_pk_bf16(y[6], y[7]);
            *(v4u*)hp = w; asm volatile("" ::: "memory"); }
}
struct EpiShRouter {
    static constexpr bool PERM = true;
    bf16* Hs; float* logits;
    __device__ __forceinline__ void operator()(AccRef acc, const pg8::Unit& u, int wr, int wc, int fr, int fq) const {
        if (u.pn < 2) { swiglu_store(acc, Hs + (size_t)u.row0 * 256 + u.pn * 128, 256, wr, wc, fr, fq); return; }
#pragma unroll
        for (int ai = 0; ai < 2; ++ai)
#pragma unroll
            for (int m = 0; m < 4; ++m) { float* lp = logits + (size_t)(u.row0 + wr * 64 + fr + ai * 128 + m * 16) * 256 + wc * 64 + 8 * fq;
#pragma unroll
                for (int bj = 0; bj < 2; ++bj) { *(f32x4*)(lp + bj * 32) = acc[ai][bj][m][0]; *(f32x4*)(lp + bj * 32 + 4) = acc[ai][bj][m][1]; } asm volatile("" ::: "memory"); }
    }
};
struct EpiMoeUp {
    static constexpr bool PERM = true;
    bf16* H;
    __device__ __forceinline__ void operator()(AccRef acc, const pg8::Unit& u, int wr, int wc, int fr, int fq) const { swiglu_store(acc, H + (size_t)u.row0 * 256 + u.pn * 128, 256, wr, wc, fr, fq); }
};
struct EpiMoeDown {
    static constexpr bool PERM = true;
    unsigned char* Y8; const int* row_dst; const float* row_w;
    __device__ __forceinline__ void operator()(AccRef acc, const pg8::Unit& u, int wr, int wc, int fr, int fq) const {
        const int s0 = u.row0 + wr * 64 + fr, colw = u.pn * 256 + wc * 64;
        int dsts[2][4]; float ws_[2][4];
#pragma unroll
        for (int ai = 0; ai < 2; ++ai)
#pragma unroll
            for (int m = 0; m < 4; ++m) { const int slot = s0 + ai * 128 + m * 16; dsts[ai][m] = row_dst[slot]; ws_[ai][m] = row_w[slot]; }
        asm volatile("" ::: "memory");
        const bool even = (fq & 1) == 0;
#pragma unroll
        for (int ai = 0; ai < 2; ++ai)
#pragma unroll
            for (int m = 0; m < 4; ++m) { const float w = ws_[ai][m]; u32x2 pc[2];
#pragma unroll
                for (int bj = 0; bj < 2; ++bj) { const f32x4 v0 = acc[ai][bj][m][0] * w, v1 = acc[ai][bj][m][1] * w;
                    int lo = 0, hi = 0; lo = __builtin_amdgcn_cvt_pk_fp8_f32(v0.x, v0.y, lo, false); lo = __builtin_amdgcn_cvt_pk_fp8_f32(v0.z, v0.w, lo, true);
                    hi = __builtin_amdgcn_cvt_pk_fp8_f32(v1.x, v1.y, hi, false); hi = __builtin_amdgcn_cvt_pk_fp8_f32(v1.z, v1.w, hi, true);
                    pc[bj].x = (unsigned)lo; pc[bj].y = (unsigned)hi; }
                const u32x2 snd = even ? pc[1] : pc[0]; u32x2 rcv; rcv.x = __shfl_xor(snd.x, 16); rcv.y = __shfl_xor(snd.y, 16);
                v4u o; if (even) { o.x = pc[0].x; o.y = pc[0].y; o.z = rcv.x; o.w = rcv.y; } else { o.x = rcv.x; o.y = rcv.y; o.z = pc[1].x; o.w = pc[1].y; }
                const int dst = dsts[ai][m];
                if (dst >= 0) *(v4u*)(Y8 + (size_t)dst * 1024 + colw + (even ? 8 * fq : 32 + 8 * (fq - 1))) = o; }
    }
};
struct EpiBf16Plain {
    static constexpr bool PERM = true;
    bf16* O; int ldc;
    __device__ __forceinline__ void operator()(AccRef acc, const pg8::Unit& u, int wr, int wc, int fr, int fq) const {
        const int rg0 = u.row0 + wr * 64 + (fr & 7), colw = u.pn * 256 + wc * 64;
#pragma unroll
        for (int ai = 0; ai < 2; ++ai)
#pragma unroll
            for (int m = 0; m < 4; ++m) { v4u pc[2];
#pragma unroll
                for (int bj = 0; bj < 2; ++bj) { const f32x4 v0 = acc[ai][bj][m][0], v1 = acc[ai][bj][m][1];
                    v4u o; o.x = cvt_pk_bf16(v0.x, v0.y); o.y = cvt_pk_bf16(v0.z, v0.w); o.z = cvt_pk_bf16(v1.x, v1.y); o.w = cvt_pk_bf16(v1.z, v1.w); pc[bj] = o; }
                bf16* ra = O + (size_t)(rg0 + ai * 128 + m * 16) * ldc + colw; store_rows128(ra, ra + (size_t)8 * ldc, fr, fq, pc[0], pc[1]); }
    }
};
struct EpiPle {
    static constexpr bool PERM = true;
    bf16* X; const bf16* Hres; const bf16* PP;
    __device__ __forceinline__ void operator()(AccRef acc, const pg8::Unit& u, int wr, int wc, int fr, int fq) const {
        const int row0 = u.row0 + wr * 64 + fr, col0 = u.pn * 256 + wc * 64 + 8 * fq, rg0 = u.row0 + wr * 64 + (fr & 7);
#pragma unroll
        for (int ai = 0; ai < 2; ++ai) {
            v4u pv[4][2], hv[4][2];
#pragma unroll
            for (int m = 0; m < 4; ++m)
#pragma unroll
                for (int bj = 0; bj < 2; ++bj) { const size_t ro = (size_t)(row0 + ai * 128 + m * 16) * D_ + col0 + bj * 32; pv[m][bj] = *(const v4u*)(PP + ro); hv[m][bj] = *(const v4u*)(Hres + ro); }
            asm volatile("" ::: "memory");
#pragma unroll
            for (int m = 0; m < 4; ++m) { v4u pc[2];
#pragma unroll
                for (int bj = 0; bj < 2; ++bj) { const f32x4 v0 = acc[ai][bj][m][0], v1 = acc[ai][bj][m][1];
                    const v4u p = pv[m][bj], h = hv[m][bj];
                    f32x4 o0, o1;
                    o0.x = bf_lo(h.x) * DN_ALPHA_ + sigmoidf_(v0.x) * bf_lo(p.x); o0.y = bf_hi(h.x) * DN_ALPHA_ + sigmoidf_(v0.y) * bf_hi(p.x); o0.z = bf_lo(h.y) * DN_ALPHA_ + sigmoidf_(v0.z) * bf_lo(p.y); o0.w = bf_hi(h.y) * DN_ALPHA_ + sigmoidf_(v0.w) * bf_hi(p.y);
                    o1.x = bf_lo(h.z) * DN_ALPHA_ + sigmoidf_(v1.x) * bf_lo(p.z); o1.y = bf_hi(h.z) * DN_ALPHA_ + sigmoidf_(v1.y) * bf_hi(p.z); o1.z = bf_lo(h.w) * DN_ALPHA_ + sigmoidf_(v1.z) * bf_lo(p.w); o1.w = bf_hi(h.w) * DN_ALPHA_ + sigmoidf_(v1.w) * bf_hi(p.w);
                    v4u w; w.x = cvt_pk_bf16(o0.x, o0.y); w.y = cvt_pk_bf16(o0.z, o0.w); w.z = cvt_pk_bf16(o1.x, o1.y); w.w = cvt_pk_bf16(o1.z, o1.w); pc[bj] = w; }
                bf16* rowa = X + (size_t)(rg0 + ai * 128 + m * 16) * D_ + u.pn * 256 + wc * 64; store_rows128(rowa, rowa + 8 * D_, fr, fq, pc[0], pc[1]); }
            asm volatile("" ::: "memory");
        }
    }
};

struct EpiNull { static constexpr bool PERM = true; __device__ __forceinline__ void operator()(AccRef acc, const pg8::Unit& u, int, int, int, int) const { if (u.row0 == -12345) { float* p = nullptr; p[0] = acc[0][0][0][0].x; } } };
struct PPOrder {
    static constexpr bool GATHER = false;
    const char* A; const char* Bt; int K, c;
    __device__ __forceinline__ bool next(int i, pg8::Unit& u) const {
        int pm, pn; if (c < 128) { if (i >= 1) return false; pm = c; pn = 3; } else { if (i >= 3 || c >= 256) return false; pm = c - 128; pn = i; }
        u.a = A + (size_t)pm * 256 * K * 2; u.b = Bt + (size_t)pn * 256 * K * 2; u.row0 = pm * 256; u.pn = pn; u.e = 0; return true;
    }
};
__device__ __forceinline__ void moe_tables(Frame& F) {
    const int lane_ = lane_id(), tid_ = F.wave * 64 + lane_; (void)tid_;
    LAS unsigned* PST = (LAS unsigned*)(F.lds + LX_PST); LAS unsigned* NB = (LAS unsigned*)(F.lds + LX_NB); LAS unsigned short* BLKE = (LAS unsigned short*)(F.lds + LX_BLKE);
    const unsigned* gcount = (const unsigned*)(F.ws + WS_GCOUNT);
    __syncthreads();
    if (tid_ < 256) NB[tid_] = (gcount[tid_] + 255u) >> 8;
    __syncthreads();
    if (tid_ < 256) { const int pe = (tid_ & 7) * 32 + (tid_ >> 3); unsigned s = 0, tot = 0; for (int j = 0; j < 256; ++j) { const unsigned nbj = NB[j]; tot += nbj; if (((j & 7) * 32 + (j >> 3)) < pe) s += nbj; }
        PST[tid_] = s * 256u; if (tid_ == 255) PST[256] = tot;
        LAS unsigned* XS = (LAS unsigned*)(F.lds + LX_XS); if (tid_ < 8) XS[tid_] = s; if (tid_ == 8) XS[8] = tot;
        const unsigned nb = NB[tid_]; for (unsigned i = 0; i < nb; ++i) BLKE[s + i] = (unsigned short)tid_; }
    __syncthreads();
}
struct MoeUpOrder {
    static constexpr bool GATHER = true;
    const LAS unsigned short* blke; const LAS unsigned* xs; const int* row_tok; const char* A; const char* Bt; int wpl, vcu;
    __device__ __forceinline__ bool next(int i, pg8::Unit& u) const {
        const int x = vcu / wpl, n = i * wpl + (vcu % wpl); if (x >= 8) return false;
        const int b0 = (int)xs[x], b1 = (int)xs[x + 1], rbl = n >> 1, pn = n & 1; if (rbl >= b1 - b0) return false;
        const int rb = b0 + rbl; const int e = __builtin_amdgcn_readfirstlane((int)blke[rb]);
        u.a = A; u.b = Bt + ((size_t)e * 512 + pn * 256) * 1024 * 2; u.row0 = rb * 256; u.pn = pn; u.e = e; return true;
    }
    __device__ __forceinline__ void aoff(const pg8::Unit& u, int tid, unsigned (&v)[2][2]) const {
#pragma unroll
        for (int i = 0; i < 2; ++i) { int R, C; pg8::stage_rc(tid * 16 + i * 8192, R, C);
#pragma unroll
            for (int h = 0; h < 2; ++h) { const int tok = row_tok[u.row0 + h * 128 + R]; v[h][i] = (unsigned)(tok * 1024 + C) * 2u; } }
    }
};
struct MoeDownOrder {
    static constexpr bool GATHER = false;
    const LAS unsigned short* blke; const LAS unsigned* xs; const char* A; const char* Bt; int wpl, vcu;
    __device__ __forceinline__ bool next(int i, pg8::Unit& u) const {
        const int x = vcu / wpl, n = i * wpl + (vcu % wpl); if (x >= 8) return false;
        const int b0 = (int)xs[x], b1 = (int)xs[x + 1], rbl = n >> 2, pn = n & 3; if (rbl >= b1 - b0) return false;
        const int rb = b0 + rbl; const int e = __builtin_amdgcn_readfirstlane((int)blke[rb]);
        u.a = A + (size_t)rb * 256 * 256 * 2; u.b = Bt + ((size_t)e * 1024 + pn * 256) * 256 * 2; u.row0 = rb * 256; u.pn = pn; u.e = e; return true;
    }
};

__device__ __forceinline__ void p_conv(Frame& F, const float* conv_w) {
    const int lane_ = lane_id(), tid_ = F.wave * 64 + lane_; (void)tid_;
    bf16* cb = (bf16*)(F.ws + WS_S6) + (size_t)3 * T_ * 512; const bf16* cc = (const bf16*)(F.ws + WS_S6) + (size_t)4 * T_ * 512; const bf16* ch = (const bf16*)(F.ws + WS_S6) + (size_t)5 * T_ * 512;
    const int gw = F.vcu * NWAVES + F.wave, NGW = F.G * NWAVES, c0 = lane_ * 8;
    float w0[8], w1[8], w2[8];
#pragma unroll
    for (int i = 0; i < 8; ++i) { w0[i] = conv_w[c0 + i]; w1[i] = conv_w[512 + c0 + i]; w2[i] = conv_w[1024 + c0 + i]; }
    for (int ck = gw; ck < T_ / 32; ck += NGW) {
        const int t0 = ck * 32;
        float u1[8], u2[8];
#pragma unroll
        for (int i = 0; i < 8; ++i) { u1[i] = 0.f; u2[i] = 0.f; }
        if ((t0 & (SEQ_ - 1)) != 0) {
            const v4u a2 = *(const v4u*)(cc + (size_t)(t0 - 2) * 512 + c0), b2 = *(const v4u*)(ch + (size_t)(t0 - 2) * 512 + c0);
            const v4u a1 = *(const v4u*)(cc + (size_t)(t0 - 1) * 512 + c0), b1 = *(const v4u*)(ch + (size_t)(t0 - 1) * 512 + c0);
            u2[0] = bf_lo(a2.x) * bf_lo(b2.x); u2[1] = bf_hi(a2.x) * bf_hi(b2.x); u2[2] = bf_lo(a2.y) * bf_lo(b2.y); u2[3] = bf_hi(a2.y) * bf_hi(b2.y);
            u2[4] = bf_lo(a2.z) * bf_lo(b2.z); u2[5] = bf_hi(a2.z) * bf_hi(b2.z); u2[6] = bf_lo(a2.w) * bf_lo(b2.w); u2[7] = bf_hi(a2.w) * bf_hi(b2.w);
            u1[0] = bf_lo(a1.x) * bf_lo(b1.x); u1[1] = bf_hi(a1.x) * bf_hi(b1.x); u1[2] = bf_lo(a1.y) * bf_lo(b1.y); u1[3] = bf_hi(a1.y) * bf_hi(b1.y);
            u1[4] = bf_lo(a1.z) * bf_lo(b1.z); u1[5] = bf_hi(a1.z) * bf_hi(b1.z); u1[6] = bf_lo(a1.w) * bf_lo(b1.w); u1[7] = bf_hi(a1.w) * bf_hi(b1.w);
        }
#pragma unroll 4
        for (int t = t0; t < t0 + 32; ++t) {
            const v4u a = *(const v4u*)(cc + (size_t)t * 512 + c0), b = *(const v4u*)(ch + (size_t)t * 512 + c0), g = *(const v4u*)(cb + (size_t)t * 512 + c0);
            float u0[8] = {bf_lo(a.x) * bf_lo(b.x), bf_hi(a.x) * bf_hi(b.x), bf_lo(a.y) * bf_lo(b.y), bf_hi(a.y) * bf_hi(b.y), bf_lo(a.z) * bf_lo(b.z), bf_hi(a.z) * bf_hi(b.z), bf_lo(a.w) * bf_lo(b.w), bf_hi(a.w) * bf_hi(b.w)};
            const float gb[8] = {bf_lo(g.x), bf_hi(g.x), bf_lo(g.y), bf_hi(g.y), bf_lo(g.z), bf_hi(g.z), bf_lo(g.w), bf_hi(g.w)};
            float y[8];
#pragma unroll
            for (int i = 0; i < 8; ++i) { y[i] = gb[i] * (w0[i] * u2[i] + w1[i] * u1[i] + w2[i] * u0[i]); u2[i] = u1[i]; u1[i] = u0[i]; }
            v4u o; o.x = cvt_pk_bf16(y[0], y[1]); o.y = cvt_pk_bf16(y[2], y[3]); o.z = cvt_pk_bf16(y[4], y[5]); o.w = cvt_pk_bf16(y[6], y[7]);
            *(v4u*)(cb + (size_t)t * 512 + c0) = o;
        }
    }
}
__device__ __forceinline__ void p_select(Frame& F) {
    const int lane_ = lane_id(), tid_ = F.wave * 64 + lane_; (void)tid_;
    const bf16* Q = (const bf16*)(F.ws + WS_S6); const float* kmean = (const float*)(F.ws + WS_KMEAN); unsigned* SEL = (unsigned*)(F.ws + WS_SEL);
    const int gt = F.vcu * 512 + tid_, NT = F.G * 512;
    for (int it = gt; it < NB_ * NH_ * SEQ_; it += NT) {
        const int s = it & (SEQ_ - 1), bh = it >> 12, b = bh >> 3, h = bh & 7;
        const int own = __builtin_amdgcn_readfirstlane(s >> 8);
        const int bhu = __builtin_amdgcn_readfirstlane(bh);
        float q[64];
        const bf16* qp = Q + ((size_t)(b * SEQ_ + s)) * 512 + h * 64;
#pragma unroll
        for (int i = 0; i < 8; ++i) { const v4u w = *(const v4u*)(qp + i * 8); q[i * 8 + 0] = bf_lo(w.x); q[i * 8 + 1] = bf_hi(w.x); q[i * 8 + 2] = bf_lo(w.y); q[i * 8 + 3] = bf_hi(w.y); q[i * 8 + 4] = bf_lo(w.z); q[i * 8 + 5] = bf_hi(w.z); q[i * 8 + 6] = bf_lo(w.w); q[i * 8 + 7] = bf_hi(w.w); }
        float v0 = -INFINITY, v1 = -INFINITY, v2 = -INFINITY; int i0 = -1, i1 = -1, i2 = -1;
        for (int j = 0; j < own; ++j) {
            const float* km = kmean + ((size_t)(bhu * NBLK_ + j)) * 64;
            float d = 0.f;
#pragma unroll
            for (int i = 0; i < 64; ++i) d += q[i] * km[i];
            if (d > v0) { v2 = v1; i2 = i1; v1 = v0; i1 = i0; v0 = d; i0 = j; }
            else if (d > v1) { v2 = v1; i2 = i1; v1 = d; i1 = j; }
            else if (d > v2) { v2 = d; i2 = j; }
        }
        unsigned m = 0u; if (i0 >= 0) m |= 1u << i0; if (i1 >= 0) m |= 1u << i1; if (i2 >= 0) m |= 1u << i2;
        SEL[it] = m;
    }
}

struct AttnOrder {
    int vcu;
    __device__ __forceinline__ bool next(int i, int& bh, int& qb) const { if (i >= 4 || vcu >= 256) return false; const int j = vcu & 3; bh = vcu >> 2; qb = (i == 0) ? 15 - j : (i == 1) ? 8 + j : (i == 2) ? 7 - j : j; return true; }
};

template <bool ADD_Y, bool WRITE_F32, bool WRITE_BF>
__device__ __forceinline__ void ln_row(Frame& F, const bf16* src, float* dst, bf16* dstb, const float* gam, const float* bet, const bf16* y0, const bf16* y1, int row) {
    const int lane_ = lane_id();
    float v[2][8];
#pragma unroll
    for (int h = 0; h < 2; ++h) { const v4u w = *(const v4u*)(src + (size_t)row * D_ + 512 * h + lane_ * 8);
        v[h][0] = bf_lo(w.x); v[h][1] = bf_hi(w.x); v[h][2] = bf_lo(w.y); v[h][3] = bf_hi(w.y); v[h][4] = bf_lo(w.z); v[h][5] = bf_hi(w.z); v[h][6] = bf_lo(w.w); v[h][7] = bf_hi(w.w); }
    if (ADD_Y) {
        const bf16* yb = (row < T_ / 2) ? y0 + (size_t)row * 8 * 1024 : y1 + (size_t)(row - T_ / 2) * 8 * 1024;
#pragma unroll
        for (int k = 0; k < 8; ++k)
#pragma unroll
            for (int h = 0; h < 2; ++h) { const v4u w = *(const v4u*)(yb + (size_t)k * 1024 + 512 * h + lane_ * 8);
                v[h][0] += bf_lo(w.x); v[h][1] += bf_hi(w.x); v[h][2] += bf_lo(w.y); v[h][3] += bf_hi(w.y); v[h][4] += bf_lo(w.z); v[h][5] += bf_hi(w.z); v[h][6] += bf_lo(w.w); v[h][7] += bf_hi(w.w); }
    }
    float s = 0.f;
#pragma unroll
    for (int h = 0; h < 2; ++h)
#pragma unroll
        for (int i = 0; i < 8; ++i) s += v[h][i];
    const float mean = wave_sum(s) * (1.f / D_); float s2 = 0.f;
#pragma unroll
    for (int h = 0; h < 2; ++h)
#pragma unroll
        for (int i = 0; i < 8; ++i) { v[h][i] -= mean; s2 += v[h][i] * v[h][i]; }
    const float rstd = 1.f / sqrtf(wave_sum(s2) * (1.f / D_) + LN_EPS_);
#pragma unroll
    for (int h = 0; h < 2; ++h) { const int c0 = 512 * h + lane_ * 8;
        const f32x4 g0 = *(const f32x4*)(gam + c0), g1 = *(const f32x4*)(gam + c0 + 4), b0 = *(const f32x4*)(bet + c0), b1 = *(const f32x4*)(bet + c0 + 4);
        f32x4 o0, o1; o0.x = v[h][0] * rstd * g0.x + b0.x; o0.y = v[h][1] * rstd * g0.y + b0.y; o0.z = v[h][2] * rstd * g0.z + b0.z; o0.w = v[h][3] * rstd * g0.w + b0.w;
        o1.x = v[h][4] * rstd * g1.x + b1.x; o1.y = v[h][5] * rstd * g1.y + b1.y; o1.z = v[h][6] * rstd * g1.z + b1.z; o1.w = v[h][7] * rstd * g1.w + b1.w;
        if (WRITE_F32) { *(f32x4*)(dst + (size_t)row * D_ + c0) = o0; *(f32x4*)(dst + (size_t)row * D_ + c0 + 4) = o1; }
        if (WRITE_BF) { v4u w; w.x = cvt_pk_bf16(o0.x, o0.y); w.y = cvt_pk_bf16(o0.z, o0.w); w.z = cvt_pk_bf16(o1.x, o1.y); w.w = cvt_pk_bf16(o1.z, o1.w); *(v4u*)(dstb + (size_t)row * D_ + c0) = w; } }
}

__device__ __forceinline__ void ln2_row(Frame& F, const bf16* src, bf16* dstb, const float* gam, const float* bet, const unsigned char* y8, int row) {
    const int lane_ = lane_id(); const int c0 = lane_ * 16;
    float v[16];
    { const v4u a = *(const v4u*)(src + (size_t)row * D_ + c0), b = *(const v4u*)(src + (size_t)row * D_ + c0 + 8);
      v[0] = bf_lo(a.x); v[1] = bf_hi(a.x); v[2] = bf_lo(a.y); v[3] = bf_hi(a.y); v[4] = bf_lo(a.z); v[5] = bf_hi(a.z); v[6] = bf_lo(a.w); v[7] = bf_hi(a.w);
      v[8] = bf_lo(b.x); v[9] = bf_hi(b.x); v[10] = bf_lo(b.y); v[11] = bf_hi(b.y); v[12] = bf_lo(b.z); v[13] = bf_hi(b.z); v[14] = bf_lo(b.w); v[15] = bf_hi(b.w); }
    v4u yw[8];
#pragma unroll
    for (int k = 0; k < 8; ++k) yw[k] = *(const v4u*)(y8 + ((size_t)row * 8 + k) * 1024 + c0);
#pragma unroll
    for (int k = 0; k < 8; ++k) { const unsigned wv[4] = {yw[k].x, yw[k].y, yw[k].z, yw[k].w};
#pragma unroll
        for (int q = 0; q < 4; ++q) { const f32x2 a = __builtin_amdgcn_cvt_pk_f32_fp8((int)wv[q], false), b = __builtin_amdgcn_cvt_pk_f32_fp8((int)wv[q], true);
            v[4 * q + 0] += a.x; v[4 * q + 1] += a.y; v[4 * q + 2] += b.x; v[4 * q + 3] += b.y; } }
    float s = 0.f;
#pragma unroll
    for (int i = 0; i < 16; ++i) s += v[i];
    const float mean = wave_sum(s) * (1.f / D_); float s2 = 0.f;
#pragma unroll
    for (int i = 0; i < 16; ++i) { v[i] -= mean; s2 += v[i] * v[i]; }
    const float rstd = 1.f / sqrtf(wave_sum(s2) * (1.f / D_) + LN_EPS_);
    float o[16];
#pragma unroll
    for (int q = 0; q < 4; ++q) { const f32x4 g = *(const f32x4*)(gam + c0 + 4 * q), bb = *(const f32x4*)(bet + c0 + 4 * q);
        o[4 * q] = v[4 * q] * rstd * g.x + bb.x; o[4 * q + 1] = v[4 * q + 1] * rstd * g.y + bb.y; o[4 * q + 2] = v[4 * q + 2] * rstd * g.z + bb.z; o[4 * q + 3] = v[4 * q + 3] * rstd * g.w + bb.w; }
    v4u w0, w1; w0.x = cvt_pk_bf16(o[0], o[1]); w0.y = cvt_pk_bf16(o[2], o[3]); w0.z = cvt_pk_bf16(o[4], o[5]); w0.w = cvt_pk_bf16(o[6], o[7]);
    w1.x = cvt_pk_bf16(o[8], o[9]); w1.y = cvt_pk_bf16(o[10], o[11]); w1.z = cvt_pk_bf16(o[12], o[13]); w1.w = cvt_pk_bf16(o[14], o[15]);
    *(v4u*)(dstb + (size_t)row * D_ + c0) = w0; *(v4u*)(dstb + (size_t)row * D_ + c0 + 8) = w1;
}

__device__ __forceinline__ void p_route(Frame& F, const float* router_bias) {
    const int lane_ = lane_id(), tid_ = F.wave * 64 + lane_; (void)tid_;
    LAS unsigned* hist = (LAS unsigned*)(F.lds + LX_HIST);
    const float* logits = (const float*)(F.ws + WS_LOGITS);
    int* topi = (int*)(F.ws + WS_TOPI); float* topw = (float*)(F.ws + WS_TOPW); int* lrank = (int*)(F.ws + WS_LRANK);
    unsigned* gcount = (unsigned*)(F.ws + WS_GCOUNT); unsigned* wgbase = (unsigned*)(F.ws + WS_WGBASE);
    { int* row_tok = (int*)(F.ws + WS_ROWTOK); int* row_dst = (int*)(F.ws + WS_ROWDST); float* row_w = (float*)(F.ws + WS_ROWW);
      for (int i = blockIdx.x * 512 + tid_; i < RMAX_; i += F.G * 512) { row_tok[i] = 0; row_dst[i] = -1; row_w[i] = 0.f; } }
    if (tid_ < 256) hist[tid_] = 0u;
    __syncthreads();
    const int lane = lane_;
    const f32x4 bias = *(const f32x4*)(router_bias + lane * 4);
    constexpr int NTK = 4;
    const int tstride = F.G * 8;
    for (int tok0 = blockIdx.x * 8 + F.wave; tok0 < T_; tok0 += NTK * tstride) {
        float sc[NTK][4], c[NTK][4]; bool live[NTK];
#pragma unroll
        for (int t = 0; t < NTK; ++t) { const int tok = tok0 + t * tstride; live[t] = tok < T_; const f32x4 lg = *(const f32x4*)(logits + (size_t)(live[t] ? tok : tok0) * 256 + lane * 4);
            sc[t][0] = sigmoidf_(lg.x); sc[t][1] = sigmoidf_(lg.y); sc[t][2] = sigmoidf_(lg.z); sc[t][3] = sigmoidf_(lg.w);
            c[t][0] = sc[t][0] + bias.x; c[t][1] = sc[t][1] + bias.y; c[t][2] = sc[t][2] + bias.z; c[t][3] = sc[t][3] + bias.w; }
        float a1[NTK], a2[NTK];
#pragma unroll
        for (int t = 0; t < NTK; ++t) { a1[t] = fmaxf(c[t][0], c[t][1]); a2[t] = fminf(c[t][0], c[t][1]); const float b1 = fmaxf(c[t][2], c[t][3]), b2 = fminf(c[t][2], c[t][3]); const float n1 = fmaxf(a1[t], b1), n2 = fmaxf(fminf(a1[t], b1), fmaxf(a2[t], b2)); a1[t] = n1; a2[t] = n2; }
#pragma unroll
        for (int off = 1; off < 8; off <<= 1)
#pragma unroll
            for (int t = 0; t < NTK; ++t) { const float b1 = __shfl_xor(a1[t], off), b2 = __shfl_xor(a2[t], off); const float n1 = fmaxf(a1[t], b1), n2 = fmaxf(fminf(a1[t], b1), fmaxf(a2[t], b2)); a1[t] = n1; a2[t] = n2; }
        const int g = lane >> 3;
        int rank[NTK];
#pragma unroll
        for (int t = 0; t < NTK; ++t) rank[t] = 0;
#pragma unroll
        for (int j = 0; j < 8; ++j)
#pragma unroll
            for (int t = 0; t < NTK; ++t) { const float gs = a1[t] + a2[t]; const float sj = __shfl(gs, j * 8); rank[t] += (sj > gs || (sj == gs && j < g)) ? 1 : 0; }
#pragma unroll
        for (int t = 0; t < NTK; ++t) if (rank[t] >= 4) { c[t][0] = -INFINITY; c[t][1] = -INFINITY; c[t][2] = -INFINITY; c[t][3] = -INFINITY; }
        int ridx[NTK]; float rs[NTK];
#pragma unroll
        for (int t = 0; t < NTK; ++t) { ridx[t] = 0; rs[t] = 0.f; }
#pragma unroll
        for (int k = 0; k < 8; ++k) {
            float v[NTK]; int ix[NTK];
#pragma unroll
            for (int t = 0; t < NTK; ++t) { float bv = c[t][0]; int bi = 0; if (c[t][1] > bv) { bv = c[t][1]; bi = 1; } if (c[t][2] > bv) { bv = c[t][2]; bi = 2; } if (c[t][3] > bv) { bv = c[t][3]; bi = 3; } v[t] = bv; ix[t] = lane * 4 + bi; }
#pragma unroll
            for (int off = 1; off < 64; off <<= 1)
#pragma unroll
                for (int t = 0; t < NTK; ++t) { const float ov = __shfl_xor(v[t], off); const int oi = __shfl_xor(ix[t], off); if (ov > v[t] || (ov == v[t] && oi < ix[t])) { v[t] = ov; ix[t] = oi; } }
#pragma unroll
            for (int t = 0; t < NTK; ++t) { const int ol = ix[t] >> 2, oj = ix[t] & 3;
                const float ssel = (oj == 0) ? sc[t][0] : (oj == 1) ? sc[t][1] : (oj == 2) ? sc[t][2] : sc[t][3];
                const float sv = __shfl(ssel, ol);
                if (lane == ol) { if (oj == 0) c[t][0] = -INFINITY; else if (oj == 1) c[t][1] = -INFINITY; else if (oj == 2) c[t][2] = -INFINITY; else c[t][3] = -INFINITY; }
                if (lane == k) { ridx[t] = ix[t]; rs[t] = sv; } }
        }
#pragma unroll
        for (int t = 0; t < NTK; ++t) { const int tok = tok0 + t * tstride;
            float sum = (lane < 8) ? rs[t] : 0.f; sum += __shfl_xor(sum, 1); sum += __shfl_xor(sum, 2); sum += __shfl_xor(sum, 4);
            if (lane < 8 && live[t]) { const float w = rs[t] / sum * ROUTED_SCALE_;
                topi[tok * 8 + lane] = ridx[t]; topw[tok * 8 + lane] = w;
                const unsigned lr = __hip_atomic_fetch_add(&hist[ridx[t]], 1u, __ATOMIC_RELAXED, __HIP_MEMORY_SCOPE_WORKGROUP);
                lrank[tok * 8 + lane] = (int)lr; } }
    }
    __syncthreads();
    if (tid_ < 256) { const unsigned hc = hist[tid_]; const unsigned base = __hip_atomic_fetch_add(gcount + tid_, hc, RLX_AGENT); wgbase[blockIdx.x * 256 + tid_] = base; }
}
__device__ __forceinline__ void p_assign(Frame& F) {
    const int lane_ = lane_id(), tid_ = F.wave * 64 + lane_; (void)tid_;
    moe_tables(F);
    LAS unsigned* PST = (LAS unsigned*)(F.lds + LX_PST);
    const int* topi = (const int*)(F.ws + WS_TOPI); const float* topw = (const float*)(F.ws + WS_TOPW); const int* lrank = (const int*)(F.ws + WS_LRANK);
    const unsigned* wgbase = (const unsigned*)(F.ws + WS_WGBASE);
    int* row_tok = (int*)(F.ws + WS_ROWTOK); int* row_dst = (int*)(F.ws + WS_ROWDST); float* row_w = (float*)(F.ws + WS_ROWW);
    for (int tok = blockIdx.x * 8 + F.wave; tok < T_; tok += F.G * 8) {
        if (lane_ < 8) { const int e = topi[tok * 8 + lane_]; const unsigned slot = PST[e] + wgbase[blockIdx.x * 256 + e] + (unsigned)lrank[tok * 8 + lane_];
            row_tok[slot] = tok; row_dst[slot] = tok * 8 + lane_; row_w[slot] = topw[tok * 8 + lane_]; }
    }
}

__global__ void __launch_bounds__(NWAVES * 64, 2) fwd_kernel(Args args) {
    extern __shared__ __attribute__((aligned(16))) unsigned char lds[];
    Frame F;
    F.lds = (LAS unsigned char*)lds;
    F.MISC = (volatile LAS unsigned*)(F.lds + MISC_OFF);
    F.wave = __builtin_amdgcn_readfirstlane((int)threadIdx.x >> 6);
    F.G = gridDim.x; { const int bx = blockIdx.x; F.vcu = (F.G % 8 == 0) ? (bx % 8) * (F.G / 8) + bx / 8 : bx; }
    F.ws = args.ws; F.out = args.out;
    F.ctl = (gu32*)(args.ws + WS_CTL);
    unsigned char* ws = args.ws;
    { const int tid_ = F.wave * 64 + lane_id(); for (int u = tid_; u < (LDS_BYTES - LDSCTL_OFF) / 4; u += NWAVES * 64) ((LAS unsigned*)(F.lds + LDSCTL_OFF))[u] = 0u; }
    __syncthreads();
    XcdBarrier bar; bar.bar = (unsigned*)(F.ctl + CW_BAR); bar.x = 0; bar.st = nullptr;
    if (N_LAUNCHES == 1) bar = xcd_barrier_post((unsigned*)(F.ctl + CW_BAR), F.MISC + 8, F.wave);
#define GRID_BAR() do { if (N_LAUNCHES == 1) xcd_barrier(bar, F.wave); } while (0)
    const int lo = args.ph_lo, hi = args.ph_hi;
#ifndef MK_PHMASK
#define MK_PHMASK 0x7fff
#endif
#ifndef MK_DOUBLE
#define MK_DOUBLE -1
#endif
#define REP(k) _Pragma("unroll") for (int rep_ = 0; rep_ < ((MK_DOUBLE) == (k) ? 2 : 1); ++rep_)
#define IN(k) ((((MK_PHMASK) >> (k)) & 1) && lo <= (k) && (k) < hi)
#define BOTH(k) (IN(k) && IN((k) + 1))
    bf16* S6 = (bf16*)(ws + WS_S6);
    float* X1 = args.out;
    bf16* TB = (bf16*)args.out;

    REP(0) if (IN(0)) { p0_prologue(F, args); if (BOTH(0)) GRID_BAR(); }

    REP(1) if (IN(1)) {
        pg8::DenseOrder S; S.init(ws + WS_XB, ws + WS_WIN, T_, INW_, D_, F.G, (int)blockIdx.x);
        EpiZ E{S6, (bf16*)(ws + WS_G), (const float*)(ws + WS_ROPE), (float*)(ws + WS_KMEAN)};
        pg8::gemm_phase<EpiZ, pg8::DenseOrder, true>(F.lds + RING_OFF, D_, S, E, F.wave);
        if (BOTH(1)) GRID_BAR();
    }
    if (IN(2)) { p_conv(F, args.in[3]); p_select(F); if (BOTH(2)) GRID_BAR(); }

    REP(3) if (IN(3)) {
        const AttnOrder S{F.vcu};
        int bh, qb;
        for (int i = 0; S.next(i, bh, qb); ++i)
            attn_body::attn_unit<8>(bh >> 3, bh & 7, qb, (const attn_body::bf16*)S6, (const attn_body::bf16*)(S6 + (size_t)T_ * 512), (const attn_body::bf16*)(S6 + (size_t)2 * T_ * 512),
                                    (attn_body::bf16*)(ws + WS_LOGITS), (const unsigned*)(ws + WS_SEL), (char*)lds + RING_OFF, F.wave);
        if (BOTH(3)) GRID_BAR();
    }
    REP(4) if (IN(4)) {
        { pg8::DenseOrder S; S.init(ws + WS_LOGITS, ws + WS_WAO, T_, D_, AW_, F.G, (int)blockIdx.x);
#ifdef MK_P4A_PLAIN
          EpiBf16Plain E{(bf16*)(ws + WS_P1), D_};
          pg8::gemm_phase<EpiBf16Plain, pg8::DenseOrder, true>(F.lds + RING_OFF, AW_, S, E, F.wave); }
#else
          EpiGate<false> E{(bf16*)(ws + WS_P1), (const bf16*)(ws + WS_G)};
          pg8::gemm_phase<EpiGate<false>, pg8::DenseOrder, true>(F.lds + RING_OFF, AW_, S, E, F.wave); }
#endif
        VM_WAIT(); __syncthreads();
#ifndef MK_SKIP_P4B
        { pg8::DenseOrder S; S.init(S6 + (size_t)3 * T_ * 512, ws + WS_WCO, T_, D_, CW_, F.G, (int)blockIdx.x);
          EpiGate<true> E{(bf16*)(ws + WS_P1), (const bf16*)(ws + WS_G) + (size_t)T_ * 1024};
          pg8::gemm_phase<EpiGate<true>, pg8::DenseOrder, true>(F.lds + RING_OFF, CW_, S, E, F.wave); }
#endif
        if (BOTH(4)) GRID_BAR();
    }
    REP(5) if (IN(5)) {
        pg8::DenseOrder S; S.init(ws + WS_P1, ws + WS_WOUT, T_, D_, D_, F.G, (int)blockIdx.x);
        EpiRes<false> E{TB, args.in[0]};
        pg8::gemm_phase<EpiRes<false>, pg8::DenseOrder, true>(F.lds + RING_OFF, D_, S, E, F.wave);
        if (BOTH(5)) GRID_BAR();
    }
    REP(6) if (IN(6)) {
        const int gw = F.vcu * NWAVES + F.wave, NGW = F.G * NWAVES;
        for (int m = gw; m < T_; m += NGW) ln_row<false, false, true>(F, TB, nullptr, (bf16*)(ws + WS_XB), args.in[7], args.in[8], nullptr, nullptr, m);
        if (BOTH(6)) GRID_BAR();
    }
    REP(7) if (IN(7)) {
        { pg8::DenseOrder S; S.init(ws + WS_XB, ws + WS_WSR, T_, 768, D_, F.G, (int)blockIdx.x);
          EpiShRouter E{(bf16*)(ws + WS_HS), (float*)(ws + WS_LOGITS)};
          pg8::gemm_phase<EpiShRouter, pg8::DenseOrder, true>(F.lds + RING_OFF, D_, S, E, F.wave); }
        if (F.G == 256) { PPOrder S{(const char*)(ws + WS_PB), (const char*)(ws + WS_WPP), PLE_, (int)blockIdx.x};
          EpiBf16Plain E{(bf16*)(ws + WS_PP), D_};
          pg8::gemm_phase<EpiBf16Plain, PPOrder, true>(F.lds + RING_OFF, PLE_, S, E, F.wave); }
        else { pg8::DenseOrder S; S.init(ws + WS_PB, ws + WS_WPP, T_, D_, PLE_, F.G, (int)blockIdx.x);
          EpiBf16Plain E{(bf16*)(ws + WS_PP), D_};
          pg8::gemm_phase<EpiBf16Plain, pg8::DenseOrder, true>(F.lds + RING_OFF, PLE_, S, E, F.wave); }
        if (BOTH(7)) GRID_BAR();
    }
    if (IN(8)) {
        p_route(F, args.in[10]);
        { pg8::DenseOrder S; S.init(ws + WS_HS, ws + WS_WSD, T_, D_, 256, F.G, (int)blockIdx.x);
          EpiRes<true> E{TB, (const void*)(ws + WS_XB)};
          pg8::gemm_phase<EpiRes<true>, pg8::DenseOrder, true>(F.lds + RING_OFF, 256, S, E, F.wave); }
        if (BOTH(8)) GRID_BAR();
    }
    if (IN(9)) { p_assign(F); if (BOTH(9)) GRID_BAR(); }

    REP(10) if (IN(10)) {
        moe_tables(F);
        MoeUpOrder S{(const LAS unsigned short*)(F.lds + LX_BLKE), (const LAS unsigned*)(F.lds + LX_XS), (const int*)(ws + WS_ROWTOK), (const char*)(ws + WS_XB), (const char*)(ws + WS_WGU), F.G >= 8 ? F.G / 8 : 1, F.vcu};
        EpiMoeUp E{(bf16*)(ws + WS_H)};
        pg8::gemm_phase<EpiMoeUp, MoeUpOrder, true>(F.lds + RING_OFF, D_, S, E, F.wave);
        if (BOTH(10)) GRID_BAR();
    }
    REP(11) if (IN(11)) {
        moe_tables(F);
        MoeDownOrder S{(const LAS unsigned short*)(F.lds + LX_BLKE), (const LAS unsigned*)(F.lds + LX_XS), (const char*)(ws + WS_H), (const char*)(ws + WS_WD), F.G >= 8 ? F.G / 8 : 1, F.vcu};
        EpiMoeDown E{(unsigned char*)(ws + WS_YLO), (const int*)(ws + WS_ROWDST), (const float*)(ws + WS_ROWW)};
        pg8::gemm_phase<EpiMoeDown, MoeDownOrder, true>(F.lds + RING_OFF, 256, S, E, F.wave);
#ifdef MK_P11_NULL
        { EpiNull E0; pg8::gemm_phase<EpiNull, MoeDownOrder, true>(F.lds + RING_OFF, 256, S, E0, F.wave); }
#endif
        if (BOTH(11)) GRID_BAR();
    }
    REP(12) if (IN(12)) {
        const int gw = F.vcu * NWAVES + F.wave, NGW = F.G * NWAVES;
        for (int m = gw; m < T_; m += NGW) ln2_row(F, TB, (bf16*)(ws + WS_XB), args.in[17], args.in[18], (const unsigned char*)(ws + WS_YLO), m);
        if (BOTH(12)) GRID_BAR();
    }
    REP(13) if (IN(13)) {
        pg8::DenseOrder S; S.init(ws + WS_XB, ws + WS_WPG, T_, D_, D_, F.G, (int)blockIdx.x);
        EpiPle E{(bf16*)(ws + WS_H), (const bf16*)(ws + WS_XB), (const bf16*)(ws + WS_PP)};
        pg8::gemm_phase<EpiPle, pg8::DenseOrder, true>(F.lds + RING_OFF, D_, S, E, F.wave);
        if (BOTH(13)) GRID_BAR();
    }
    REP(14) if (IN(14)) {
        const int gw = F.vcu * NWAVES + F.wave, NGW = F.G * NWAVES;
        for (int m = gw; m < T_; m += NGW) ln_row<false, true, false>(F, (const bf16*)(ws + WS_H), X1, nullptr, args.in[21], args.in[22], nullptr, nullptr, m);
    }
#if defined(MK_DBG_OFF)
    if (lo <= 14 && 14 < hi) { const int lane_ = lane_id(), tid_ = F.wave * 64 + lane_; const bf16* src = (const bf16*)(ws + (size_t)(MK_DBG_OFF));
        for (size_t i = (size_t)F.vcu * 512 + tid_; i < (size_t)T_ * D_ / 8; i += (size_t)F.G * 512) { const v4u w = *(const v4u*)(src + (i % (size_t)(MK_DBG_WRAP)) * 8);
            f32x4 a, b; a.x = bf_lo(w.x); a.y = bf_hi(w.x); a.z = bf_lo(w.y); a.w = bf_hi(w.y); b.x = bf_lo(w.z); b.y = bf_hi(w.z); b.z = bf_lo(w.w); b.w = bf_hi(w.w);
            *(f32x4*)(args.out + i * 8) = a; *(f32x4*)(args.out + i * 8 + 4) = b; } }
#endif
#undef IN
#undef BOTH
#undef GRID_BAR
}

extern "C" void kernel_launch(void* const* d_in, const int* in_sizes, int n_in, void* d_out, int out_size, void* d_ws, size_t ws_size, hipStream_t stream) {
    static int grid = 0;
    if (grid == 0) {
        if (n_in != 23 || in_sizes[0] != T_ * D_ || out_size != T_ * D_ || ws_size < WS_END) { fprintf(stderr, "kernel_launch: unexpected shapes (n_in %d, in0 %d, out %d, ws %zu); nothing launched\n", n_in, n_in > 0 ? in_sizes[0] : -1, out_size, ws_size); grid = -1; return; }
        int dev = 0, cus = 0, per_cu = 0;
        if (hipGetDevice(&dev) != hipSuccess || hipDeviceGetAttribute(&cus, hipDeviceAttributeMultiprocessorCount, dev) != hipSuccess) { fprintf(stderr, "kernel_launch: device query failed\n"); grid = -1; return; }
        if (hipFuncSetAttribute((const void*)fwd_kernel, hipFuncAttributeMaxDynamicSharedMemorySize, LDS_BYTES) != hipSuccess) { fprintf(stderr, "kernel_launch: hipFuncSetAttribute failed\n"); grid = -1; return; }
        if (hipOccupancyMaxActiveBlocksPerMultiprocessor(&per_cu, (const void*)fwd_kernel, NWAVES * 64, LDS_BYTES) != hipSuccess || per_cu < 1)
            fprintf(stderr, "kernel_launch: note: occupancy query reports %d workgroups per CU\n", per_cu);
        (void)hipGetLastError();
        grid = cus;
    }
    if (grid < 0) return;
    if (hipMemsetAsync((char*)d_ws + WS_CTL, 0, CTL_ZERO_BYTES, stream) != hipSuccess) { fprintf(stderr, "kernel_launch: memset failed\n"); return; }
    Args a{};
    for (int i = 0; i < 23; ++i) a.in[i] = (const float*)d_in[i];
    a.out = (float*)d_out; a.ws = (unsigned char*)d_ws; a.pad = 0;
    for (int li = 0; li < N_LAUNCHES; ++li) {
        a.ph_lo = (N_LAUNCHES == 1) ? 0 : li; a.ph_hi = (N_LAUNCHES == 1) ? NPH : li + 1; a.li = li;
        hipLaunchKernelGGL(fwd_kernel, dim3(grid), dim3(NWAVES * 64), LDS_BYTES, stream, a);
        const hipError_t le = hipPeekAtLastError();
        if (le != hipSuccess) { fprintf(stderr, "kernel_launch: launch %d failed: %s\n", li, hipGetErrorName(le)); break; }
    }
}
```
